# Optimizing an MI355X kernel written in HIP

```python
import jax, jax.numpy as jnp
from jax import lax
import numpy as np

D_MODEL = 1024
BATCH = 1
SEQ = 16384
DEPTH = 2

HEAD_DIM = 64
A_HEADS = 8
A_KV = 2
B_HEADS = 8
B_KV = 2
C_HEADS = 16
D_FF = 2816
GRID_W = 64
Q_BLOCK = 128
WINDOW = 128
NA_KH = 8
NA_KW = 16
ROPE_THETA = 10000.0
EPS = 1e-6
EVEN_IN = (A_HEADS + 2 * A_KV + B_HEADS + 2 * B_KV) * HEAD_DIM
EVEN_OUT = (A_HEADS + B_HEADS) * HEAD_DIM
ODD_IN = 3 * C_HEADS * HEAD_DIM
ODD_OUT = C_HEADS * HEAD_DIM
NEG_INF = -1e30

kernel_name = "hybrid_axial_window_neighbourhood_encoder"


def rms_norm(x, g):
    xf = x.astype(jnp.float32)
    y = xf * lax.rsqrt(jnp.mean(xf * xf, axis=-1, keepdims=True) + EPS)
    return (y * g.astype(jnp.float32)).astype(x.dtype)


def swiglu(h, w_gate, w_up, w_down):
    return (jax.nn.silu(h @ w_gate) * (h @ w_up)) @ w_down


def rope_cos_sin(pos, dim):
    inv = ROPE_THETA ** (-jnp.arange(0, dim, 2, dtype=jnp.float32) / dim)
    ang = pos.astype(jnp.float32)[:, None] * inv[None, :]
    return jnp.cos(ang), jnp.sin(ang)


def apply_rope(x, cos, sin):
    half = x.shape[-1] // 2
    c = cos[None, :, None, :].astype(x.dtype)
    s = sin[None, :, None, :].astype(x.dtype)
    x1, x2 = x[..., :half], x[..., half:]
    return jnp.concatenate([x1 * c - x2 * s, x1 * s + x2 * c], axis=-1)


def apply_axial_rope(x, cos_r, sin_r, cos_c, sin_c):
    half = x.shape[-1] // 2
    return jnp.concatenate([apply_rope(x[..., :half], cos_r, sin_r),
                            apply_rope(x[..., half:], cos_c, sin_c)], axis=-1)


def global_gqa(q, k, v):
    bsz, s_len, h, d = q.shape
    kv = k.shape[2]
    g = h // kv
    nb = s_len // Q_BLOCK
    scale = HEAD_DIM ** -0.5
    qb = q.reshape(bsz, nb, Q_BLOCK, kv, g, d).transpose(1, 0, 2, 3, 4, 5)

    def block(qi):
        s = jnp.einsum('bqkgd,bskd->bkgqs', qi, k, preferred_element_type=jnp.float32) * scale
        p = jax.nn.softmax(s, axis=-1).astype(v.dtype)
        return jnp.einsum('bkgqs,bskd->bqkgd', p, v)

    o = lax.map(block, qb)
    return o.transpose(1, 0, 2, 3, 4, 5).reshape(bsz, s_len, h * d)


def windowed_gqa_sink(q, k, v, sink):
    bsz, s_len, h, d = q.shape
    kv = k.shape[2]
    g = h // kv
    nb = s_len // Q_BLOCK
    scale = HEAD_DIM ** -0.5
    qb = q.reshape(bsz, nb, Q_BLOCK, kv, g, d)
    pad = ((0, 0), (Q_BLOCK, Q_BLOCK), (0, 0), (0, 0))
    kb = jnp.pad(k, pad).reshape(bsz, nb + 2, Q_BLOCK, kv, d)
    vb = jnp.pad(v, pad).reshape(bsz, nb + 2, Q_BLOCK, kv, d)
    k_slab = jnp.concatenate([kb[:, :-2], kb[:, 1:-1], kb[:, 2:]], axis=2)
    v_slab = jnp.concatenate([vb[:, :-2], vb[:, 1:-1], vb[:, 2:]], axis=2)
    s = jnp.einsum('bnqkgd,bnskd->bnkgqs', qb, k_slab, preferred_element_type=jnp.float32) * scale
    blk = jnp.arange(nb)[:, None, None] * Q_BLOCK
    qpos = blk + jnp.arange(Q_BLOCK)[None, :, None]
    kpos = blk - Q_BLOCK + jnp.arange(3 * Q_BLOCK)[None, None, :]
    valid = (jnp.abs(qpos - kpos) <= WINDOW) & (kpos >= 0) & (kpos < s_len)
    s = jnp.where(valid[None, :, None, None], s, NEG_INF)
    sk = sink.astype(jnp.float32).reshape(kv, g)[None, None, :, :, None]
    m = jnp.maximum(jnp.max(s, axis=-1), sk)
    p = jnp.exp(s - m[..., None])
    denom = jnp.sum(p, axis=-1) + jnp.exp(sk - m)
    p = (p / denom[..., None]).astype(v.dtype)
    o = jnp.einsum('bnkgqs,bnskd->bnqkgd', p, v_slab)
    return o.reshape(bsz, s_len, h * d)


def neighbourhood_attention(q, k, v, rel_bias, rows):
    bsz, s_len, h, d = q.shape
    kh = min(NA_KH, rows)
    kw = NA_KW
    scale = HEAD_DIM ** -0.5
    qg = q.reshape(bsz, rows, GRID_W, h, d)
    kg = k.reshape(bsz, rows, GRID_W, h, d)
    vg = v.reshape(bsz, rows, GRID_W, h, d)
    cols = jnp.arange(GRID_W)
    col_start = jnp.clip(cols - kw // 2, 0, GRID_W - kw)
    col_idx = col_start[:, None] + jnp.arange(kw)[None, :]
    col_bias_idx = col_idx - cols[:, None] + (NA_KW - 1)

    def row_fn(args):
        q_r, r = args
        rs = jnp.clip(r - kh // 2, 0, rows - kh)
        k_rows = lax.dynamic_slice_in_dim(kg, rs, kh, axis=1)
        v_rows = lax.dynamic_slice_in_dim(vg, rs, kh, axis=1)
        k_win = k_rows[:, :, col_idx]
        v_win = v_rows[:, :, col_idx]
        row_bias_idx = rs + jnp.arange(kh) - r + (NA_KH - 1)
        bias = rel_bias[:, row_bias_idx[:, None, None], col_bias_idx[None, :, :]]
        s = jnp.einsum('bchd,bacwhd->bhcaw', q_r, k_win, preferred_element_type=jnp.float32) * scale
        s = s + bias.transpose(0, 2, 1, 3)[None].astype(jnp.float32)
        p = jax.nn.softmax(s.reshape(bsz, h, GRID_W, kh * kw), axis=-1)
        p = p.reshape(s.shape).astype(v.dtype)
        return jnp.einsum('bhcaw,bacwhd->bchd', p, v_win)

    o = lax.map(row_fn, (qg.transpose(1, 0, 2, 3, 4), jnp.arange(rows)))
    return o.transpose(1, 0, 2, 3, 4).reshape(bsz, s_len, h * d)


def even_mixer(h, w_in, q_gain, k_gain, sink, w_out, rope1, rope_axial):
    bsz, s_len, _ = h.shape
    proj = h @ w_in
    sizes = [A_HEADS * HEAD_DIM, A_KV * HEAD_DIM, A_KV * HEAD_DIM,
             B_HEADS * HEAD_DIM, B_KV * HEAD_DIM, B_KV * HEAD_DIM]
    cuts = list(np.cumsum(sizes)[:-1])
    qa, ka, va, qb, kb, vb = jnp.split(proj, cuts, axis=-1)
    hd = lambda t: t.reshape(bsz, s_len, -1, HEAD_DIM)
    qa, ka, va, qb, kb, vb = map(hd, (qa, ka, va, qb, kb, vb))
    qa = apply_axial_rope(rms_norm(qa, q_gain), *rope_axial)
    ka = apply_axial_rope(rms_norm(ka, k_gain), *rope_axial)
    oa = global_gqa(qa, ka, va)
    qb = apply_rope(qb, *rope1)
    kb = apply_rope(kb, *rope1)
    ob = windowed_gqa_sink(qb, kb, vb, sink)
    return jnp.concatenate([oa, ob], axis=-1) @ w_out


def odd_mixer(h, w_qkv, rel_bias, w_out, rows):
    bsz, s_len, _ = h.shape
    q, k, v = jnp.split(h @ w_qkv, 3, axis=-1)
    q = q.reshape(bsz, s_len, C_HEADS, HEAD_DIM)
    k = k.reshape(bsz, s_len, C_HEADS, HEAD_DIM)
    v = v.reshape(bsz, s_len, C_HEADS, HEAD_DIM)
    return neighbourhood_attention(q, k, v, rel_bias, rows) @ w_out


def setup_inputs(seed: int = 0) -> dict:
    key = jax.random.key(seed)
    ks = iter(jax.random.split(key, 32))
    f32 = jnp.float32
    n_even = (DEPTH + 1) // 2
    n_odd = DEPTH // 2

    def w(shape, fan_in):
        return jax.random.normal(next(ks), shape, f32) * (fan_in ** -0.5)

    def gain(shape):
        return 1.0 + 0.1 * jax.random.normal(next(ks), shape, f32)

    return {
        "x": jax.random.normal(next(ks), (BATCH, SEQ, D_MODEL), f32),
        "ffn1_norm": gain((DEPTH, D_MODEL)),
        "ffn1_w_gate": w((DEPTH, D_MODEL, D_FF), D_MODEL),
        "ffn1_w_up": w((DEPTH, D_MODEL, D_FF), D_MODEL),
        "ffn1_w_down": w((DEPTH, D_FF, D_MODEL), D_FF),
        "mix_norm": gain((DEPTH, D_MODEL)),
        "ffn2_norm": gain((DEPTH, D_MODEL)),
        "ffn2_w_gate": w((DEPTH, D_MODEL, D_FF), D_MODEL),
        "ffn2_w_up": w((DEPTH, D_MODEL, D_FF), D_MODEL),
        "ffn2_w_down": w((DEPTH, D_FF, D_MODEL), D_FF),
        "even_w_in": w((n_even, D_MODEL, EVEN_IN), D_MODEL),
        "a_q_norm": gain((n_even, HEAD_DIM)),
        "a_k_norm": gain((n_even, HEAD_DIM)),
        "b_sink": 0.5 * jax.random.normal(next(ks), (n_even, B_HEADS), f32),
        "even_w_out": w((n_even, EVEN_OUT, D_MODEL), EVEN_OUT),
        "odd_w_qkv": w((n_odd, D_MODEL, ODD_IN), D_MODEL),
        "c_rel_bias": 0.1 * jax.random.normal(next(ks), (n_odd, C_HEADS, 2 * NA_KH - 1, 2 * NA_KW - 1), f32),
        "odd_w_out": w((n_odd, ODD_OUT, D_MODEL), ODD_OUT),
        "final_norm": gain((D_MODEL,)),
    }


def reference(x, ffn1_norm, ffn1_w_gate, ffn1_w_up, ffn1_w_down, mix_norm,
              ffn2_norm, ffn2_w_gate, ffn2_w_up, ffn2_w_down,
              even_w_in, a_q_norm, a_k_norm, b_sink, even_w_out,
              odd_w_qkv, c_rel_bias, odd_w_out, final_norm):
    s_len = x.shape[1]
    rows = s_len // GRID_W
    pos = jnp.arange(s_len)
    rope1 = rope_cos_sin(pos, HEAD_DIM)
    cos_r, sin_r = rope_cos_sin(pos // GRID_W, HEAD_DIM // 2)
    cos_c, sin_c = rope_cos_sin(pos % GRID_W, HEAD_DIM // 2)
    rope_axial = (cos_r, sin_r, cos_c, sin_c)
    for layer in range(DEPTH):
        i = layer // 2
        h = rms_norm(x, ffn1_norm[layer])
        x = x + 0.5 * swiglu(h, ffn1_w_gate[layer], ffn1_w_up[layer], ffn1_w_down[layer])
        h = rms_norm(x, mix_norm[layer])
        if layer % 2 == 0:
            x = x + even_mixer(h, even_w_in[i], a_q_norm[i], a_k_norm[i], b_sink[i],
                               even_w_out[i], rope1, rope_axial)
        else:
            x = x + odd_mixer(h, odd_w_qkv[i], c_rel_bias[i], odd_w_out[i], rows)
        h = rms_norm(x, ffn2_norm[layer])
        x = x + 0.5 * swiglu(h, ffn2_w_gate[layer], ffn2_w_up[layer], ffn2_w_down[layer])
    return rms_norm(x, final_norm)
```

```cpp
#include <hip/hip_runtime.h>
#include <hip/hip_cooperative_groups.h>
#include <hip/hip_bf16.h>
#include <cstdio>
#include <cstdint>
#include <cmath>
namespace cg = cooperative_groups;

constexpr int SEQ = 16384, DMODEL = 1024, DFF = 2816, NGU = 2 * DFF;
constexpr float RMS_EPS = 1e-6f;
constexpr float LOG2E = 1.4426950408889634f;
constexpr float QSCALE = 0.125f * 1.4426950408889634f;

namespace pg8 {
#define PG8_LAS __attribute__((address_space(3)))
typedef unsigned short bf16_t;
typedef short bf16x8 __attribute__((ext_vector_type(8)));
typedef float f32x4 __attribute__((ext_vector_type(4)));
typedef unsigned u32x4 __attribute__((ext_vector_type(4)));
#define WT_RSRC(base) __builtin_amdgcn_make_buffer_rsrc((void*)(base), 0, 0x7fffffff, 0x00020000)
#define WT_STORE16(rsrc, byteoff, v) __builtin_amdgcn_raw_buffer_store_b128((v), (rsrc), (int)(byteoff), 0, 16)
constexpr int BM = 256, BK = 64, HALF = 128, HTB = HALF * BK * 2  , STAGE_BYTES = 8 * HTB, NXCD = 8, WGM = 8;

__host__ __device__ __forceinline__ int lds_byte(int r, int c) { const int st = (r >> 4) * 2 + (c >> 5), rr = r & 15, cc = c & 31, ob = rr * 64 + cc * 2; return st * 1024 + (ob ^ (((ob >> 9) & 1) << 5)); }
__host__ __device__ __forceinline__ void stage_rc(int b, int& R, int& C) { const int st = b / 1024, sb = b % 1024, swz = sb ^ (((sb >> 9) & 1) << 5); R = (st >> 1) * 16 + swz / 64; C = (st & 1) * 32 + (swz % 64) / 2; }
__host__ __device__ __forceinline__ int perm32(int rho) { const int n = rho >> 4, i = rho & 15; return 8 * (i >> 2) + 4 * n + (i & 3); }

struct Unit { int pm, pn; };
struct Gemm { const bf16_t* A; const bf16_t* Bt; int M, N, K; };

struct StaticOrder {
    int nM, nN, nwg, G, c;
    __host__ __device__ void init(int M, int N, int G_, int c_) { nM = M / BM; nN = N / BM; nwg = nM * nN; G = G_; c = c_; }
    __host__ __device__ bool next(int i, Unit& u) const {
        const long L = (long)i * G + c; if (L >= nwg) return false;
        int wgid = (int)L; { const int q = nwg / NXCD, r = nwg % NXCD, xcd = wgid % NXCD, off = wgid / NXCD; wgid = (xcd < r ? xcd * (q + 1) : r * (q + 1) + (xcd - r) * q) + off; }
        const int nig = WGM * nN, gid = wgid / nig, fm = gid * WGM, gsz = (nM - fm) < WGM ? (nM - fm) : WGM;
        u.pm = fm + ((wgid % nig) % gsz); u.pn = (wgid % nig) / gsz; return true;
    }
    __device__ __forceinline__ void a_ready(const Unit&) const {}
    __device__ __forceinline__ void done(const Unit&) const {}
};

__device__ __forceinline__ unsigned cvt_pk_bf16(float lo, float hi) { unsigned r; asm volatile("v_cvt_pk_bf16_f32 %0, %1, %2" : "=v"(r) : "v"(lo), "v"(hi)); return r; }
typedef unsigned long long u64;
__device__ __forceinline__ float row_scale(const u64* sq, unsigned row) {
    return __builtin_amdgcn_rsqf((float)sq[row] * (1.f / (1048576.f * 1024.f)) + 1e-6f);
}
constexpr int SCALE_LDS = 131072 + 1024;
__device__ __forceinline__ float silu_mul(float g, float u) { return g * u * __builtin_amdgcn_rcpf(1.f + __builtin_amdgcn_exp2f(-1.4426950408889634f * g)); }

struct EpiGU {
    static constexpr bool PERM = true, AFTER_DRAIN = false, HAS_PRE = true;
    bf16_t* ACT; const u64* sq; u64* sqz;
    __device__ __forceinline__ void pre_first(const Unit& u, PG8_LAS unsigned char* lds, int tid) const {
        if (tid < 256) ((PG8_LAS float*)(lds + SCALE_LDS))[tid] = row_scale(sq, u.pm * BM + tid);
    }
    __device__ __forceinline__ void operator()(const f32x4 (&acc)[2][2][4][2], const Unit& u, const Unit& nx, bool has_next, int par, PG8_LAS unsigned char* lds, int tid, int wr, int wc, int fr, int fq) const {
        u64 nsq = 0; const bool ld = has_next && tid < 256; if (ld) nsq = sq[nx.pm * BM + tid];
        const PG8_LAS float* sc = (const PG8_LAS float*)(lds + SCALE_LDS) + par * 256;
        const unsigned rl0 = wr * 64 + fr, row0 = u.pm * BM + rl0, col0 = u.pn * 128 + wc * 32 + 8 * fq; const auto rs_ = WT_RSRC(ACT);
        const bool zr = (u.pn == 0) && (wc == 0) && (fq == 0);
#pragma unroll
        for (int ai = 0; ai < 2; ++ai) {
#pragma unroll
            for (int m = 0; m < 4; ++m) { const unsigned row = row0 + ai * HALF + m * 16; const float s = sc[rl0 + ai * HALF + m * 16]; if (zr) sqz[row] = 0ull;
                const f32x4 g0 = acc[ai][0][m][0] * s, g1 = acc[ai][0][m][1] * s, u0 = acc[ai][1][m][0] * s, u1 = acc[ai][1][m][1] * s;
                u32x4 w; w.x = cvt_pk_bf16(silu_mul(g0[0], u0[0]), silu_mul(g0[1], u0[1])); w.y = cvt_pk_bf16(silu_mul(g0[2], u0[2]), silu_mul(g0[3], u0[3]));
                w.z = cvt_pk_bf16(silu_mul(g1[0], u1[0]), silu_mul(g1[1], u1[1])); w.w = cvt_pk_bf16(silu_mul(g1[2], u1[2]), silu_mul(g1[3], u1[3]));
                WT_STORE16(rs_, (row * 2816u + col0) * 2u, w); }
            __builtin_amdgcn_sched_barrier(0);
        }
        if (ld) ((PG8_LAS float*)(lds + SCALE_LDS))[(par ^ 1) * 256 + tid] = __builtin_amdgcn_rsqf((float)nsq * (1.f / (1048576.f * 1024.f)) + 1e-6f);
    }
};
template <bool F32IN> struct EpiRes {
    static constexpr bool PERM = true, AFTER_DRAIN = false, HAS_PRE = false;
    const float* in_f32; bf16_t* xb; u64* sqa; float alpha;
    __device__ __forceinline__ void finish(const f32x4& v0, const f32x4& v1, unsigned off, float& ss) const {
        u32x4 w; w.x = cvt_pk_bf16(v0[0], v0[1]); w.y = cvt_pk_bf16(v0[2], v0[3]); w.z = cvt_pk_bf16(v1[0], v1[1]); w.w = cvt_pk_bf16(v1[2], v1[3]);
        WT_STORE16(WT_RSRC(xb), off * 2u, w);
        ss += ((v0[0] * v0[0] + v0[1] * v0[1]) + (v0[2] * v0[2] + v0[3] * v0[3])) + ((v1[0] * v1[0] + v1[1] * v1[1]) + (v1[2] * v1[2] + v1[3] * v1[3]));
    }
    __device__ __forceinline__ void operator()(const f32x4 (&acc)[2][2][4][2], const Unit& u, int wr, int wc, int fr, int fq) const {
        const unsigned row0 = u.pm * BM + wr * 64 + fr, col0 = u.pn * BM + wc * 32 + 8 * fq;
        if constexpr (F32IN) {
#pragma unroll
            for (int ai = 0; ai < 2; ++ai)
#pragma unroll
                for (int mp = 0; mp < 2; ++mp) {
                    f32x4 o[2][2][2];
#pragma unroll
                    for (int mm = 0; mm < 2; ++mm)
#pragma unroll
                        for (int bj = 0; bj < 2; ++bj) { const unsigned off = (row0 + ai * HALF + (2 * mp + mm) * 16) * 1024u + col0 + bj * HALF;
                            o[mm][bj][0] = *(const f32x4*)(in_f32 + off); o[mm][bj][1] = *(const f32x4*)(in_f32 + (off + 4u)); }
#pragma unroll
                    for (int mm = 0; mm < 2; ++mm) { const int m = 2 * mp + mm; const unsigned row = row0 + ai * HALF + m * 16; float ss = 0.f;
#pragma unroll
                        for (int bj = 0; bj < 2; ++bj) finish(o[mm][bj][0] + acc[ai][bj][m][0] * alpha, o[mm][bj][1] + acc[ai][bj][m][1] * alpha, row * 1024u + col0 + bj * HALF, ss);
                        ss += __shfl_xor(ss, 16); ss += __shfl_xor(ss, 32);
                        if (fq == 0) atomicAdd(sqa + row, (u64)(ss * 1048576.f)); }
                    __builtin_amdgcn_sched_barrier(0);
                }
        } else {
            u32x4 t[2][4][2];
#pragma unroll
            for (int ai = 0; ai < 2; ++ai)
#pragma unroll
                for (int m = 0; m < 4; ++m)
#pragma unroll
                    for (int bj = 0; bj < 2; ++bj) t[ai][m][bj] = *(const u32x4*)(xb + ((row0 + ai * HALF + m * 16) * 1024u + col0 + bj * HALF));
            __builtin_amdgcn_sched_barrier(0);
#pragma unroll
            for (int ai = 0; ai < 2; ++ai) {
#pragma unroll
                for (int m = 0; m < 4; ++m) { const unsigned row = row0 + ai * HALF + m * 16; float ss = 0.f;
#pragma unroll
                    for (int bj = 0; bj < 2; ++bj) { const u32x4 w0 = t[ai][m][bj];
                        const f32x4 o0 = {__builtin_bit_cast(float, w0.x << 16), __builtin_bit_cast(float, w0.x & 0xffff0000u), __builtin_bit_cast(float, w0.y << 16), __builtin_bit_cast(float, w0.y & 0xffff0000u)};
                        const f32x4 o1 = {__builtin_bit_cast(float, w0.z << 16), __builtin_bit_cast(float, w0.z & 0xffff0000u), __builtin_bit_cast(float, w0.w << 16), __builtin_bit_cast(float, w0.w & 0xffff0000u)};
                        finish(o0 + acc[ai][bj][m][0] * alpha, o1 + acc[ai][bj][m][1] * alpha, row * 1024u + col0 + bj * HALF, ss); }
                    ss += __shfl_xor(ss, 16); ss += __shfl_xor(ss, 32);
                    if (fq == 0) atomicAdd(sqa + row, (u64)(ss * 1048576.f)); }
                __builtin_amdgcn_sched_barrier(0);
            }
        }
    }
};
struct EpiNull {
    static constexpr bool PERM = true, AFTER_DRAIN = false, HAS_PRE = false;
    float* sink;
    __device__ __forceinline__ void operator()(const f32x4 (&acc)[2][2][4][2], const Unit& u, int wr, int wc, int fr, int fq) const {
        float s = 0.f;
#pragma unroll
        for (int a = 0; a < 2; ++a)
#pragma unroll
            for (int b = 0; b < 2; ++b)
#pragma unroll
                for (int m = 0; m < 4; ++m)
#pragma unroll
                    for (int n = 0; n < 2; ++n) s += acc[a][b][m][n][0] + acc[a][b][m][n][1] + acc[a][b][m][n][2] + acc[a][b][m][n][3];
        if (s == 123.456f) sink[0] = s;
    }
};
struct EpiProj {
    static constexpr bool PERM = true, AFTER_DRAIN = false, HAS_PRE = true;
    bf16_t* O; unsigned ldc; const u64* sq; u64* sqz; int qcols; float qscale;
    __device__ __forceinline__ void pre_first(const Unit& u, PG8_LAS unsigned char* lds, int tid) const {
        if (tid < 256) ((PG8_LAS float*)(lds + SCALE_LDS))[tid] = row_scale(sq, u.pm * BM + tid);
    }
    __device__ __forceinline__ void operator()(const f32x4 (&acc)[2][2][4][2], const Unit& u, const Unit& nx, bool has_next, int par, PG8_LAS unsigned char* lds, int tid, int wr, int wc, int fr, int fq) const {
        u64 nsq = 0; const bool ld = has_next && tid < 256; if (ld) nsq = sq[nx.pm * BM + tid];
        const PG8_LAS float* sc = (const PG8_LAS float*)(lds + SCALE_LDS) + par * 256;
        const unsigned rl0 = wr * 64 + fr, row0 = u.pm * BM + rl0, col0 = u.pn * BM + wc * 32 + 8 * fq; const auto rs_ = WT_RSRC(O);
        const float cs = (u.pn * BM < qcols) ? qscale : 1.f;
        const bool zr = (u.pn == 0) && (wc == 0) && (fq == 0);
#pragma unroll
        for (int ai = 0; ai < 2; ++ai) {
#pragma unroll
            for (int m = 0; m < 4; ++m) { const unsigned row = row0 + ai * HALF + m * 16; const float s = sc[rl0 + ai * HALF + m * 16] * cs; if (zr) sqz[row] = 0ull;
#pragma unroll
                for (int bj = 0; bj < 2; ++bj) { const f32x4 v0 = acc[ai][bj][m][0] * s, v1 = acc[ai][bj][m][1] * s;
                    u32x4 w; w.x = cvt_pk_bf16(v0[0], v0[1]); w.y = cvt_pk_bf16(v0[2], v0[3]); w.z = cvt_pk_bf16(v1[0], v1[1]); w.w = cvt_pk_bf16(v1[2], v1[3]);
                    WT_STORE16(rs_, (row * ldc + col0 + bj * HALF) * 2u, w); } }
            __builtin_amdgcn_sched_barrier(0);
        }
        if (ld) ((PG8_LAS float*)(lds + SCALE_LDS))[(par ^ 1) * 256 + tid] = __builtin_amdgcn_rsqf((float)nsq * (1.f / (1048576.f * 1024.f)) + 1e-6f);
    }
};
template <class Epi, class Sched, bool ALIGN_EPI = false, bool SP2 = false>
__device__ __forceinline__ void gemm_phase(PG8_LAS unsigned char* lds, Gemm g, const Sched& S, const Epi& E) {
    asm volatile("" : "+s"(g.A), "+s"(g.Bt));
    int tid = threadIdx.x; asm volatile("" : "+v"(tid));
    const int wid = __builtin_amdgcn_readfirstlane(tid >> 6), lane = tid & 63, wr = wid >> 2, wc = wid & 3, fr = lane & 15, fq = lane >> 4;
    const int K = g.K, nt = K / BK;
    unsigned voffA[2], voffB[2];
#pragma unroll
    for (int i = 0; i < 2; ++i) { int R, C; stage_rc(tid * 16 + i * 8192, R, C); const int Rb = Epi::PERM ? ((R & ~31) + perm32(R & 31)) : R;
        voffA[i] = (unsigned)(R * K + C) * 2u; voffB[i] = (unsigned)(Rb * K + C) * 2u; }
    const size_t kstep = (size_t)(BK * 2);
    const size_t hstep = (size_t)HALF * K * 2;
    const size_t tstep = 2 * hstep;
    const unsigned ldsw = (unsigned)wid * 1024u;
    const int aoff = lds_byte(wr * 64 + fr, fq * 8), boff = lds_byte(wc * 32 + fr, fq * 8);
#define PG8_SA(b, h) (((b) * 2 + (h)) * HTB)
#define PG8_SB(b, h) ((4 + (b) * 2 + (h)) * HTB)
#define PG8_STAGE(bufoff, gbase, voff) do { _Pragma("unroll") for (int _i = 0; _i < 2; ++_i) \
        __builtin_amdgcn_global_load_lds((const unsigned*)((const char*)(gbase) + (voff)[_i]), (PG8_LAS unsigned*)(lds + (bufoff) + ldsw + _i * 8192), 16, 0, 0); } while (0)
#define PG8_LDA(dst, b, h) do { _Pragma("unroll") for (int m = 0; m < 4; ++m) _Pragma("unroll") for (int k = 0; k < 2; ++k) dst[m][k] = *(const PG8_LAS bf16x8*)(lds + PG8_SA(b, h) + aoff + m * 2048 + k * 1024); } while (0)
#define PG8_LDB(dst, b, h) do { _Pragma("unroll") for (int n = 0; n < 2; ++n) _Pragma("unroll") for (int k = 0; k < 2; ++k) dst[n][k] = *(const PG8_LAS bf16x8*)(lds + PG8_SB(b, h) + boff + n * 2048 + k * 1024); } while (0)
#define PG8_MMA(ai, bj, At, Bt) do { __builtin_amdgcn_s_setprio(1); _Pragma("unroll") for (int m = 0; m < 4; ++m) _Pragma("unroll") for (int n = 0; n < 2; ++n) _Pragma("unroll") for (int k = 0; k < 2; ++k) \
        acc[ai][bj][m][n] = __builtin_amdgcn_mfma_f32_16x16x32_bf16(Bt[n][k], At[m][k], acc[ai][bj][m][n], 0, 0, 0); __builtin_amdgcn_s_setprio(0); } while (0)
#define PG8_WAIT_V(n) asm volatile("s_waitcnt vmcnt(" #n ")" ::: "memory")
#define PG8_WAIT_L(n) asm volatile("s_waitcnt lgkmcnt(" #n ")" ::: "memory")
#define PG8_BAR __builtin_amdgcn_s_barrier()
#define PG8_SCHED __builtin_amdgcn_sched_barrier(0)
    Unit cur, nxt; int ui = 0;
    if (!S.next(0, cur)) return;
    f32x4 acc[2][2][4][2];
#pragma unroll
    for (int a = 0; a < 2; ++a)
#pragma unroll
        for (int b = 0; b < 2; ++b)
#pragma unroll
            for (int m = 0; m < 4; ++m)
#pragma unroll
                for (int n = 0; n < 2; ++n) acc[a][b][m][n] = (f32x4){0.f, 0.f, 0.f, 0.f};
    bf16x8 At[4][2], B0[2][2], B1[2][2];
    const char* cA = (const char*)g.A + (size_t)cur.pm * tstep; const char* cB = (const char*)g.Bt + (size_t)cur.pn * tstep;
    S.a_ready(cur);
    if constexpr (Epi::HAS_PRE) E.pre_first(cur, lds, tid);
    if constexpr (SP2) {
        PG8_STAGE(PG8_SB(0, 0), cB, voffB); PG8_STAGE(PG8_SB(0, 1), cB + hstep, voffB); PG8_STAGE(PG8_SA(0, 0), cA, voffA); PG8_STAGE(PG8_SA(0, 1), cA + hstep, voffA);
        if (wr == 1) PG8_BAR;
        PG8_WAIT_V(2); PG8_BAR;
        PG8_STAGE(PG8_SB(1, 0), cB + kstep, voffB); PG8_STAGE(PG8_SA(1, 0), cA + kstep, voffA); PG8_STAGE(PG8_SB(1, 1), cB + hstep + kstep, voffB);
        PG8_WAIT_V(6); PG8_BAR;
    } else {
        PG8_STAGE(PG8_SB(0, 0), cB, voffB); PG8_STAGE(PG8_SA(0, 0), cA, voffA); PG8_STAGE(PG8_SB(0, 1), cB + hstep, voffB); PG8_STAGE(PG8_SA(0, 1), cA + hstep, voffA);
        if (wr == 1) PG8_BAR;
        PG8_WAIT_V(4); PG8_BAR;
        PG8_STAGE(PG8_SB(1, 0), cB + kstep, voffB); PG8_STAGE(PG8_SA(1, 0), cA + kstep, voffA); PG8_STAGE(PG8_SB(1, 1), cB + hstep + kstep, voffB);
        PG8_WAIT_V(6); PG8_BAR;
    }
    for (;;) {
        const bool has_next = S.next(ui + 1, nxt);
        const char* nA = has_next ? (const char*)g.A + (size_t)nxt.pm * tstep : cA; const char* nB = has_next ? (const char*)g.Bt + (size_t)nxt.pn * tstep : cB;
        for (int t = 0; t < nt; t += 2) {
            const bool last = (t == nt - 2);
            const char* a1 = cA + (size_t)(t + 1) * kstep;
            const char* a2 = last ? nA : cA + (size_t)(t + 2) * kstep; const char* b2 = last ? nB : cB + (size_t)(t + 2) * kstep;
            const char* a3 = a2 + kstep; const char* b3 = b2 + kstep;
            if (last && has_next) S.a_ready(nxt);
            if constexpr (SP2) {
            PG8_LDB(B0, 0, 0); PG8_LDB(B1, 0, 1); PG8_SCHED; PG8_LDA(At, 0, 0); PG8_STAGE(PG8_SA(1, 1), a1 + hstep, voffA);
            PG8_WAIT_V(8); PG8_WAIT_L(0); PG8_BAR; PG8_MMA(0, 0, At, B0); PG8_MMA(0, 1, At, B1); PG8_BAR; PG8_SCHED;
            PG8_LDA(At, 0, 1); PG8_STAGE(PG8_SB(0, 0), b2, voffB); PG8_STAGE(PG8_SB(0, 1), b2 + hstep, voffB); PG8_STAGE(PG8_SA(0, 0), a2, voffA);
            PG8_WAIT_V(8); PG8_WAIT_L(0); PG8_BAR; PG8_MMA(1, 0, At, B0); PG8_MMA(1, 1, At, B1); PG8_BAR; PG8_SCHED;
            PG8_LDB(B0, 1, 0); PG8_LDB(B1, 1, 1); PG8_SCHED; PG8_LDA(At, 1, 0); PG8_STAGE(PG8_SA(0, 1), a2 + hstep, voffA);
            PG8_WAIT_V(8); PG8_WAIT_L(0); PG8_BAR; PG8_MMA(0, 0, At, B0); PG8_MMA(0, 1, At, B1); PG8_BAR; PG8_SCHED;
            PG8_LDA(At, 1, 1); PG8_STAGE(PG8_SB(1, 0), b3, voffB); PG8_STAGE(PG8_SB(1, 1), b3 + hstep, voffB); PG8_STAGE(PG8_SA(1, 0), a3, voffA);
            PG8_WAIT_V(8); PG8_WAIT_L(0); PG8_BAR; PG8_MMA(1, 0, At, B0); PG8_MMA(1, 1, At, B1); PG8_BAR; PG8_SCHED;
            } else {
            PG8_LDB(B0, 0, 0); PG8_SCHED; PG8_LDA(At, 0, 0); PG8_STAGE(PG8_SA(1, 1), a1 + hstep, voffA);
            PG8_WAIT_L(8); PG8_BAR; PG8_WAIT_L(0); PG8_MMA(0, 0, At, B0); PG8_BAR; PG8_SCHED;
            PG8_LDB(B1, 0, 1); PG8_STAGE(PG8_SB(0, 0), b2, voffB);
            PG8_BAR; PG8_WAIT_L(0); PG8_MMA(0, 1, At, B1); PG8_BAR;
            PG8_LDA(At, 0, 1); PG8_STAGE(PG8_SA(0, 0), a2, voffA);
            PG8_BAR; PG8_WAIT_L(0); PG8_MMA(1, 0, At, B0); PG8_BAR; PG8_SCHED;
            PG8_STAGE(PG8_SB(0, 1), b2 + hstep, voffB);
            PG8_WAIT_V(6); PG8_BAR; PG8_MMA(1, 1, At, B1); PG8_BAR;
            PG8_LDB(B0, 1, 0); PG8_SCHED; PG8_LDA(At, 1, 0); PG8_STAGE(PG8_SA(0, 1), a2 + hstep, voffA);
            PG8_WAIT_L(8); PG8_BAR; PG8_WAIT_L(0); PG8_MMA(0, 0, At, B0); PG8_BAR; PG8_SCHED;
            PG8_LDB(B1, 1, 1); PG8_STAGE(PG8_SB(1, 0), b3, voffB);
            PG8_BAR; PG8_WAIT_L(0); PG8_MMA(0, 1, At, B1); PG8_BAR;
            PG8_LDA(At, 1, 1); PG8_STAGE(PG8_SA(1, 0), a3, voffA);
            PG8_BAR; PG8_WAIT_L(0); PG8_MMA(1, 0, At, B0); PG8_BAR; PG8_SCHED;
            PG8_STAGE(PG8_SB(1, 1), b3 + hstep, voffB);
            PG8_WAIT_V(6); PG8_BAR; PG8_MMA(1, 1, At, B1); PG8_BAR;
            }
        }
        if constexpr (ALIGN_EPI) { if (wr == 0) PG8_BAR; }
        if constexpr (Epi::HAS_PRE) { E(acc, cur, nxt, has_next, ui & 1, lds, tid, wr, wc, fr, fq); S.done(cur); }
        else if constexpr (!Epi::AFTER_DRAIN) { E(acc, cur, wr, wc, fr, fq); S.done(cur); }
        if (!has_next) break;
#pragma unroll
        for (int a = 0; a < 2; ++a)
#pragma unroll
            for (int b = 0; b < 2; ++b)
#pragma unroll
                for (int m = 0; m < 4; ++m)
#pragma unroll
                    for (int n = 0; n < 2; ++n) acc[a][b][m][n] = (f32x4){0.f, 0.f, 0.f, 0.f};
        cur = nxt; cA = nA; cB = nB; ++ui;
        if constexpr (ALIGN_EPI) { if (wr == 1) PG8_BAR; }
    }
    PG8_WAIT_V(0);
    if constexpr (!ALIGN_EPI) { if (wr == 0) PG8_BAR; }
    PG8_BAR;
    if constexpr (Epi::AFTER_DRAIN) { E.fused(acc, cur, wr, wc, fr, fq, lds, wid, lane); S.done(cur); }
#undef PG8_SA
#undef PG8_SB
#undef PG8_STAGE
#undef PG8_LDA
#undef PG8_LDB
#undef PG8_MMA
#undef PG8_WAIT_V
#undef PG8_WAIT_L
#undef PG8_BAR
#undef PG8_SCHED
}
}
namespace attn_body {
using bf16=__hip_bfloat16;
using bf16x8=__attribute__((ext_vector_type(8)))short;
using s16x4=__attribute__((ext_vector_type(4)))short;
using f32x16=__attribute__((ext_vector_type(16)))float;
using u32x4=__attribute__((ext_vector_type(4)))unsigned;
constexpr int BATCH=2,NHEAD=16,SEQ=8192,D=64,DM=NHEAD*D;
constexpr int NW=8,QBLK=32,QB=QBLK*NW,KVBLK=64,NQB=SEQ/QB;
constexpr int ATTN_PITCH=DM, ATTN_UNIT_ROWS=QB;
__device__ __forceinline__ int crow(int r,int hi){return (r&3)+8*(r>>2)+4*hi;}
#define SBAR() __builtin_amdgcn_sched_barrier(0)
constexpr int NSLOT=3, SLOTB=8192;
constexpr int LDS_K=0, LDS_V=NSLOT*SLOTB, LDS_WS=2*NSLOT*SLOTB, LDS_OST=LDS_WS+NW*64*4, LDS_BYTES=LDS_OST+NW*4096;
constexpr float C2=0.125f*1.4426950408889634f;
__device__ __forceinline__ void glds16(const void*gsrc,unsigned lds_dst){unsigned keep;
  asm volatile("s_mov_b32 %0, m0\n\ts_mov_b32 m0, %2\n\ts_nop 0\n\tglobal_load_lds_dwordx4 %1, off\n\ts_mov_b32 m0, %0":"=&s"(keep):"v"(gsrc),"s"(lds_dst):"memory");}
__device__ __forceinline__ float max3f(float a,float b,float c){float r;asm("v_max3_f32 %0, %1, %2, %3":"=v"(r):"v"(a),"v"(b),"v"(c));return r;}
__device__ __forceinline__ float max2f(float a,float b){float r;asm("v_max_f32_e32 %0, %1, %2":"=v"(r):"v"(a),"v"(b));return r;}
__device__ __forceinline__ float fadd_s(float a,float b){float r;asm("v_add_f32_e32 %0, %1, %2":"=v"(r):"v"(a),"v"(b));return r;}
__device__ __forceinline__ float fsub_s(float a,float b){float r;asm("v_sub_f32_e32 %0, %1, %2":"=v"(r):"v"(a),"v"(b));return r;}
typedef float f32x2_t __attribute__((ext_vector_type(2))); typedef __bf16 bf16x2_t __attribute__((ext_vector_type(2)));
__device__ __forceinline__ unsigned cvtpk_s(float lo,float hi){f32x2_t v={lo,hi};bf16x2_t b=__builtin_convertvector(v,bf16x2_t);return __builtin_bit_cast(unsigned,b);}
#define WAIT_BAR(N) asm volatile("s_waitcnt vmcnt(" #N ") lgkmcnt(0)\n\ts_barrier":::"memory")

__device__ __forceinline__ void qkt(f32x16&p0,f32x16&p1,const char*Kslot,const bf16x8*qr,const f32x16&negm,int r32,int hi){
  const char*kb=Kslot+hi*1024+r32*16;
  #pragma unroll
  for(int d0=0;d0<4;++d0){
    const bf16x8 b0=*reinterpret_cast<const bf16x8*>(kb+d0*2048);
    const bf16x8 b1=*reinterpret_cast<const bf16x8*>(kb+d0*2048+512);
    if(d0==0){p0=__builtin_amdgcn_mfma_f32_32x32x16_bf16(b0,qr[0],negm,0,0,0);p1=__builtin_amdgcn_mfma_f32_32x32x16_bf16(b1,qr[0],negm,0,0,0);}
    else{p0=__builtin_amdgcn_mfma_f32_32x32x16_bf16(b0,qr[d0],p0,0,0,0);p1=__builtin_amdgcn_mfma_f32_32x32x16_bf16(b1,qr[d0],p1,0,0,0);}}
}
typedef __attribute__((address_space(3))) const char* lds_cptr;
typedef short v4i16_t __attribute__((ext_vector_type(4)));
__device__ __forceinline__ void kload8(bf16x8*kf,lds_cptr kp){
  kf[0]=*(const __attribute__((address_space(3))) bf16x8*)(kp);      kf[1]=*(const __attribute__((address_space(3))) bf16x8*)(kp+512);
  kf[2]=*(const __attribute__((address_space(3))) bf16x8*)(kp+2048); kf[3]=*(const __attribute__((address_space(3))) bf16x8*)(kp+2560);
  kf[4]=*(const __attribute__((address_space(3))) bf16x8*)(kp+4096); kf[5]=*(const __attribute__((address_space(3))) bf16x8*)(kp+4608);
  kf[6]=*(const __attribute__((address_space(3))) bf16x8*)(kp+6144); kf[7]=*(const __attribute__((address_space(3))) bf16x8*)(kp+6656);
}
__device__ __forceinline__ void kload2(bf16x8*kf,lds_cptr kp,int j){ kf[2*j]=*(const __attribute__((address_space(3))) bf16x8*)(kp+j*2048); kf[2*j+1]=*(const __attribute__((address_space(3))) bf16x8*)(kp+j*2048+512); }
__device__ __forceinline__ s16x4 vtr(lds_cptr p){ return __builtin_bit_cast(s16x4,__builtin_amdgcn_ds_read_tr16_b64_v4i16((__attribute__((address_space(3))) v4i16_t*)p)); }
__device__ __forceinline__ float rowmax(const f32x16&p0,const f32x16&p1){
  float a=max3f(p0[0],p0[1],p1[0]),b=max3f(p0[2],p0[3],p1[1]);a=max3f(a,p1[2],p1[3]);
  #pragma unroll
  for(int r=4;r<16;r+=4){a=max3f(a,p0[r],p0[r+1]);b=max3f(b,p0[r+2],p0[r+3]);a=max3f(a,p1[r],p1[r+1]);b=max3f(b,p1[r+2],p1[r+3]);}
  const float m=max2f(a,b);
  auto rr=__builtin_amdgcn_permlane32_swap(__float_as_uint(m),__float_as_uint(m),false,false);
  return max2f(__uint_as_float(rr[0]),__uint_as_float(rr[1]));
}
__device__ __forceinline__ void pv(f32x16*o,int vb,bf16x8 pa0,bf16x8 pa1,bf16x8 pa2,bf16x8 pa3){
  #pragma unroll
  for(int d0=0;d0<2;++d0){s16x4 lo[4],hi[4];
    #pragma unroll
    for(int ks=0;ks<4;++ks){
      asm volatile("ds_read_b64_tr_b16 %0,%1 offset:%c2":"=&v"(lo[ks]):"v"(vb),"i"(d0*4096+ks*1024):"memory");
      asm volatile("ds_read_b64_tr_b16 %0,%1 offset:%c2":"=&v"(hi[ks]):"v"(vb),"i"(d0*4096+ks*1024+512):"memory");}
    asm volatile("s_waitcnt lgkmcnt(0)":::"memory");SBAR();
    #define PK(k) (bf16x8){lo[k][0],lo[k][1],lo[k][2],lo[k][3],hi[k][0],hi[k][1],hi[k][2],hi[k][3]}
    o[d0]=__builtin_amdgcn_mfma_f32_32x32x16_bf16(pa0,PK(0),o[d0],0,0,0);
    o[d0]=__builtin_amdgcn_mfma_f32_32x32x16_bf16(pa1,PK(1),o[d0],0,0,0);
    o[d0]=__builtin_amdgcn_mfma_f32_32x32x16_bf16(pa2,PK(2),o[d0],0,0,0);
    o[d0]=__builtin_amdgcn_mfma_f32_32x32x16_bf16(pa3,PK(3),o[d0],0,0,0);
    #undef PK
  }
}
constexpr int NA_DR=656, NA_TAB=15*NA_DR;
constexpr int LDS_BIAS=LDS_BYTES+1024, ATTN_LDS_TOTAL=LDS_BIAS+NA_TAB*4+2048;
constexpr int OPITCH=1024;
typedef __attribute__((address_space(3))) float* lds_fptr;
template<int MODE> __device__ __forceinline__ void amask(f32x16&p0,f32x16&p1,const int kt,const int qpos,const int hi,lds_fptr bias,const int tb0,const int tb1,const int qrow){
  if(MODE==1){
    const int kb=kt*64+4*hi, lo=qpos-128, hq=qpos+128;
    #pragma unroll
    for(int r=0;r<16;++r){const int kv=kb+(r&3)+8*(r>>2); if(kv<lo||kv>hq)p0[r]=-INFINITY; if(kv+32<lo||kv+32>hq)p1[r]=-INFINITY;}
  }
  if(MODE==2){
    const int rs=min(max(qrow-4,0),248);
    if(kt<rs||kt>=rs+8){
      #pragma unroll
      for(int r=0;r<16;++r){p0[r]=-INFINITY;p1[r]=-INFINITY;}
    } else {
      const int dr=kt-qrow+7; lds_fptr b0=bias+dr*NA_DR+tb0, b1=bias+dr*NA_DR+tb1;
      #pragma unroll
      for(int r=0;r<16;++r){const int o=(r&3)+8*(r>>2); p0[r]+=b0[o]; p1[r]+=b1[o];}
    }
  }
}
#define ATTN_STORE16(base,byteoff,v) __builtin_amdgcn_raw_buffer_store_b128((v), __builtin_amdgcn_make_buffer_rsrc((void*)(base), 0, 0x7fffffff, 0x00020000), (int)(byteoff), 0, 16)
template<int MODE,int THRL> __device__ __forceinline__ void attn_unit(const bf16*Qh,const bf16*__restrict__ Kh,const bf16*__restrict__ Vh,bf16*Oh,const int DM,const int q0,const int tile0,const int NT,const float sink_l2,const float*biasg,const bool build,const bool pre,const bool preV,const bf16*nKh,const bf16*nVh,const int ntile0,char*shm){
  int tid=threadIdx.x; asm volatile("":"+v"(tid)); const int lane=tid&63,r32=lane&31,hi=lane>>5; const int wid=__builtin_amdgcn_readfirstlane(tid>>6);
  const bf16*Qw=Qh+(long)(q0+wid*QBLK)*DM;
  const unsigned lds0=(unsigned)(uintptr_t)shm;
  float*wsf=(float*)(shm+LDS_WS)+wid*64;
  const bf16*ksrc=Kh+(long)(tile0*KVBLK+lane)*DM+wid*8;
  const bf16*vsrc=Vh+(long)(tile0*KVBLK+16*(wid&3)+(lane>>2))*DM+(wid>>2)*32+(lane&3)*8;
  const unsigned kdst=lds0+LDS_K+wid*1024, vdst=lds0+LDS_V+wid*1024;
  #define DMA_K(t,slot) glds16(ksrc+(long)(t)*KVBLK*DM,(unsigned)__builtin_amdgcn_readfirstlane(kdst+(slot)))
  #define DMA_V(t,slot) glds16(vsrc+(long)(t)*KVBLK*DM,(unsigned)__builtin_amdgcn_readfirstlane(vdst+(slot)))
  const int vb0=(int)(lds0+LDS_V)+((lane>>4)&1)*32+(lane&3)*8+(4*hi+((lane&15)>>2))*64;
  const char*Kbase=shm+LDS_K; bf16x8 kf[8];
  const lds_cptr shm3=(lds_cptr)shm; const lds_cptr kp0=shm3+LDS_K+hi*1024+r32*16; const lds_cptr vp0=shm3+LDS_V+((lane>>4)&1)*32+(lane&3)*8+(4*hi+((lane&15)>>2))*64;
  lds_fptr biasl=(lds_fptr)((lds_cptr)shm+LDS_BIAS);
  if(MODE==2&&build){
    lds_fptr stg=biasl+NA_TAB; if(tid<465) stg[tid]=biasg[tid]*1.4426950408889634f;
    asm volatile("s_waitcnt vmcnt(0) lgkmcnt(0)\n\ts_barrier":::"memory");
    for(int e=tid;e<NA_TAB;e+=512){ const int dr=e/NA_DR, w=e-dr*NA_DR; int idx=-1;
      if(w<112){ if(w>=48&&w<64) idx=w-41; } else if(w<144){ } else if(w<400){ const int q=(w-144)>>5, kc=(w-144)&31; if(kc<16) idx=kc-q+15; } else { const int q=(w-400)>>5, j=(w-400)&31; if(j>=16) idx=j-q-9; }
      biasl[e]=(idx>=0)?stg[dr*31+idx]:-INFINITY; } }
  if(!pre){DMA_K(0,0);} if(!preV){DMA_V(0,0);} if(!pre){DMA_K(1,SLOTB);}
  bf16x8 qr[4];
  #pragma unroll
  for(int d0=0;d0<4;++d0)qr[d0]=*reinterpret_cast<const bf16x8*>(&Qw[(long)r32*DM+d0*16+hi*8]);
  float mhat=0.f,l_reg=0.f;f32x16 o[2];o[0]=f32x16{};o[1]=f32x16{};f32x16 negm=f32x16{};asm volatile("":"+v"(negm));
  const int qpos=q0+wid*QBLK+r32; const int qrow=(q0>>6)+(wid>>1);
  int tb0=0,tb1=0; if(MODE==2){ const int qc=qpos&63; if(qc<8){tb0=144+qc*32;tb1=112;} else if(qc>=56){tb0=112;tb1=400+(qc-56)*32;} else {tb0=56-qc;tb1=tb0+32;} tb0+=4*hi;tb1+=4*hi; }
  #define CMASK(P0,P1,t) amask<MODE>(P0,P1,tile0+(t),qpos,hi,biasl,tb0,tb1,qrow)
  bool resc=false;
  #define START(P0,P1) do{ const float rm=rowmax(P0,P1); resc=false; \
    { const float dl=(MODE==0)?rm:__builtin_fmaxf(rm,-64.f); mhat=fadd_s(mhat,dl); \
      _Pragma("unroll") for(int r=0;r<16;++r){P0[r]=fsub_s(P0[r],dl);P1[r]=fsub_s(P1[r],dl);} \
      _Pragma("unroll") for(int r=0;r<16;++r)negm[r]=-mhat; asm volatile("":"+v"(negm)); } \
    _Pragma("unroll") for(int r=0;r<16;++r)P0[r]=__builtin_amdgcn_exp2f(P0[r]); }while(0)
  #define RESC() do{ if(resc){ asm volatile("s_waitcnt lgkmcnt(0)":::"memory"); \
      _Pragma("unroll") for(int d_=0;d_<2;++d_) _Pragma("unroll") for(int r=0;r<16;++r)o[d_][r]*=wsf[crow(r,hi)]; } }while(0)
  f32x16 pA0,pA1,pB0,pB1;
  int sl_prev=0,sl_cur=0,sl_next=SLOTB;
  #define ROT() do{sl_prev=sl_cur;sl_cur=sl_next;sl_next=(sl_next==(NSLOT-1)*SLOTB)?0:sl_next+SLOTB;}while(0)
  DMA_K(2,2*SLOTB);
  WAIT_BAR(3);
  qkt(pA0,pA1,Kbase,qr,negm,r32,hi);asm volatile("s_nop 15\n\ts_nop 7":"+v"(pA0),"+v"(pA1));CMASK(pA0,pA1,0);
  START(pA0,pA1);
  _Pragma("unroll") for(int r=0;r<16;++r)pA1[r]=__builtin_amdgcn_exp2f(pA1[r]);
  WAIT_BAR(0);
  DMA_K(3,0);DMA_V(1,SLOTB);
  ROT();
  kload8(kf,kp0+sl_cur);
  WAIT_BAR(2);
  s16x4 vlo[8],vhi[8]; u32x4 pw0,pw1,pw2,pw3;
  #define PKW(P,B) cvtpk_s(P[B],P[B+1])
  #define PAF(k) __builtin_bit_cast(bf16x8,pw##k)
  #define VFR(i) (bf16x8){vlo[i][0],vlo[i][1],vlo[i][2],vlo[i][3],vhi[i][0],vhi[i][1],vhi[i][2],vhi[i][3]}
  #define PIN(x) asm volatile("":"+v"(x))
  #define MX3(a,b,c) __builtin_fmaxf(__builtin_fmaxf((a),(b)),(c))
  #define GAPA(MF,A0,A1,A2,A3,W0,W1,PW) do{ MF; sacc+=A0; sacc+=A1; sacc+=A2; sacc+=A3; PIN(sacc); W0; W1; PIN(PW); SBAR(); }while(0)
  #define EX(v) __builtin_amdgcn_exp2f(v)
  #define GAPB(MF,X,B) do{ MF; X[B]=EX(X[B]); X[B+1]=EX(X[B+1]); X[B+2]=EX(X[B+2]); X[B+3]=EX(X[B+3]); PIN(X); SBAR(); }while(0)
  #define VRD(i) do{ vlo[i]=vtr(vp_+(((i)>>2)*4096+((i)&3)*1024)); vhi[i]=vtr(vp_+(((i)>>2)*4096+((i)&3)*1024+512)); }while(0)
  #define KRD(G,j) do{ if(G){ kload2(kf,kp0+sl_next,j); SBAR(); } }while(0)
  #define STEP(C0,C1,P0,P1,t,GK,GV,GL) do{ SBAR(); \
    const lds_cptr vp_=vp0+sl_prev; \
    VRD(0); SBAR(); float sacc=(P0[0]+P0[1]); \
    GAPA(C0=__builtin_amdgcn_mfma_f32_32x32x16_bf16(kf[0],qr[0],negm,0,0,0), P0[2],P0[3],P0[4],P0[5],     pw0[0]=PKW(P0,0), pw0[1]=PKW(P0,2), pw0); \
    VRD(4); SBAR(); GAPA(C1=__builtin_amdgcn_mfma_f32_32x32x16_bf16(kf[1],qr[0],negm,0,0,0), P0[6],P0[7],P0[8],P0[9],     pw0[2]=PKW(P0,4), pw0[3]=PKW(P0,6), pw0); \
    VRD(1); SBAR(); GAPA(C0=__builtin_amdgcn_mfma_f32_32x32x16_bf16(kf[2],qr[1],C0,0,0,0),   P0[10],P0[11],P0[12],P0[13], pw1[0]=PKW(P0,8), pw1[1]=PKW(P0,10), pw1); \
    VRD(5); SBAR(); GAPA(C1=__builtin_amdgcn_mfma_f32_32x32x16_bf16(kf[3],qr[1],C1,0,0,0),   P0[14],P0[15],P1[0],P1[1],   pw1[2]=PKW(P0,12),pw1[3]=PKW(P0,14), pw1); \
    VRD(2); SBAR(); GAPA(C0=__builtin_amdgcn_mfma_f32_32x32x16_bf16(kf[4],qr[2],C0,0,0,0),   P1[2],P1[3],P1[4],P1[5],     pw2[0]=PKW(P1,0), pw2[1]=PKW(P1,2), pw2); \
    VRD(6); SBAR(); GAPA(C1=__builtin_amdgcn_mfma_f32_32x32x16_bf16(kf[5],qr[2],C1,0,0,0),   P1[6],P1[7],P1[8],P1[9],     pw2[2]=PKW(P1,4), pw2[3]=PKW(P1,6), pw2); \
    VRD(3); SBAR(); GAPA(C0=__builtin_amdgcn_mfma_f32_32x32x16_bf16(kf[6],qr[3],C0,0,0,0),   P1[10],P1[11],P1[12],P1[13], pw3[0]=PKW(P1,8), pw3[1]=PKW(P1,10), pw3); \
    VRD(7); SBAR(); GAPA(C1=__builtin_amdgcn_mfma_f32_32x32x16_bf16(kf[7],qr[3],C1,0,0,0),   P1[14],P1[15],0.f,0.f,       pw3[2]=PKW(P1,12),pw3[3]=PKW(P1,14), pw3); \
    l_reg+=sacc; \
    if(GK){DMA_K((t)+3,sl_cur);} if(GV){DMA_V((t)+1,sl_next);} \
    CMASK(C0,C1,t); \
    { float a=MX3(C0[0],C0[1],C1[0]),b=MX3(C0[2],C0[3],C1[1]); a=MX3(a,C1[2],C1[3]); \
      _Pragma("unroll") for(int r=4;r<16;r+=4){a=MX3(a,C0[r],C0[r+1]);b=MX3(b,C0[r+2],C0[r+3]);a=MX3(a,C1[r],C1[r+1]);b=MX3(b,C1[r+2],C1[r+3]);} \
      float rm=__builtin_fmaxf(a,b); { auto rr=__builtin_amdgcn_permlane32_swap(__float_as_uint(rm),__float_as_uint(rm),false,false); rm=__builtin_fmaxf(__uint_as_float(rr[0]),__uint_as_float(rr[1])); } \
      resc=false; \
      if(__builtin_expect(__any(rm>(float)THRL),0)){ const float dl=__builtin_fmaxf(rm,0.f); mhat+=dl; \
        _Pragma("unroll") for(int r=0;r<16;++r){C0[r]-=dl;C1[r]-=dl;} \
        _Pragma("unroll") for(int r=0;r<16;++r)negm[r]=-mhat; asm volatile("":"+v"(negm)); \
        const float f=__builtin_amdgcn_exp2f(-dl); l_reg*=f; if(hi==0)wsf[r32]=f; resc=true; } } \
    SBAR(); \
    GAPB(o[0]=__builtin_amdgcn_mfma_f32_32x32x16_bf16(PAF(0),VFR(0),o[0],0,0,0), C0,0); \
    GAPB(o[1]=__builtin_amdgcn_mfma_f32_32x32x16_bf16(PAF(0),VFR(4),o[1],0,0,0), C0,4); \
    KRD(GL,0); GAPB(o[0]=__builtin_amdgcn_mfma_f32_32x32x16_bf16(PAF(1),VFR(1),o[0],0,0,0), C0,8); \
    KRD(GL,1); GAPB(o[1]=__builtin_amdgcn_mfma_f32_32x32x16_bf16(PAF(1),VFR(5),o[1],0,0,0), C0,12); \
    KRD(GL,2); GAPB(o[0]=__builtin_amdgcn_mfma_f32_32x32x16_bf16(PAF(2),VFR(2),o[0],0,0,0), C1,0); \
    KRD(GL,3); GAPB(o[1]=__builtin_amdgcn_mfma_f32_32x32x16_bf16(PAF(2),VFR(6),o[1],0,0,0), C1,4); \
    GAPB(o[0]=__builtin_amdgcn_mfma_f32_32x32x16_bf16(PAF(3),VFR(3),o[0],0,0,0), C1,8); \
    GAPB(o[1]=__builtin_amdgcn_mfma_f32_32x32x16_bf16(PAF(3),VFR(7),o[1],0,0,0), C1,12); \
    }while(0)
  int t=1;
  for(;t+5<NT;t+=2){
    STEP(pB0,pB1,pA0,pA1,t,true,true,true);     WAIT_BAR(2); RESC(); ROT();
    STEP(pA0,pA1,pB0,pB1,t+1,true,true,true);   WAIT_BAR(2); RESC(); ROT();
  }
  #define ENDW(tt) do{ if((tt)+3<NT){WAIT_BAR(2);} else if((tt)+2<NT){WAIT_BAR(1);} else {WAIT_BAR(0);} }while(0)
  for(;t+1<NT;t+=2){
    STEP(pB0,pB1,pA0,pA1,t,(t+3<NT),(t+1<NT),(t+1<NT));       ENDW(t);   RESC(); ROT();
    STEP(pA0,pA1,pB0,pB1,t+1,(t+4<NT),(t+2<NT),(t+2<NT));     ENDW(t+1); RESC(); ROT();
  }
  if(nKh){
    const bf16*nks=nKh+(long)(ntile0*KVBLK+lane)*DM+wid*8;
    glds16(nks,(unsigned)__builtin_amdgcn_readfirstlane(kdst));
    if(NT%3==0){ const bf16*nvs=nVh+(long)(ntile0*KVBLK+16*(wid&3)+(lane>>2))*DM+(wid>>2)*32+(lane&3)*8; glds16(nvs,(unsigned)__builtin_amdgcn_readfirstlane(vdst)); }
    glds16(nks+(long)KVBLK*DM,(unsigned)__builtin_amdgcn_readfirstlane(kdst+SLOTB)); }
  STEP(pB0,pB1,pA0,pA1,NT-1,false,false,false); RESC();
  { float sacc=pB0[0]+pB0[1]; _Pragma("unroll") for(int r=2;r<16;++r)sacc+=pB0[r]; _Pragma("unroll") for(int r=0;r<16;++r)sacc+=pB1[r]; l_reg+=sacc;
    pw0=(u32x4){PKW(pB0,0),PKW(pB0,2),PKW(pB0,4),PKW(pB0,6)};pw1=(u32x4){PKW(pB0,8),PKW(pB0,10),PKW(pB0,12),PKW(pB0,14)};pw2=(u32x4){PKW(pB1,0),PKW(pB1,2),PKW(pB1,4),PKW(pB1,6)};pw3=(u32x4){PKW(pB1,8),PKW(pB1,10),PKW(pB1,12),PKW(pB1,14)};
    SBAR(); pv(o,vb0+sl_cur,PAF(0),PAF(1),PAF(2),PAF(3)); }
  #undef PKW
  #undef PAF
  #undef VFR
  #undef PIN
  #undef MX3
  #undef GAPA
  #undef GAPB
  #undef EX
  #undef VRD
  #undef KRD
  #undef STEP
  #undef ENDW
  {auto rr=__builtin_amdgcn_permlane32_swap(__float_as_uint(l_reg),__float_as_uint(l_reg),false,false);l_reg=__uint_as_float(rr[0])+__uint_as_float(rr[1]);}
  if(MODE==1) l_reg+=__builtin_amdgcn_exp2f(sink_l2-mhat);
  if(hi==0)wsf[32+r32]=l_reg;asm volatile("s_waitcnt lgkmcnt(0)":::"memory");
  float rli[16];
  #pragma unroll
  for(int r=0;r<16;++r)rli[r]=__builtin_amdgcn_rcpf(wsf[32+crow(r,hi)]);
  bf16*Ow=Oh+(long)(q0+wid*QBLK)*OPITCH;
  { bf16*stg=(bf16*)(shm+LDS_OST)+wid*2048;
    #pragma unroll
    for(int r=0;r<16;++r){const int orow=crow(r,hi);
      #pragma unroll
      for(int d0=0;d0<2;++d0)stg[orow*64+d0*32+r32]=__float2bfloat16(o[d0][r]*rli[r]);}
    asm volatile("s_waitcnt lgkmcnt(0)":::"memory");
    #pragma unroll
    for(int i=0;i<4;++i){const int row=i*8+(lane>>3),ch=lane&7; const u32x4 v=*(const u32x4*)(stg+row*64+ch*8); ATTN_STORE16(Oh,(unsigned)(((q0+wid*QBLK+row)*OPITCH+ch*8)*2),v);} }
  asm volatile("s_waitcnt lgkmcnt(0)\n\ts_barrier":::"memory");
  #undef DMA_K
  #undef DMA_V
  #undef CMASK
  #undef START
  #undef RESC
  #undef ROT
}
#undef SBAR
#undef WAIT_BAR
}
#define GAS __attribute__((address_space(1)))
#define LAS __attribute__((address_space(3)))
typedef unsigned short bf16;
typedef unsigned v4u __attribute__((ext_vector_type(4)));
typedef float f32x4 __attribute__((ext_vector_type(4)));
constexpr int NWAVES = 8;
#ifndef REP_P0
#define REP_P0 1
#endif
#ifndef REP_ATT_E
#define REP_ATT_E 1
#endif
#ifndef REP_ATT_O
#define REP_ATT_O 1
#endif
#ifndef REP_GU
#define REP_GU 1
#endif
#ifndef REP_PROJ
#define REP_PROJ 1
#endif
constexpr int LDS_BYTES = 135168;
static_assert(attn_body::ATTN_LDS_TOTAL <= 131072, "attention LDS inside the ring");

constexpr size_t SZ_WGU = (size_t)NGU * DMODEL * 2, SZ_WD = (size_t)DMODEL * DFF * 2;
constexpr size_t WS_WGU = 0;
constexpr size_t WS_WD = WS_WGU + 4 * SZ_WGU;
constexpr size_t WS_WIN = WS_WD + 4 * SZ_WD;
constexpr size_t WS_WOE = WS_WIN + (size_t)1536 * 1024 * 2;
constexpr size_t WS_WQKV = WS_WOE + (size_t)1024 * 1024 * 2;
constexpr size_t WS_WOO = WS_WQKV + (size_t)3072 * 1024 * 2;
constexpr size_t WS_XB = WS_WOO + (size_t)1024 * 1024 * 2;
constexpr size_t WS_PART = WS_XB + (size_t)SEQ * DMODEL * 2;
constexpr size_t WS_U = WS_PART + (size_t)SEQ * 16 * 4;
constexpr size_t WS_PROJ = WS_U, WS_O = WS_U + (size_t)SEQ * 3072 * 2, WS_END = WS_O + (size_t)SEQ * 1024 * 2;
static_assert(WS_END <= 268435456 && WS_U % 256 == 0, "d_ws map");

struct Args { const float* in[19]; float* out; unsigned char* ws; };
typedef unsigned long long u64;
__device__ __forceinline__ u64 ldptr(LAS u64* PT, int i) { const u64 v = PT[i]; const unsigned lo = __builtin_amdgcn_readfirstlane((unsigned)v), hi = __builtin_amdgcn_readfirstlane((unsigned)(v >> 32)); return ((u64)hi << 32) | lo; }

__device__ __forceinline__ unsigned f2bf(float f) { unsigned u = __builtin_bit_cast(unsigned, f); return (u + 0x7fffu + ((u >> 16) & 1u)) >> 16; }
__device__ __forceinline__ unsigned pk2(float lo, float hi) { return f2bf(lo) | (f2bf(hi) << 16); }
__device__ __forceinline__ float bf2f(unsigned short b) { return __builtin_bit_cast(float, (unsigned)b << 16); }
#define LDS_WAIT() asm volatile("s_waitcnt lgkmcnt(0)" ::: "memory")
__device__ __forceinline__ float wave_sum(float v) {
#pragma unroll
    for (int o = 1; o < 64; o <<= 1) v += __shfl_xor(v, o);
    return v;
}
__device__ __forceinline__ void transpose_item(const float* W, int K, int N, bf16* WT, const float* gain, int mode, LAS float* scr, int item, int lane) {
    const int nblk = N / 32, kb = item / nblk, nb = item % nblk, k0 = 64 * kb, n0 = 32 * nb;
    {
        const int kk8 = lane >> 3, seg = lane & 7;
        f32x4 w[8]; float gk[8];
#pragma unroll
        for (int i = 0; i < 8; ++i) { w[i] = *(const GAS f32x4*)(W + (size_t)(k0 + 8 * i + kk8) * N + n0 + 4 * seg); gk[i] = gain ? gain[k0 + 8 * i + kk8] : 1.f; }
#pragma unroll
        for (int i = 0; i < 8; ++i) { LAS float* d = scr + (8 * i + kk8) * 33 + 4 * seg; const f32x4 v = w[i] * gk[i]; d[0] = v.x; d[1] = v.y; d[2] = v.z; d[3] = v.w; }
    }
    LDS_WAIT(); asm volatile("" ::: "memory");
    const int d0 = (mode == 0) ? n0 : ((n0 >> 7) * 256 + (n0 & 127) + (mode == 2 ? 128 : 0));
    const auto wrs = __builtin_amdgcn_make_buffer_rsrc((void*)WT, 0, 0x7fffffff, 0x00020000);
    const int c = lane & 7;
#pragma unroll
    for (int j = 0; j < 4; ++j) { const int n = (lane >> 3) + 8 * j; const LAS float* s = scr + (8 * c) * 33 + n;
        v4u o; o.x = pk2(s[0 * 33], s[1 * 33]); o.y = pk2(s[2 * 33], s[3 * 33]); o.z = pk2(s[4 * 33], s[5 * 33]); o.w = pk2(s[6 * 33], s[7 * 33]);
        __builtin_amdgcn_raw_buffer_store_b128(o, wrs, (int)((((unsigned)(d0 + n)) * (unsigned)K + k0 + 8 * c) * 2u), 0, 16); }
    LDS_WAIT(); asm volatile("" ::: "memory");
}

__device__ __forceinline__ void cs_of(float ang, float& c, float& s) {
    double t = (double)ang * 0.15915494309189535; t -= __builtin_rint(t); const float r = (float)t;
    c = __builtin_amdgcn_cosf(r); s = __builtin_amdgcn_sinf(r);
}

#define P_IN(i) ((const float*)(const GAS float*)ldptr(PT, (i)))
#define P_WSB(off) ((bf16*)(GAS bf16*)(ldptr(PT, 20) + (off)))
__device__ __forceinline__ void conv_weights(LAS u64* PT, LAS unsigned char* ldsl, const unsigned mask, const int worker, const int nworkers, const int wave, const int lane) {
    LAS float* scr = (LAS float*)(ldsl + wave * 16384);
    bf16* WGU = P_WSB(WS_WGU); bf16* WD = P_WSB(WS_WD);
    constexpr int I_G = 16 * 88, I_D = 44 * 32, I_IN = 16 * 48, I_O = 16 * 32, I_QKV = 16 * 96;
    for (int it = worker; ; it += nworkers) {
        int r = it;
#define CONV_ENTRY(bit, cnt, call) if (mask & (1u << (bit))) { if (r < (cnt)) { call; continue; } r -= (cnt); }
#define FFN_ITEMS(f_, L_, GI, WG, WU, WDN) { const size_t wo = (size_t)(L_) * DMODEL * DFF; \
            CONV_ENTRY(3 * (f_) + 0, I_G, transpose_item(P_IN(WG) + wo, DMODEL, DFF, WGU + (size_t)(f_) * NGU * DMODEL, P_IN(GI) + (L_) * DMODEL, 1, scr, r, lane)) \
            CONV_ENTRY(3 * (f_) + 1, I_G, transpose_item(P_IN(WU) + wo, DMODEL, DFF, WGU + (size_t)(f_) * NGU * DMODEL, P_IN(GI) + (L_) * DMODEL, 2, scr, r, lane)) \
            CONV_ENTRY(3 * (f_) + 2, I_D, transpose_item(P_IN(WDN) + wo, DFF, DMODEL, WD + (size_t)(f_) * DMODEL * DFF, nullptr, 0, scr, r, lane)) }
        FFN_ITEMS(0, 0, 1, 2, 3, 4)
        FFN_ITEMS(1, 0, 6, 7, 8, 9)
        FFN_ITEMS(2, 1, 1, 2, 3, 4)
        FFN_ITEMS(3, 1, 6, 7, 8, 9)
#undef FFN_ITEMS
        CONV_ENTRY(12, I_IN, transpose_item(P_IN(10), DMODEL, 1536, P_WSB(WS_WIN), P_IN(5), 0, scr, r, lane))
        CONV_ENTRY(13, I_O, transpose_item(P_IN(14), DMODEL, DMODEL, P_WSB(WS_WOE), nullptr, 0, scr, r, lane))
        CONV_ENTRY(14, I_QKV, transpose_item(P_IN(15), DMODEL, 3072, P_WSB(WS_WQKV), P_IN(5) + DMODEL, 0, scr, r, lane))
        CONV_ENTRY(15, I_O, transpose_item(P_IN(17), DMODEL, DMODEL, P_WSB(WS_WOO), nullptr, 0, scr, r, lane))
#undef CONV_ENTRY
        break;
    }
}
#undef P_IN
#undef P_WSB
__device__ __forceinline__ void conv_in_tail(LAS u64* PT, LAS unsigned char* ldsl, const unsigned mask, const int nwg, const int G, const int bx, const int wave, const int lane) {
    const int rem = nwg % G, first = rem;
    if (bx >= first) conv_weights(PT, ldsl, mask, (bx - first) * NWAVES + wave, (G - first) * NWAVES, wave, lane);
}
#define RLX_AGENT __ATOMIC_RELAXED, __HIP_MEMORY_SCOPE_AGENT
#define XB_TMO      128
#define XB_XCNT(j)  (256  + 64 * (j))
#define XB_XSUB(j)  (1280 + 64 * (j))
#define XB_XGEN(j)  (2304 + 64 * (j))
#define XB_TOP      3328
#define XB_TOPGEN   3392
#define XCD_BAR_WORDS 3456
#define XB_SPIN_CAP (1u << 18)

__device__ __forceinline__ unsigned xb_ld(unsigned* p)              { return __hip_atomic_load(p, __ATOMIC_RELAXED, __HIP_MEMORY_SCOPE_AGENT); }
__device__ __forceinline__ unsigned xb_add(unsigned* p, unsigned v) { return __hip_atomic_fetch_add(p, v, __ATOMIC_RELAXED, __HIP_MEMORY_SCOPE_AGENT); }
__device__ __forceinline__ unsigned xb_xcc_id() { return (unsigned)__builtin_amdgcn_s_getreg((3 << 11) | 20) & 0xFu; }
#define XB_SPIN(cond, bar) do { unsigned _sp = 0; while (cond) { __builtin_amdgcn_s_sleep(1); \
    if ((++_sp & 255u) == 0u) { if (xb_ld(&(bar)[XB_TMO])) break; if (_sp > XB_SPIN_CAP) { atomicAdd(&(bar)[XB_TMO], 1u); break; } } } } while (0)

struct XcdBarrier {
    unsigned* bar; unsigned x;
    volatile LAS unsigned* st;
};

__device__ __forceinline__ XcdBarrier xcd_barrier_post(unsigned* bar, volatile LAS unsigned* st) {
    XcdBarrier b; b.bar = bar; b.x = xb_xcc_id(); b.st = st;
    if (threadIdx.x == 0) (void)xb_add(&bar[XB_XCNT(b.x)], 1u);
    return b;
}
__device__ __forceinline__ void xcd_barrier_complete(unsigned* bar, unsigned x, unsigned& nloc, unsigned& nx) {
    const unsigned G = gridDim.x * gridDim.y * gridDim.z;
    unsigned sum, cnt, mine, sp = 0u;
    for (;;) {
        sum = 0u; cnt = 0u; mine = 0u;
#pragma unroll
        for (unsigned j = 0; j < 16; ++j) { const unsigned c = xb_ld(&bar[XB_XCNT(j)]); sum += c; cnt += (c > 0u) ? 1u : 0u; mine = (j == x) ? c : mine; }
        if (sum == G) break;
        __builtin_amdgcn_s_sleep(1);
        if ((++sp & 255u) == 0u) { if (xb_ld(&bar[XB_TMO])) break; if (sp > XB_SPIN_CAP) { atomicAdd(&bar[XB_TMO], 1u); break; } }
    }
    nloc = mine > 0u ? mine : 1u; nx = cnt > 0u ? cnt : 1u;
}

__device__ __forceinline__ void xcd_barrier(const XcdBarrier& b) {
    asm volatile("s_waitcnt vmcnt(0)" ::: "memory");
    __syncthreads();
    if (threadIdx.x == 0) {
        unsigned* bar = b.bar;
        __builtin_amdgcn_s_waitcnt(0);
        unsigned nloc = b.st[0], nx = b.st[1];
        if (nloc == 0u) { xcd_barrier_complete(bar, b.x, nloc, nx); b.st[0] = nloc; b.st[1] = nx; }
        const unsigned old = xb_add(&bar[XB_XSUB(b.x)], 1u);
        const unsigned gen = old / nloc;
        if (old + 1u == (gen + 1u) * nloc) {
            __builtin_amdgcn_fence(__ATOMIC_RELEASE, "agent");
            asm volatile("s_waitcnt vmcnt(0)" ::: "memory");
            const unsigned og = xb_add(&bar[XB_TOP], 1u);
            const unsigned tg = og / nx;
            if (og + 1u == (tg + 1u) * nx) xb_add(&bar[XB_TOPGEN], 1u);
            else XB_SPIN(xb_ld(&bar[XB_TOPGEN]) == tg, bar);
            __builtin_amdgcn_fence(__ATOMIC_ACQUIRE, "agent");
            xb_add(&bar[XB_XGEN(b.x)], 1u);
            asm volatile("s_waitcnt vmcnt(0)" ::: "memory");
        } else {
            XB_SPIN(xb_ld(&bar[XB_XGEN(b.x)]) == gen, bar);
            __builtin_amdgcn_fence(__ATOMIC_ACQUIRE, "agent");
            asm volatile("s_waitcnt vmcnt(0)" ::: "memory");
        }
    }
    __syncthreads();
}

constexpr size_t WS_BAR = WS_PART + 512 * 1024;
__global__ void __launch_bounds__(NWAVES * 64, 2) fwd_megakernel(Args args) {
    extern __shared__ __attribute__((aligned(16))) unsigned char lds[];
    cg::grid_group grid = cg::this_grid();
    LAS unsigned char* ldsl = (LAS unsigned char*)lds;
#define FRESH() int tid = threadIdx.x; asm volatile("" : "+v"(tid)); int G = gridDim.x, bx = blockIdx.x; asm volatile("" : "+s"(G), "+s"(bx)); \
    const int lane = tid & 63, wave = __builtin_amdgcn_readfirstlane(tid >> 6); const int gw = bx * NWAVES + wave, NGW = G * NWAVES; (void)lane; (void)gw; (void)NGW;
    LAS u64* PT = (LAS u64*)(ldsl + 131072);
    if (threadIdx.x == 0) {
#pragma unroll
        for (int i = 0; i < 19; ++i) PT[i] = (u64)args.in[i];
        PT[19] = (u64)args.out; PT[20] = (u64)args.ws;
        ((volatile LAS unsigned*)(ldsl + 131072 + 256))[0] = 0u; ((volatile LAS unsigned*)(ldsl + 131072 + 256))[1] = 0u;
    }
    __syncthreads();
    int par = 0;
#define P_IN(i) ((const float*)(const GAS float*)ldptr(PT, (i)))
#define P_OUT ((float*)(GAS float*)ldptr(PT, 19))
#define P_WSB(off) ((bf16*)(GAS bf16*)(ldptr(PT, 20) + (off)))
#define P_SUMQ ((u64*)(GAS u64*)(ldptr(PT, 20) + WS_PART))

#ifndef NO_P0
    {
        FRESH();
        bf16* XB = P_WSB(WS_XB); u64* SUMQ = P_SUMQ;
        for (int rep = 0; rep < REP_P0; ++rep) {
        conv_weights(PT, ldsl, 0x0003u, gw, NGW, wave, lane);
        if (bx == 0) { unsigned* bw = (unsigned*)(GAS unsigned*)(ldptr(PT, 20) + WS_BAR); for (int i = tid; i < XCD_BAR_WORDS; i += NWAVES * 64) bw[i] = 0u; }
        const float* x = P_IN(0); const auto xrs = __builtin_amdgcn_make_buffer_rsrc((void*)XB, 0, 0x7fffffff, 0x00020000);
        for (int m0 = gw; m0 < SEQ; m0 += 2 * NGW) {
            f32x4 v[2][4]; float s[2];
#pragma unroll
            for (int q = 0; q < 2; ++q) { const int m = m0 + q * NGW; const GAS f32x4* xr = (const GAS f32x4*)(x + (size_t)(m < SEQ ? m : m0) * DMODEL) + lane;
#pragma unroll
                for (int j = 0; j < 4; ++j) v[q][j] = xr[64 * j]; }
#pragma unroll
            for (int q = 0; q < 2; ++q) { const int m = m0 + q * NGW; s[q] = 0.f;
#pragma unroll
                for (int j = 0; j < 4; ++j) s[q] += (v[q][j].x * v[q][j].x + v[q][j].y * v[q][j].y) + (v[q][j].z * v[q][j].z + v[q][j].w * v[q][j].w);
                s[q] = wave_sum(s[q]);
                if (m < SEQ) {
#pragma unroll
                    for (int j = 0; j < 4; ++j) { typedef unsigned v2u __attribute__((ext_vector_type(2))); const v2u w2 = {pk2(v[q][j].x, v[q][j].y), pk2(v[q][j].z, v[q][j].w)};
                        __builtin_amdgcn_raw_buffer_store_b64(w2, xrs, (int)(((unsigned)m * DMODEL + 256u * j + 4u * lane) * 2u), 0, 16); }
                    if (lane == 0) { SUMQ[m] = (unsigned long long)(s[q] * 1048576.f); SUMQ[SEQ + m] = 0ull; }
                } }
        }
        }
    }
    grid.sync();
    { XcdBarrier b0 = xcd_barrier_post((unsigned*)(GAS unsigned*)(ldptr(PT, 20) + WS_BAR), (volatile LAS unsigned*)(ldsl + 131072 + 256)); (void)b0; }
#define GRID_BAR() do { XcdBarrier b_; b_.bar = (unsigned*)(GAS unsigned*)(ldptr(PT, 20) + WS_BAR); b_.x = xb_xcc_id(); b_.st = (volatile LAS unsigned*)(ldsl + 131072 + 256); xcd_barrier(b_); } while (0)
#endif

#pragma unroll 1
    for (int L = 0; L < 2; ++L) {
#pragma unroll 1
        for (int h2 = 0; h2 < 2; ++h2) {
            const int f = 2 * L + h2;
#ifndef NO_GU
            {
                FRESH();
                u64* SUMQ = P_SUMQ; pg8::Gemm g{P_WSB(WS_XB), P_WSB(WS_WGU) + (size_t)f * NGU * DMODEL, SEQ, NGU, DMODEL}; pg8::StaticOrder S; S.init(SEQ, NGU, G, bx);
                pg8::EpiGU E{P_WSB(WS_U), SUMQ + par * SEQ, SUMQ + (par ^ 1) * SEQ};
                for (int rep = 0; rep < ((f == 0) ? REP_GU : 1); ++rep)
                pg8::gemm_phase<pg8::EpiGU, pg8::StaticOrder, true, true>(ldsl, g, S, E);
                { const unsigned cm = (f == 0) ? 0x301Cu : (f == 1) ? 0x02C0u : (f == 2) ? 0xCC00u : 0u; if (cm) conv_in_tail(PT, ldsl, cm, (SEQ / 256) * (NGU / 256), G, bx, wave, lane); }
            }
#endif
            GRID_BAR();
#ifndef NO_DOWN
            {
                FRESH();
                u64* SUMQ = P_SUMQ; pg8::Gemm g{P_WSB(WS_U), P_WSB(WS_WD) + (size_t)f * DMODEL * DFF, SEQ, DMODEL, DFF}; pg8::StaticOrder S; S.init(SEQ, DMODEL, G, bx);
                if (f == 0) { pg8::EpiRes<true> E{P_IN(0), P_WSB(WS_XB), SUMQ + (par ^ 1) * SEQ, 0.5f}; pg8::gemm_phase<pg8::EpiRes<true>, pg8::StaticOrder, true, true>(ldsl, g, S, E); }
                else { pg8::EpiRes<false> E{nullptr, P_WSB(WS_XB), SUMQ + (par ^ 1) * SEQ, 0.5f}; pg8::gemm_phase<pg8::EpiRes<false>, pg8::StaticOrder, true, true>(ldsl, g, S, E); }
                par ^= 1;
            }
#endif
            GRID_BAR();
            if (h2 == 1) continue;
            const int NPROJ = (L == 0) ? 1536 : 3072;
#ifndef NO_PROJ
            {
                FRESH();
                u64* SUMQ = P_SUMQ; pg8::Gemm g{P_WSB(WS_XB), (L == 0) ? P_WSB(WS_WIN) : P_WSB(WS_WQKV), SEQ, NPROJ, DMODEL}; pg8::StaticOrder S; S.init(SEQ, NPROJ, G, bx);
                pg8::EpiProj E{P_WSB(WS_PROJ), (unsigned)NPROJ, SUMQ + par * SEQ, SUMQ + (par ^ 1) * SEQ, (L == 0) ? 0 : 1024, QSCALE};
                for (int rep = 0; rep < REP_PROJ; ++rep)
                pg8::gemm_phase<pg8::EpiProj, pg8::StaticOrder, true, true>(ldsl, g, S, E);
                if (L == 0) conv_in_tail(PT, ldsl, 0x0120u, (SEQ / 256) * (1536 / 256), G, bx, wave, lane);
            }
#endif
            GRID_BAR();
            if (L == 0) {
#ifndef NO_POST
                {
                FRESH();
                const int seg = lane & 7, ts = lane >> 3;
                const float* pq = P_IN(11); const float* pk = P_IN(12); bf16* PROJ = P_WSB(WS_PROJ);
                float i32[8], i64[8], gq[8], gk[8];
#pragma unroll
                for (int j = 0; j < 8; ++j) {
                    i32[j] = (float)::exp2(-(double)(8 * (seg & 1) + j) * (2.0 / 32.0) * 13.287712379549449);
                    i64[j] = (float)::exp2(-(double)(8 * (seg & 3) + j) * (2.0 / 64.0) * 13.287712379549449);
                    gq[j] = pq[8 * seg + j]; gk[j] = pk[8 * seg + j]; }
                const auto prs = __builtin_amdgcn_make_buffer_rsrc((void*)PROJ, 0, 0x7fffffff, 0x00020000);
                for (int grp = gw; grp < SEQ / 8; grp += NGW) {
                    const int tok = grp * 8 + ts;
                    GAS v4u* row = (GAS v4u*)(PROJ + (size_t)tok * 1536) + seg;
                    v4u ra[10], rb[10];
#pragma unroll
                    for (int i = 0; i < 10; ++i) { ra[i] = row[8 * i]; rb[i] = row[96 + 8 * i]; }
                    float ca[8], sa[8], cb[8], sb[8];
                    const float pa = (float)((seg < 4) ? (tok >> 6) : (tok & 63)), pb = (float)tok;
#pragma unroll
                    for (int j = 0; j < 8; ++j) { cs_of(pa * i32[j], ca[j], sa[j]); cs_of(pb * i64[j], cb[j], sb[j]); }
#pragma unroll
                    for (int i = 0; i < 10; ++i) {
                        {
                            float v[8]; const v4u w = ra[i];
                            v[0] = __builtin_bit_cast(float, w.x << 16); v[1] = __builtin_bit_cast(float, w.x & 0xffff0000u); v[2] = __builtin_bit_cast(float, w.y << 16); v[3] = __builtin_bit_cast(float, w.y & 0xffff0000u);
                            v[4] = __builtin_bit_cast(float, w.z << 16); v[5] = __builtin_bit_cast(float, w.z & 0xffff0000u); v[6] = __builtin_bit_cast(float, w.w << 16); v[7] = __builtin_bit_cast(float, w.w & 0xffff0000u);
                            float ss = ((v[0] * v[0] + v[1] * v[1]) + (v[2] * v[2] + v[3] * v[3])) + ((v[4] * v[4] + v[5] * v[5]) + (v[6] * v[6] + v[7] * v[7]));
                            ss += __shfl_xor(ss, 1); ss += __shfl_xor(ss, 2); ss += __shfl_xor(ss, 4);
                            const float rs = __builtin_amdgcn_rsqf(ss * (1.f / 64.f) + RMS_EPS) * ((i < 8) ? QSCALE : 1.f);
                            float o[8];
#pragma unroll
                            for (int j = 0; j < 8; ++j) { const float nv = v[j] * rs * ((i < 8) ? gq[j] : gk[j]); const float pr = __shfl_xor(nv, 2);
                                o[j] = (seg & 2) ? (pr * sa[j] + nv * ca[j]) : (nv * ca[j] - pr * sa[j]); }
                            v4u r; r.x = pk2(o[0], o[1]); r.y = pk2(o[2], o[3]); r.z = pk2(o[4], o[5]); r.w = pk2(o[6], o[7]);
                            __builtin_amdgcn_raw_buffer_store_b128(r, prs, (int)(((unsigned)tok * 1536u + 64u * i + 8u * seg) * 2u), 0, 16);
                        }
                        {
                            float v[8]; const v4u w = rb[i];
                            v[0] = __builtin_bit_cast(float, w.x << 16); v[1] = __builtin_bit_cast(float, w.x & 0xffff0000u); v[2] = __builtin_bit_cast(float, w.y << 16); v[3] = __builtin_bit_cast(float, w.y & 0xffff0000u);
                            v[4] = __builtin_bit_cast(float, w.z << 16); v[5] = __builtin_bit_cast(float, w.z & 0xffff0000u); v[6] = __builtin_bit_cast(float, w.w << 16); v[7] = __builtin_bit_cast(float, w.w & 0xffff0000u);
                            const float qs = (i < 8) ? QSCALE : 1.f;
                            float o[8];
#pragma unroll
                            for (int j = 0; j < 8; ++j) { const float nv = v[j] * qs; const float pr = __shfl_xor(nv, 4);
                                o[j] = (seg & 4) ? (pr * sb[j] + nv * cb[j]) : (nv * cb[j] - pr * sb[j]); }
                            v4u r; r.x = pk2(o[0], o[1]); r.y = pk2(o[2], o[3]); r.z = pk2(o[4], o[5]); r.w = pk2(o[6], o[7]);
                            __builtin_amdgcn_raw_buffer_store_b128(r, prs, (int)(((unsigned)tok * 1536u + 768u + 64u * i + 8u * seg) * 2u), 0, 16);
                        }
                    }
                }
                }
                GRID_BAR();
#endif
                FRESH();
                {
                const attn_body::bf16* P = (const attn_body::bf16*)P_WSB(WS_PROJ); attn_body::bf16* O = (attn_body::bf16*)P_WSB(WS_O);
#define EVEN_KV(u_, kc_, vc_, t0_) { const int uu_ = (u_) & 511, h_ = uu_ & 7, qb_ = uu_ >> 3, kvh_ = h_ >> 2; \
                    if ((u_) < 512) { kc_ = 512 + kvh_ * 64; vc_ = 640 + kvh_ * 64; t0_ = 0; } else { kc_ = 1280 + kvh_ * 64; vc_ = 1408 + kvh_ * 64; t0_ = min(max(qb_ * 4 - 2, 0), 248); } }
                bool pre = false;
                for (int u = bx; u < 1024; u += G) {
                    const int uu = u & 511, h = uu & 7, qb = uu >> 3;
                    int kc, vc, t0; EVEN_KV(u, kc, vc, t0)
                    const int un = u + G; int nkc = 0, nvc = 0, nt0 = 0; const bool hn = un < 1024; if (hn) EVEN_KV(un, nkc, nvc, nt0)
                    const attn_body::bf16* nK = hn ? P + nkc : nullptr; const attn_body::bf16* nV = hn ? P + nvc : nullptr;
                    if (u < 512) attn_body::attn_unit<0, 8>(P + h * 64, P + kc, P + vc, O + h * 64, 1536, qb * 256, 0, 256, 0.f, nullptr, false, pre, false, nK, nV, nt0, (char*)lds);
                    else attn_body::attn_unit<1, 8>(P + 768 + h * 64, P + kc, P + vc, O + 512 + h * 64, 1536, qb * 256, t0, 8, P_IN(13)[h] * LOG2E, nullptr, false, pre, false, nK, nV, nt0, (char*)lds);
                    pre = hn;
                }
#ifdef PROBE_B2
                for (int u = bx + 512; u < 1024; u += G) {
                    const int uu = u & 511, h = uu & 7, qb = uu >> 3; int kc, vc, t0; EVEN_KV(u, kc, vc, t0)
                    attn_body::attn_unit<1, 8>(P + 768 + h * 64, P + kc, P + vc, O + 512 + h * 64, 1536, qb * 256, t0, 8, P_IN(13)[h] * LOG2E, nullptr, false, false, false, nullptr, nullptr, 0, (char*)lds);
                }
#endif
#undef EVEN_KV
                }
            } else {
                FRESH();
                int hb = -1;
#ifdef PROBE_NA24
                for (int u = bx; u < 1024; u += G) {
                    const int h = u & 15, qb = u >> 4; const int t0 = min(max(qb * 4 - 4, 0), 232);
                    const attn_body::bf16* P = (const attn_body::bf16*)P_WSB(WS_PROJ); attn_body::bf16* O = (attn_body::bf16*)P_WSB(WS_O);
                    attn_body::attn_unit<2, 8>(P + h * 64, P + 1024 + h * 64, P + 2048 + h * 64, O + h * 64, 3072, qb * 256, t0, 24, 0.f, P_IN(16) + h * 465, h != hb, false, false, nullptr, nullptr, 0, (char*)lds); hb = h;
                }
#endif
                {
                const attn_body::bf16* P = (const attn_body::bf16*)P_WSB(WS_PROJ); attn_body::bf16* O = (attn_body::bf16*)P_WSB(WS_O);
                bool pre = false;
                for (int u = bx; u < 1024; u += G) {
                    const int h = u & 15, qb = u >> 4; const int t0 = min(max(qb * 4 - 4, 0), 244);
                    const int un = u + G; const bool hn = un < 1024; const int nh = un & 15, nqb = un >> 4, nt0 = min(max(nqb * 4 - 4, 0), 244);
                    attn_body::attn_unit<2, 8>(P + h * 64, P + 1024 + h * 64, P + 2048 + h * 64, O + h * 64, 3072, qb * 256, t0, 12, 0.f, P_IN(16) + h * 465, h != hb, pre, pre,
                                               hn ? P + 1024 + nh * 64 : nullptr, hn ? P + 2048 + nh * 64 : nullptr, nt0, (char*)lds); hb = h;
                    pre = hn;
                }
                }
            }
            GRID_BAR();
#ifndef NO_OUT
            {
                FRESH();
                u64* SUMQ = P_SUMQ; float* OUT = P_OUT; pg8::Gemm g{P_WSB(WS_O), (L == 0) ? P_WSB(WS_WOE) : P_WSB(WS_WOO), SEQ, DMODEL, DMODEL}; pg8::StaticOrder S; S.init(SEQ, DMODEL, G, bx);
                pg8::EpiRes<false> E{nullptr, P_WSB(WS_XB), SUMQ + (par ^ 1) * SEQ, 1.0f}; par ^= 1;
                pg8::gemm_phase<pg8::EpiRes<false>, pg8::StaticOrder, true, true>(ldsl, g, S, E);
            }
#endif
            GRID_BAR();
        }
    }
    {
        FRESH();
        const float* fg = P_IN(18); u64* SUMQ = P_SUMQ; float* OUT = P_OUT; const bf16* XB = P_WSB(WS_XB);
        f32x4 gv[4];
#pragma unroll
        for (int j = 0; j < 2; ++j) { gv[2 * j] = ((const GAS f32x4*)fg)[128 * j + 2 * lane]; gv[2 * j + 1] = ((const GAS f32x4*)fg)[128 * j + 2 * lane + 1]; }
        for (int m0 = gw; m0 < SEQ; m0 += 4 * NGW) {
            v4u w[4][2]; float sc[4];
#pragma unroll
            for (int q = 0; q < 4; ++q) { const int m = (m0 + q * NGW < SEQ) ? m0 + q * NGW : m0; sc[q] = pg8::row_scale(SUMQ + par * SEQ, m);
                const GAS v4u* xr = (const GAS v4u*)(XB + (size_t)m * DMODEL) + lane; w[q][0] = xr[0]; w[q][1] = xr[64]; }
#pragma unroll
            for (int q = 0; q < 4; ++q) { const int m = m0 + q * NGW; if (m < SEQ) {
                GAS f32x4* orow = (GAS f32x4*)(OUT + (size_t)m * DMODEL);
#pragma unroll
                for (int j = 0; j < 2; ++j) { const v4u ww = w[q][j];
                    const f32x4 a = {__builtin_bit_cast(float, ww.x << 16), __builtin_bit_cast(float, ww.x & 0xffff0000u), __builtin_bit_cast(float, ww.y << 16), __builtin_bit_cast(float, ww.y & 0xffff0000u)};
                    const f32x4 b = {__builtin_bit_cast(float, ww.z << 16), __builtin_bit_cast(float, ww.z & 0xffff0000u), __builtin_bit_cast(float, ww.w << 16), __builtin_bit_cast(float, ww.w & 0xffff0000u)};
                    orow[128 * j + 2 * lane] = a * sc[q] * gv[2 * j]; orow[128 * j + 2 * lane + 1] = b * sc[q] * gv[2 * j + 1]; } } }
        }
    }
}

extern "C" void kernel_launch(void* const* d_in, const int* in_sizes, int n_in, void* d_out, int out_size, void* d_ws, size_t ws_size, hipStream_t stream) {
    static int grid = 0;
    if (grid == 0) {
        if (n_in != 19 || out_size != SEQ * DMODEL || ws_size < WS_END) { fprintf(stderr, "kernel_launch: unexpected shapes (n_in %d, out %d, ws %zu < %zu)\n", n_in, out_size, ws_size, (size_t)WS_END); grid = -1; return; }
        int dev = 0, cus = 0, per_cu = 0;
        (void)hipGetDevice(&dev);
        (void)hipDeviceGetAttribute(&cus, hipDeviceAttributeMultiprocessorCount, dev);
        if (hipFuncSetAttribute((const void*)fwd_megakernel, hipFuncAttributeMaxDynamicSharedMemorySize, LDS_BYTES) != hipSuccess) { fprintf(stderr, "kernel_launch: hipFuncSetAttribute failed\n"); grid = -1; return; }
        if (hipOccupancyMaxActiveBlocksPerMultiprocessor(&per_cu, (const void*)fwd_megakernel, NWAVES * 64, LDS_BYTES) != hipSuccess || per_cu < 1) { fprintf(stderr, "kernel_launch: occupancy query failed (%d)\n", per_cu); (void)hipGetLastError(); per_cu = 1; }
        grid = cus * per_cu;
        fprintf(stderr, "kernel_launch: %d CUs x %d = grid %d\n", cus, per_cu, grid);
    }
    if (grid < 0) return;
    Args a{};
    for (int i = 0; i < 19; ++i) a.in[i] = (const float*)d_in[i];
    a.out = (float*)d_out; a.ws = (unsigned char*)d_ws;
    void* kargs[] = {&a};
    hipError_t e = hipLaunchCooperativeKernel((const void*)fwd_megakernel, dim3(grid), dim3(NWAVES * 64), kargs, LDS_BYTES, stream);
    if (e != hipSuccess) fprintf(stderr, "kernel_launch: cooperative launch failed: %s (grid %d)\n", hipGetErrorString(e), grid);
}
```

```cpp
#include <hip/hip_runtime.h>
#include <hip/hip_cooperative_groups.h>
#include <hip/hip_bf16.h>
#include <cstdio>
#include <cstdint>
#include <cmath>
namespace cg = cooperative_groups;

constexpr int SEQ = 16384, DMODEL = 1024, DFF = 2816, NGU = 2 * DFF;
constexpr float RMS_EPS = 1e-6f;
constexpr float LOG2E = 1.4426950408889634f;
constexpr float QSCALE = 0.125f * 1.4426950408889634f;

namespace pg8 {
#define PG8_LAS __attribute__((address_space(3)))
typedef unsigned short bf16_t;
typedef short bf16x8 __attribute__((ext_vector_type(8)));
typedef float f32x4 __attribute__((ext_vector_type(4)));
typedef unsigned u32x4 __attribute__((ext_vector_type(4)));
#define WT_RSRC(base) __builtin_amdgcn_make_buffer_rsrc((void*)(base), 0, 0x7fffffff, 0x00020000)
#define WT_STORE16(rsrc, byteoff, v) __builtin_amdgcn_raw_buffer_store_b128((v), (rsrc), (int)(byteoff), 0, 16)
constexpr int BM = 256, BK = 64, HALF = 128, HTB = HALF * BK * 2  , STAGE_BYTES = 8 * HTB, NXCD = 8, WGM = 8;

__host__ __device__ __forceinline__ int lds_byte(int r, int c) { const int st = (r >> 4) * 2 + (c >> 5), rr = r & 15, cc = c & 31, ob = rr * 64 + cc * 2; return st * 1024 + (ob ^ (((ob >> 9) & 1) << 5)); }
__host__ __device__ __forceinline__ void stage_rc(int b, int& R, int& C) { const int st = b / 1024, sb = b % 1024, swz = sb ^ (((sb >> 9) & 1) << 5); R = (st >> 1) * 16 + swz / 64; C = (st & 1) * 32 + (swz % 64) / 2; }
__host__ __device__ __forceinline__ int perm32(int rho) { const int n = rho >> 4, i = rho & 15; return 8 * (i >> 2) + 4 * n + (i & 3); }

struct Unit { int pm, pn; };
struct Gemm { const bf16_t* A; const bf16_t* Bt; int M, N, K; };

struct StaticOrder {
    int nM, nN, nwg, G, c;
    __host__ __device__ void init(int M, int N, int G_, int c_) { nM = M / BM; nN = N / BM; nwg = nM * nN; G = G_; c = c_; }
    __host__ __device__ bool next(int i, Unit& u) const {
        const long L = (long)i * G + c; if (L >= nwg) return false;
        int wgid = (int)L; { const int q = nwg / NXCD, r = nwg % NXCD, xcd = wgid % NXCD, off = wgid / NXCD; wgid = (xcd < r ? xcd * (q + 1) : r * (q + 1) + (xcd - r) * q) + off; }
        const int nig = WGM * nN, gid = wgid / nig, fm = gid * WGM, gsz = (nM - fm) < WGM ? (nM - fm) : WGM;
        u.pm = fm + ((wgid % nig) % gsz); u.pn = (wgid % nig) / gsz; return true;
    }
    __device__ __forceinline__ void a_ready(const Unit&) const {}
    __device__ __forceinline__ void done(const Unit&) const {}
};

__device__ __forceinline__ unsigned cvt_pk_bf16(float lo, float hi) { unsigned r; asm volatile("v_cvt_pk_bf16_f32 %0, %1, %2" : "=v"(r) : "v"(lo), "v"(hi)); return r; }
typedef unsigned long long u64;
__device__ __forceinline__ float row_scale(const u64* sq, unsigned row) {
    return __builtin_amdgcn_rsqf((float)sq[row] * (1.f / (1048576.f * 1024.f)) + 1e-6f);
}
constexpr int SCALE_LDS = 131072 + 1024;
__device__ __forceinline__ float silu_mul(float g, float u) { return g * u * __builtin_amdgcn_rcpf(1.f + __builtin_amdgcn_exp2f(-1.4426950408889634f * g)); }

struct EpiGU {
    static constexpr bool PERM = true, AFTER_DRAIN = false, HAS_PRE = true;
    bf16_t* ACT; const u64* sq; u64* sqz;
    __device__ __forceinline__ void pre_first(const Unit& u, PG8_LAS unsigned char* lds, int tid) const {
        if (tid < 256) ((PG8_LAS float*)(lds + SCALE_LDS))[tid] = row_scale(sq, u.pm * BM + tid);
    }
    __device__ __forceinline__ void operator()(const f32x4 (&acc)[2][2][4][2], const Unit& u, const Unit& nx, bool has_next, int par, PG8_LAS unsigned char* lds, int tid, int wr, int wc, int fr, int fq) const {
        u64 nsq = 0; const bool ld = has_next && tid < 256; if (ld) nsq = sq[nx.pm * BM + tid];
        const PG8_LAS float* sc = (const PG8_LAS float*)(lds + SCALE_LDS) + par * 256;
        const unsigned rl0 = wr * 64 + fr, row0 = u.pm * BM + rl0, col0 = u.pn * 128 + wc * 32 + 8 * fq; const auto rs_ = WT_RSRC(ACT);
        const bool zr = (u.pn == 0) && (wc == 0) && (fq == 0);
#pragma unroll
        for (int ai = 0; ai < 2; ++ai) {
#pragma unroll
            for (int m = 0; m < 4; ++m) { const unsigned row = row0 + ai * HALF + m * 16; const float s = sc[rl0 + ai * HALF + m * 16]; if (zr) sqz[row] = 0ull;
                const f32x4 g0 = acc[ai][0][m][0] * s, g1 = acc[ai][0][m][1] * s, u0 = acc[ai][1][m][0] * s, u1 = acc[ai][1][m][1] * s;
                u32x4 w; w.x = cvt_pk_bf16(silu_mul(g0[0], u0[0]), silu_mul(g0[1], u0[1])); w.y = cvt_pk_bf16(silu_mul(g0[2], u0[2]), silu_mul(g0[3], u0[3]));
                w.z = cvt_pk_bf16(silu_mul(g1[0], u1[0]), silu_mul(g1[1], u1[1])); w.w = cvt_pk_bf16(silu_mul(g1[2], u1[2]), silu_mul(g1[3], u1[3]));
                WT_STORE16(rs_, (row * 2816u + col0) * 2u, w); }
            __builtin_amdgcn_sched_barrier(0);
        }
        if (ld) ((PG8_LAS float*)(lds + SCALE_LDS))[(par ^ 1) * 256 + tid] = __builtin_amdgcn_rsqf((float)nsq * (1.f / (1048576.f * 1024.f)) + 1e-6f);
    }
};
template <bool F32IN> struct EpiRes {
    static constexpr bool PERM = true, AFTER_DRAIN = false, HAS_PRE = false;
    const float* in_f32; bf16_t* xb; u64* sqa; float alpha;
    __device__ __forceinline__ void finish(const f32x4& v0, const f32x4& v1, unsigned off, float& ss) const {
        u32x4 w; w.x = cvt_pk_bf16(v0[0], v0[1]); w.y = cvt_pk_bf16(v0[2], v0[3]); w.z = cvt_pk_bf16(v1[0], v1[1]); w.w = cvt_pk_bf16(v1[2], v1[3]);
        WT_STORE16(WT_RSRC(xb), off * 2u, w);
        ss += ((v0[0] * v0[0] + v0[1] * v0[1]) + (v0[2] * v0[2] + v0[3] * v0[3])) + ((v1[0] * v1[0] + v1[1] * v1[1]) + (v1[2] * v1[2] + v1[3] * v1[3]));
    }
    __device__ __forceinline__ void operator()(const f32x4 (&acc)[2][2][4][2], const Unit& u, int wr, int wc, int fr, int fq) const {
        const unsigned row0 = u.pm * BM + wr * 64 + fr, col0 = u.pn * BM + wc * 32 + 8 * fq;
        if constexpr (F32IN) {
#pragma unroll
            for (int ai = 0; ai < 2; ++ai)
#pragma unroll
                for (int mp = 0; mp < 2; ++mp) {
                    f32x4 o[2][2][2];
#pragma unroll
                    for (int mm = 0; mm < 2; ++mm)
#pragma unroll
                        for (int bj = 0; bj < 2; ++bj) { const unsigned off = (row0 + ai * HALF + (2 * mp + mm) * 16) * 1024u + col0 + bj * HALF;
                            o[mm][bj][0] = *(const f32x4*)(in_f32 + off); o[mm][bj][1] = *(const f32x4*)(in_f32 + (off + 4u)); }
#pragma unroll
                    for (int mm = 0; mm < 2; ++mm) { const int m = 2 * mp + mm; const unsigned row = row0 + ai * HALF + m * 16; float ss = 0.f;
#pragma unroll
                        for (int bj = 0; bj < 2; ++bj) finish(o[mm][bj][0] + acc[ai][bj][m][0] * alpha, o[mm][bj][1] + acc[ai][bj][m][1] * alpha, row * 1024u + col0 + bj * HALF, ss);
                        ss += __shfl_xor(ss, 16); ss += __shfl_xor(ss, 32);
                        if (fq == 0) atomicAdd(sqa + row, (u64)(ss * 1048576.f)); }
                    __builtin_amdgcn_sched_barrier(0);
                }
        } else {
            u32x4 t[2][4][2];
#pragma unroll
            for (int ai = 0; ai < 2; ++ai)
#pragma unroll
                for (int m = 0; m < 4; ++m)
#pragma unroll
                    for (int bj = 0; bj < 2; ++bj) t[ai][m][bj] = *(const u32x4*)(xb + ((row0 + ai * HALF + m * 16) * 1024u + col0 + bj * HALF));
            __builtin_amdgcn_sched_barrier(0);
#pragma unroll
            for (int ai = 0; ai < 2; ++ai) {
#pragma unroll
                for (int m = 0; m < 4; ++m) { const unsigned row = row0 + ai * HALF + m * 16; float ss = 0.f;
#pragma unroll
                    for (int bj = 0; bj < 2; ++bj) { const u32x4 w0 = t[ai][m][bj];
                        const f32x4 o0 = {__builtin_bit_cast(float, w0.x << 16), __builtin_bit_cast(float, w0.x & 0xffff0000u), __builtin_bit_cast(float, w0.y << 16), __builtin_bit_cast(float, w0.y & 0xffff0000u)};
                        const f32x4 o1 = {__builtin_bit_cast(float, w0.z << 16), __builtin_bit_cast(float, w0.z & 0xffff0000u), __builtin_bit_cast(float, w0.w << 16), __builtin_bit_cast(float, w0.w & 0xffff0000u)};
                        finish(o0 + acc[ai][bj][m][0] * alpha, o1 + acc[ai][bj][m][1] * alpha, row * 1024u + col0 + bj * HALF, ss); }
                    ss += __shfl_xor(ss, 16); ss += __shfl_xor(ss, 32);
                    if (fq == 0) atomicAdd(sqa + row, (u64)(ss * 1048576.f)); }
                __builtin_amdgcn_sched_barrier(0);
            }
        }
    }
};
struct EpiNull {
    static constexpr bool PERM = true, AFTER_DRAIN = false, HAS_PRE = false;
    float* sink;
    __device__ __forceinline__ void operator()(const f32x4 (&acc)[2][2][4][2], const Unit& u, int wr, int wc, int fr, int fq) const {
        float s = 0.f;
#pragma unroll
        for (int a = 0; a < 2; ++a)
#pragma unroll
            for (int b = 0; b < 2; ++b)
#pragma unroll
                for (int m = 0; m < 4; ++m)
#pragma unroll
                    for (int n = 0; n < 2; ++n) s += acc[a][b][m][n][0] + acc[a][b][m][n][1] + acc[a][b][m][n][2] + acc[a][b][m][n][3];
        if (s == 123.456f) sink[0] = s;
    }
};
struct EpiProj {
    static constexpr bool PERM = true, AFTER_DRAIN = false, HAS_PRE = true;
    bf16_t* O; unsigned ldc; const u64* sq; u64* sqz; int qcols; float qscale;
    __device__ __forceinline__ void pre_first(const Unit& u, PG8_LAS unsigned char* lds, int tid) const {
        if (tid < 256) ((PG8_LAS float*)(lds + SCALE_LDS))[tid] = row_scale(sq, u.pm * BM + tid);
    }
    __device__ __forceinline__ void operator()(const f32x4 (&acc)[2][2][4][2], const Unit& u, const Unit& nx, bool has_next, int par, PG8_LAS unsigned char* lds, int tid, int wr, int wc, int fr, int fq) const {
        u64 nsq = 0; const bool ld = has_next && tid < 256; if (ld) nsq = sq[nx.pm * BM + tid];
        const PG8_LAS float* sc = (const PG8_LAS float*)(lds + SCALE_LDS) + par * 256;
        const unsigned rl0 = wr * 64 + fr, row0 = u.pm * BM + rl0, col0 = u.pn * BM + wc * 32 + 8 * fq; const auto rs_ = WT_RSRC(O);
        const float cs = (u.pn * BM < qcols) ? qscale : 1.f;
        const bool zr = (u.pn == 0) && (wc == 0) && (fq == 0);
#pragma unroll
        for (int ai = 0; ai < 2; ++ai) {
#pragma unroll
            for (int m = 0; m < 4; ++m) { const unsigned row = row0 + ai * HALF + m * 16; const float s = sc[rl0 + ai * HALF + m * 16] * cs; if (zr) sqz[row] = 0ull;
#pragma unroll
                for (int bj = 0; bj < 2; ++bj) { const f32x4 v0 = acc[ai][bj][m][0] * s, v1 = acc[ai][bj][m][1] * s;
                    u32x4 w; w.x = cvt_pk_bf16(v0[0], v0[1]); w.y = cvt_pk_bf16(v0[2], v0[3]); w.z = cvt_pk_bf16(v1[0], v1[1]); w.w = cvt_pk_bf16(v1[2], v1[3]);
                    WT_STORE16(rs_, (row * ldc + col0 + bj * HALF) * 2u, w); } }
            __builtin_amdgcn_sched_barrier(0);
        }
        if (ld) ((PG8_LAS float*)(lds + SCALE_LDS))[(par ^ 1) * 256 + tid] = __builtin_amdgcn_rsqf((float)nsq * (1.f / (1048576.f * 1024.f)) + 1e-6f);
    }
};
template <class Epi, class Sched, bool ALIGN_EPI = false, bool SP2 = false>
__device__ __forceinline__ void gemm_phase(PG8_LAS unsigned char* lds, Gemm g, const Sched& S, const Epi& E) {
    asm volatile("" : "+s"(g.A), "+s"(g.Bt));
    int tid = threadIdx.x; asm volatile("" : "+v"(tid));
    const int wid = __builtin_amdgcn_readfirstlane(tid >> 6), lane = tid & 63, wr = wid >> 2, wc = wid & 3, fr = lane & 15, fq = lane >> 4;
    const int K = g.K, nt = K / BK;
    unsigned voffA[2], voffB[2];
#pragma unroll
    for (int i = 0; i < 2; ++i) { int R, C; stage_rc(tid * 16 + i * 8192, R, C); const int Rb = Epi::PERM ? ((R & ~31) + perm32(R & 31)) : R;
        voffA[i] = (unsigned)(R * K + C) * 2u; voffB[i] = (unsigned)(Rb * K + C) * 2u; }
    const size_t kstep = (size_t)(BK * 2);
    const size_t hstep = (size_t)HALF * K * 2;
    const size_t tstep = 2 * hstep;
    const unsigned ldsw = (unsigned)wid * 1024u;
    const int aoff = lds_byte(wr * 64 + fr, fq * 8), boff = lds_byte(wc * 32 + fr, fq * 8);
#define PG8_SA(b, h) (((b) * 2 + (h)) * HTB)
#define PG8_SB(b, h) ((4 + (b) * 2 + (h)) * HTB)
#define PG8_STAGE(bufoff, gbase, voff) do { _Pragma("unroll") for (int _i = 0; _i < 2; ++_i) \
        __builtin_amdgcn_global_load_lds((const unsigned*)((const char*)(gbase) + (voff)[_i]), (PG8_LAS unsigned*)(lds + (bufoff) + ldsw + _i * 8192), 16, 0, 0); } while (0)
#define PG8_LDA(dst, b, h) do { _Pragma("unroll") for (int m = 0; m < 4; ++m) _Pragma("unroll") for (int k = 0; k < 2; ++k) dst[m][k] = *(const PG8_LAS bf16x8*)(lds + PG8_SA(b, h) + aoff + m * 2048 + k * 1024); } while (0)
#define PG8_LDB(dst, b, h) do { _Pragma("unroll") for (int n = 0; n < 2; ++n) _Pragma("unroll") for (int k = 0; k < 2; ++k) dst[n][k] = *(const PG8_LAS bf16x8*)(lds + PG8_SB(b, h) + boff + n * 2048 + k * 1024); } while (0)
#define PG8_MMA(ai, bj, At, Bt) do { __builtin_amdgcn_s_setprio(1); _Pragma("unroll") for (int m = 0; m < 4; ++m) _Pragma("unroll") for (int n = 0; n < 2; ++n) _Pragma("unroll") for (int k = 0; k < 2; ++k) \
        acc[ai][bj][m][n] = __builtin_amdgcn_mfma_f32_16x16x32_bf16(Bt[n][k], At[m][k], acc[ai][bj][m][n], 0, 0, 0); __builtin_amdgcn_s_setprio(0); } while (0)
#define PG8_WAIT_V(n) asm volatile("s_waitcnt vmcnt(" #n ")" ::: "memory")
#define PG8_WAIT_L(n) asm volatile("s_waitcnt lgkmcnt(" #n ")" ::: "memory")
#define PG8_BAR __builtin_amdgcn_s_barrier()
#define PG8_SCHED __builtin_amdgcn_sched_barrier(0)
    Unit cur, nxt; int ui = 0;
    if (!S.next(0, cur)) return;
    f32x4 acc[2][2][4][2];
#pragma unroll
    for (int a = 0; a < 2; ++a)
#pragma unroll
        for (int b = 0; b < 2; ++b)
#pragma unroll
            for (int m = 0; m < 4; ++m)
#pragma unroll
                for (int n = 0; n < 2; ++n) acc[a][b][m][n] = (f32x4){0.f, 0.f, 0.f, 0.f};
    bf16x8 At[4][2], B0[2][2], B1[2][2];
    const char* cA = (const char*)g.A + (size_t)cur.pm * tstep; const char* cB = (const char*)g.Bt + (size_t)cur.pn * tstep;
    S.a_ready(cur);
    if constexpr (Epi::HAS_PRE) E.pre_first(cur, lds, tid);
    if constexpr (SP2) {
        PG8_STAGE(PG8_SB(0, 0), cB, voffB); PG8_STAGE(PG8_SB(0, 1), cB + hstep, voffB); PG8_STAGE(PG8_SA(0, 0), cA, voffA); PG8_STAGE(PG8_SA(0, 1), cA + hstep, voffA);
        if (wr == 1) PG8_BAR;
        PG8_WAIT_V(2); PG8_BAR;
        PG8_STAGE(PG8_SB(1, 0), cB + kstep, voffB); PG8_STAGE(PG8_SA(1, 0), cA + kstep, voffA); PG8_STAGE(PG8_SB(1, 1), cB + hstep + kstep, voffB);
        PG8_WAIT_V(6); PG8_BAR;
    } else {
        PG8_STAGE(PG8_SB(0, 0), cB, voffB); PG8_STAGE(PG8_SA(0, 0), cA, voffA); PG8_STAGE(PG8_SB(0, 1), cB + hstep, voffB); PG8_STAGE(PG8_SA(0, 1), cA + hstep, voffA);
        if (wr == 1) PG8_BAR;
        PG8_WAIT_V(4); PG8_BAR;
        PG8_STAGE(PG8_SB(1, 0), cB + kstep, voffB); PG8_STAGE(PG8_SA(1, 0), cA + kstep, voffA); PG8_STAGE(PG8_SB(1, 1), cB + hstep + kstep, voffB);
        PG8_WAIT_V(6); PG8_BAR;
    }
    for (;;) {
        const bool has_next = S.next(ui + 1, nxt);
        const char* nA = has_next ? (const char*)g.A + (size_t)nxt.pm * tstep : cA; const char* nB = has_next ? (const char*)g.Bt + (size_t)nxt.pn * tstep : cB;
        for (int t = 0; t < nt; t += 2) {
            const bool last = (t == nt - 2);
            const char* a1 = cA + (size_t)(t + 1) * kstep;
            const char* a2 = last ? nA : cA + (size_t)(t + 2) * kstep; const char* b2 = last ? nB : cB + (size_t)(t + 2) * kstep;
            const char* a3 = a2 + kstep; const char* b3 = b2 + kstep;
            if (last && has_next) S.a_ready(nxt);
            if constexpr (SP2) {
            PG8_LDB(B0, 0, 0); PG8_LDB(B1, 0, 1); PG8_SCHED; PG8_LDA(At, 0, 0); PG8_STAGE(PG8_SA(1, 1), a1 + hstep, voffA);
            PG8_WAIT_V(8); PG8_WAIT_L(0); PG8_BAR; PG8_MMA(0, 0, At, B0); PG8_MMA(0, 1, At, B1); PG8_BAR; PG8_SCHED;
            PG8_LDA(At, 0, 1); PG8_STAGE(PG8_SB(0, 0), b2, voffB); PG8_STAGE(PG8_SB(0, 1), b2 + hstep, voffB); PG8_STAGE(PG8_SA(0, 0), a2, voffA);
            PG8_WAIT_V(8); PG8_WAIT_L(0); PG8_BAR; PG8_MMA(1, 0, At, B0); PG8_MMA(1, 1, At, B1); PG8_BAR; PG8_SCHED;
            PG8_LDB(B0, 1, 0); PG8_LDB(B1, 1, 1); PG8_SCHED; PG8_LDA(At, 1, 0); PG8_STAGE(PG8_SA(0, 1), a2 + hstep, voffA);
            PG8_WAIT_V(8); PG8_WAIT_L(0); PG8_BAR; PG8_MMA(0, 0, At, B0); PG8_MMA(0, 1, At, B1); PG8_BAR; PG8_SCHED;
            PG8_LDA(At, 1, 1); PG8_STAGE(PG8_SB(1, 0), b3, voffB); PG8_STAGE(PG8_SB(1, 1), b3 + hstep, voffB); PG8_STAGE(PG8_SA(1, 0), a3, voffA);
            PG8_WAIT_V(8); PG8_WAIT_L(0); PG8_BAR; PG8_MMA(1, 0, At, B0); PG8_MMA(1, 1, At, B1); PG8_BAR; PG8_SCHED;
            } else {
            PG8_LDB(B0, 0, 0); PG8_SCHED; PG8_LDA(At, 0, 0); PG8_STAGE(PG8_SA(1, 1), a1 + hstep, voffA);
            PG8_WAIT_L(8); PG8_BAR; PG8_WAIT_L(0); PG8_MMA(0, 0, At, B0); PG8_BAR; PG8_SCHED;
            PG8_LDB(B1, 0, 1); PG8_STAGE(PG8_SB(0, 0), b2, voffB);
            PG8_BAR; PG8_WAIT_L(0); PG8_MMA(0, 1, At, B1); PG8_BAR;
            PG8_LDA(At, 0, 1); PG8_STAGE(PG8_SA(0, 0), a2, voffA);
            PG8_BAR; PG8_WAIT_L(0); PG8_MMA(1, 0, At, B0); PG8_BAR; PG8_SCHED;
            PG8_STAGE(PG8_SB(0, 1), b2 + hstep, voffB);
            PG8_WAIT_V(6); PG8_BAR; PG8_MMA(1, 1, At, B1); PG8_BAR;
            PG8_LDB(B0, 1, 0); PG8_SCHED; PG8_LDA(At, 1, 0); PG8_STAGE(PG8_SA(0, 1), a2 + hstep, voffA);
            PG8_WAIT_L(8); PG8_BAR; PG8_WAIT_L(0); PG8_MMA(0, 0, At, B0); PG8_BAR; PG8_SCHED;
            PG8_LDB(B1, 1, 1); PG8_STAGE(PG8_SB(1, 0), b3, voffB);
            PG8_BAR; PG8_WAIT_L(0); PG8_MMA(0, 1, At, B1); PG8_BAR;
            PG8_LDA(At, 1, 1); PG8_STAGE(PG8_SA(1, 0), a3, voffA);
            PG8_BAR; PG8_WAIT_L(0); PG8_MMA(1, 0, At, B0); PG8_BAR; PG8_SCHED;
            PG8_STAGE(PG8_SB(1, 1), b3 + hstep, voffB);
            PG8_WAIT_V(6); PG8_BAR; PG8_MMA(1, 1, At, B1); PG8_BAR;
            }
        }
        if constexpr (ALIGN_EPI) { if (wr == 0) PG8_BAR; }
        if constexpr (Epi::HAS_PRE) { E(acc, cur, nxt, has_next, ui & 1, lds, tid, wr, wc, fr, fq); S.done(cur); }
        else if constexpr (!Epi::AFTER_DRAIN) { E(acc, cur, wr, wc, fr, fq); S.done(cur); }
        if (!has_next) break;
#pragma unroll
        for (int a = 0; a < 2; ++a)
#pragma unroll
            for (int b = 0; b < 2; ++b)
#pragma unroll
                for (int m = 0; m < 4; ++m)
#pragma unroll
                    for (int n = 0; n < 2; ++n) acc[a][b][m][n] = (f32x4){0.f, 0.f, 0.f, 0.f};
        cur = nxt; cA = nA; cB = nB; ++ui;
        if constexpr (ALIGN_EPI) { if (wr == 1) PG8_BAR; }
    }
    PG8_WAIT_V(0);
    if constexpr (!ALIGN_EPI) { if (wr == 0) PG8_BAR; }
    PG8_BAR;
    if constexpr (Epi::AFTER_DRAIN) { E.fused(acc, cur, wr, wc, fr, fq, lds, wid, lane); S.done(cur); }
#undef PG8_SA
#undef PG8_SB
#undef PG8_STAGE
#undef PG8_LDA
#undef PG8_LDB
#undef PG8_MMA
#undef PG8_WAIT_V
#undef PG8_WAIT_L
#undef PG8_BAR
#undef PG8_SCHED
}
}
namespace attn_body {
using bf16=__hip_bfloat16;
using bf16x8=__attribute__((ext_vector_type(8)))short;
using s16x4=__attribute__((ext_vector_type(4)))short;
using f32x16=__attribute__((ext_vector_type(16)))float;
using u32x4=__attribute__((ext_vector_type(4)))unsigned;
constexpr int BATCH=2,NHEAD=16,SEQ=8192,D=64,DM=NHEAD*D;
constexpr int NW=8,QBLK=32,QB=QBLK*NW,KVBLK=64,NQB=SEQ/QB;
constexpr int ATTN_PITCH=DM, ATTN_UNIT_ROWS=QB;
__device__ __forceinline__ int crow(int r,int hi){return (r&3)+8*(r>>2)+4*hi;}
#define SBAR() __builtin_amdgcn_sched_barrier(0)
constexpr int NSLOT=3, SLOTB=8192;
constexpr int LDS_K=0, LDS_V=NSLOT*SLOTB, LDS_WS=2*NSLOT*SLOTB, LDS_OST=LDS_WS+NW*64*4, LDS_BYTES=LDS_OST+NW*4096;
constexpr float C2=0.125f*1.4426950408889634f;
__device__ __forceinline__ void glds16(const void*gsrc,unsigned lds_dst){unsigned keep;
  asm volatile("s_mov_b32 %0, m0\n\ts_mov_b32 m0, %2\n\ts_nop 0\n\tglobal_load_lds_dwordx4 %1, off\n\ts_mov_b32 m0, %0":"=&s"(keep):"v"(gsrc),"s"(lds_dst):"memory");}
__device__ __forceinline__ float max3f(float a,float b,float c){float r;asm("v_max3_f32 %0, %1, %2, %3":"=v"(r):"v"(a),"v"(b),"v"(c));return r;}
__device__ __forceinline__ float max2f(float a,float b){float r;asm("v_max_f32_e32 %0, %1, %2":"=v"(r):"v"(a),"v"(b));return r;}
__device__ __forceinline__ float fadd_s(float a,float b){float r;asm("v_add_f32_e32 %0, %1, %2":"=v"(r):"v"(a),"v"(b));return r;}
__device__ __forceinline__ float fsub_s(float a,float b){float r;asm("v_sub_f32_e32 %0, %1, %2":"=v"(r):"v"(a),"v"(b));return r;}
typedef float f32x2_t __attribute__((ext_vector_type(2))); typedef __bf16 bf16x2_t __attribute__((ext_vector_type(2)));
__device__ __forceinline__ unsigned cvtpk_s(float lo,float hi){f32x2_t v={lo,hi};bf16x2_t b=__builtin_convertvector(v,bf16x2_t);return __builtin_bit_cast(unsigned,b);}
#define WAIT_BAR(N) asm volatile("s_waitcnt vmcnt(" #N ") lgkmcnt(0)\n\ts_barrier":::"memory")

__device__ __forceinline__ void qkt(f32x16&p0,f32x16&p1,const char*Kslot,const bf16x8*qr,const f32x16&negm,int r32,int hi){
  const char*kb=Kslot+hi*1024+r32*16;
  #pragma unroll
  for(int d0=0;d0<4;++d0){
    const bf16x8 b0=*reinterpret_cast<const bf16x8*>(kb+d0*2048);
    const bf16x8 b1=*reinterpret_cast<const bf16x8*>(kb+d0*2048+512);
    if(d0==0){p0=__builtin_amdgcn_mfma_f32_32x32x16_bf16(b0,qr[0],negm,0,0,0);p1=__builtin_amdgcn_mfma_f32_32x32x16_bf16(b1,qr[0],negm,0,0,0);}
    else{p0=__builtin_amdgcn_mfma_f32_32x32x16_bf16(b0,qr[d0],p0,0,0,0);p1=__builtin_amdgcn_mfma_f32_32x32x16_bf16(b1,qr[d0],p1,0,0,0);}}
}
typedef __attribute__((address_space(3))) const char* lds_cptr;
typedef short v4i16_t __attribute__((ext_vector_type(4)));
__device__ __forceinline__ void kload8(bf16x8*kf,lds_cptr kp){
  kf[0]=*(const __attribute__((address_space(3))) bf16x8*)(kp);      kf[1]=*(const __attribute__((address_space(3))) bf16x8*)(kp+512);
  kf[2]=*(const __attribute__((address_space(3))) bf16x8*)(kp+2048); kf[3]=*(const __attribute__((address_space(3))) bf16x8*)(kp+2560);
  kf[4]=*(const __attribute__((address_space(3))) bf16x8*)(kp+4096); kf[5]=*(const __attribute__((address_space(3))) bf16x8*)(kp+4608);
  kf[6]=*(const __attribute__((address_space(3))) bf16x8*)(kp+6144); kf[7]=*(const __attribute__((address_space(3))) bf16x8*)(kp+6656);
}
__device__ __forceinline__ void kload2(bf16x8*kf,lds_cptr kp,int j){ kf[2*j]=*(const __attribute__((address_space(3))) bf16x8*)(kp+j*2048); kf[2*j+1]=*(const __attribute__((address_space(3))) bf16x8*)(kp+j*2048+512); }
__device__ __forceinline__ s16x4 vtr(lds_cptr p){ return __builtin_bit_cast(s16x4,__builtin_amdgcn_ds_read_tr16_b64_v4i16((__attribute__((address_space(3))) v4i16_t*)p)); }
__device__ __forceinline__ float rowmax(const f32x16&p0,const f32x16&p1){
  float a=max3f(p0[0],p0[1],p1[0]),b=max3f(p0[2],p0[3],p1[1]);a=max3f(a,p1[2],p1[3]);
  #pragma unroll
  for(int r=4;r<16;r+=4){a=max3f(a,p0[r],p0[r+1]);b=max3f(b,p0[r+2],p0[r+3]);a=max3f(a,p1[r],p1[r+1]);b=max3f(b,p1[r+2],p1[r+3]);}
  const float m=max2f(a,b);
  auto rr=__builtin_amdgcn_permlane32_swap(__float_as_uint(m),__float_as_uint(m),false,false);
  return max2f(__uint_as_float(rr[0]),__uint_as_float(rr[1]));
}
__device__ __forceinline__ void pv(f32x16*o,int vb,bf16x8 pa0,bf16x8 pa1,bf16x8 pa2,bf16x8 pa3){
  #pragma unroll
  for(int d0=0;d0<2;++d0){s16x4 lo[4],hi[4];
    #pragma unroll
    for(int ks=0;ks<4;++ks){
      asm volatile("ds_read_b64_tr_b16 %0,%1 offset:%c2":"=&v"(lo[ks]):"v"(vb),"i"(d0*4096+ks*1024):"memory");
      asm volatile("ds_read_b64_tr_b16 %0,%1 offset:%c2":"=&v"(hi[ks]):"v"(vb),"i"(d0*4096+ks*1024+512):"memory");}
    asm volatile("s_waitcnt lgkmcnt(0)":::"memory");SBAR();
    #define PK(k) (bf16x8){lo[k][0],lo[k][1],lo[k][2],lo[k][3],hi[k][0],hi[k][1],hi[k][2],hi[k][3]}
    o[d0]=__builtin_amdgcn_mfma_f32_32x32x16_bf16(pa0,PK(0),o[d0],0,0,0);
    o[d0]=__builtin_amdgcn_mfma_f32_32x32x16_bf16(pa1,PK(1),o[d0],0,0,0);
    o[d0]=__builtin_amdgcn_mfma_f32_32x32x16_bf16(pa2,PK(2),o[d0],0,0,0);
    o[d0]=__builtin_amdgcn_mfma_f32_32x32x16_bf16(pa3,PK(3),o[d0],0,0,0);
    #undef PK
  }
}
constexpr int NA_DR=656, NA_TAB=15*NA_DR;
constexpr int LDS_BIAS=LDS_BYTES+1024, ATTN_LDS_TOTAL=LDS_BIAS+NA_TAB*4+2048;
constexpr int OPITCH=1024;
typedef __attribute__((address_space(3))) float* lds_fptr;
template<int MODE> __device__ __forceinline__ void amask(f32x16&p0,f32x16&p1,const int kt,const int qpos,const int hi,lds_fptr bias,const int tb0,const int tb1,const int qrow){
  if(MODE==1){
    const int kb=kt*64+4*hi, lo=qpos-128, hq=qpos+128;
    #pragma unroll
    for(int r=0;r<16;++r){const int kv=kb+(r&3)+8*(r>>2); if(kv<lo||kv>hq)p0[r]=-INFINITY; if(kv+32<lo||kv+32>hq)p1[r]=-INFINITY;}
  }
  if(MODE==2){
    const int rs=min(max(qrow-4,0),248);
    if(kt<rs||kt>=rs+8){
      #pragma unroll
      for(int r=0;r<16;++r){p0[r]=-INFINITY;p1[r]=-INFINITY;}
    } else {
      const int dr=kt-qrow+7; lds_fptr b0=bias+dr*NA_DR+tb0, b1=bias+dr*NA_DR+tb1;
      #pragma unroll
      for(int r=0;r<16;++r){const int o=(r&3)+8*(r>>2); p0[r]+=b0[o]; p1[r]+=b1[o];}
    }
  }
}
#define ATTN_STORE16(base,byteoff,v) __builtin_amdgcn_raw_buffer_store_b128((v), __builtin_amdgcn_make_buffer_rsrc((void*)(base), 0, 0x7fffffff, 0x00020000), (int)(byteoff), 0, 16)
template<int MODE,int THRL> __device__ __forceinline__ void attn_unit(const bf16*Qh,const bf16*__restrict__ Kh,const bf16*__restrict__ Vh,bf16*Oh,const int DM,const int q0,const int tile0,const int NT,const float sink_l2,const float*biasg,const bool build,const bool pre,const bool preV,const bf16*nKh,const bf16*nVh,const int ntile0,char*shm){
  int tid=threadIdx.x; asm volatile("":"+v"(tid)); const int lane=tid&63,r32=lane&31,hi=lane>>5; const int wid=__builtin_amdgcn_readfirstlane(tid>>6);
  const bf16*Qw=Qh+(long)(q0+wid*QBLK)*DM;
  const unsigned lds0=(unsigned)(uintptr_t)shm;
  float*wsf=(float*)(shm+LDS_WS)+wid*64;
  const bf16*ksrc=Kh+(long)(tile0*KVBLK+lane)*DM+wid*8;
  const bf16*vsrc=Vh+(long)(tile0*KVBLK+16*(wid&3)+(lane>>2))*DM+(wid>>2)*32+(lane&3)*8;
  const unsigned kdst=lds0+LDS_K+wid*1024, vdst=lds0+LDS_V+wid*1024;
  #define DMA_K(t,slot) glds16(ksrc+(long)(t)*KVBLK*DM,(unsigned)__builtin_amdgcn_readfirstlane(kdst+(slot)))
  #define DMA_V(t,slot) glds16(vsrc+(long)(t)*KVBLK*DM,(unsigned)__builtin_amdgcn_readfirstlane(vdst+(slot)))
  const int vb0=(int)(lds0+LDS_V)+((lane>>4)&1)*32+(lane&3)*8+(4*hi+((lane&15)>>2))*64;
  const char*Kbase=shm+LDS_K; bf16x8 kf[8];
  const lds_cptr shm3=(lds_cptr)shm; const lds_cptr kp0=shm3+LDS_K+hi*1024+r32*16; const lds_cptr vp0=shm3+LDS_V+((lane>>4)&1)*32+(lane&3)*8+(4*hi+((lane&15)>>2))*64;
  lds_fptr biasl=(lds_fptr)((lds_cptr)shm+LDS_BIAS);
  if(MODE==2&&build){
    lds_fptr stg=biasl+NA_TAB; if(tid<465) stg[tid]=biasg[tid]*1.4426950408889634f;
    asm volatile("s_waitcnt vmcnt(0) lgkmcnt(0)\n\ts_barrier":::"memory");
    for(int e=tid;e<NA_TAB;e+=512){ const int dr=e/NA_DR, w=e-dr*NA_DR; int idx=-1;
      if(w<112){ if(w>=48&&w<64) idx=w-41; } else if(w<144){ } else if(w<400){ const int q=(w-144)>>5, kc=(w-144)&31; if(kc<16) idx=kc-q+15; } else { const int q=(w-400)>>5, j=(w-400)&31; if(j>=16) idx=j-q-9; }
      biasl[e]=(idx>=0)?stg[dr*31+idx]:-INFINITY; } }
  if(!pre){DMA_K(0,0);} if(!preV){DMA_V(0,0);} if(!pre){DMA_K(1,SLOTB);}
  bf16x8 qr[4];
  #pragma unroll
  for(int d0=0;d0<4;++d0)qr[d0]=*reinterpret_cast<const bf16x8*>(&Qw[(long)r32*DM+d0*16+hi*8]);
  float mhat=0.f,l_reg=0.f;f32x16 o[2];o[0]=f32x16{};o[1]=f32x16{};f32x16 negm=f32x16{};asm volatile("":"+v"(negm));
  const int qpos=q0+wid*QBLK+r32; const int qrow=(q0>>6)+(wid>>1);
  int tb0=0,tb1=0; if(MODE==2){ const int qc=qpos&63; if(qc<8){tb0=144+qc*32;tb1=112;} else if(qc>=56){tb0=112;tb1=400+(qc-56)*32;} else {tb0=56-qc;tb1=tb0+32;} tb0+=4*hi;tb1+=4*hi; }
  #define CMASK(P0,P1,t) amask<MODE>(P0,P1,tile0+(t),qpos,hi,biasl,tb0,tb1,qrow)
  bool resc=false;
  #define START(P0,P1) do{ const float rm=rowmax(P0,P1); resc=false; \
    { const float dl=(MODE==0)?rm:__builtin_fmaxf(rm,-64.f); mhat=fadd_s(mhat,dl); \
      _Pragma("unroll") for(int r=0;r<16;++r){P0[r]=fsub_s(P0[r],dl);P1[r]=fsub_s(P1[r],dl);} \
      _Pragma("unroll") for(int r=0;r<16;++r)negm[r]=-mhat; asm volatile("":"+v"(negm)); } \
    _Pragma("unroll") for(int r=0;r<16;++r)P0[r]=__builtin_amdgcn_exp2f(P0[r]); }while(0)
  #define RESC() do{ if(resc){ asm volatile("s_waitcnt lgkmcnt(0)":::"memory"); \
      _Pragma("unroll") for(int d_=0;d_<2;++d_) _Pragma("unroll") for(int r=0;r<16;++r)o[d_][r]*=wsf[crow(r,hi)]; } }while(0)
  f32x16 pA0,pA1,pB0,pB1;
  int sl_prev=0,sl_cur=0,sl_next=SLOTB;
  #define ROT() do{sl_prev=sl_cur;sl_cur=sl_next;sl_next=(sl_next==(NSLOT-1)*SLOTB)?0:sl_next+SLOTB;}while(0)
  DMA_K(2,2*SLOTB);
  WAIT_BAR(3);
  qkt(pA0,pA1,Kbase,qr,negm,r32,hi);asm volatile("s_nop 15\n\ts_nop 7":"+v"(pA0),"+v"(pA1));CMASK(pA0,pA1,0);
  START(pA0,pA1);
  _Pragma("unroll") for(int r=0;r<16;++r)pA1[r]=__builtin_amdgcn_exp2f(pA1[r]);
  WAIT_BAR(0);
  DMA_K(3,0);DMA_V(1,SLOTB);
  ROT();
  kload8(kf,kp0+sl_cur);
  WAIT_BAR(2);
  s16x4 vlo[8],vhi[8]; u32x4 pw0,pw1,pw2,pw3;
  #define PKW(P,B) cvtpk_s(P[B],P[B+1])
  #define PAF(k) __builtin_bit_cast(bf16x8,pw##k)
  #define VFR(i) (bf16x8){vlo[i][0],vlo[i][1],vlo[i][2],vlo[i][3],vhi[i][0],vhi[i][1],vhi[i][2],vhi[i][3]}
  #define PIN(x) asm volatile("":"+v"(x))
  #define MX3(a,b,c) __builtin_fmaxf(__builtin_fmaxf((a),(b)),(c))
  #define GAPA(MF,A0,A1,A2,A3,W0,W1,PW) do{ MF; sacc+=A0; sacc+=A1; sacc+=A2; sacc+=A3; PIN(sacc); W0; W1; PIN(PW); SBAR(); }while(0)
  #define EX(v) __builtin_amdgcn_exp2f(v)
  #define GAPB(MF,X,B) do{ MF; X[B]=EX(X[B]); X[B+1]=EX(X[B+1]); X[B+2]=EX(X[B+2]); X[B+3]=EX(X[B+3]); PIN(X); SBAR(); }while(0)
  #define VRD(i) do{ vlo[i]=vtr(vp_+(((i)>>2)*4096+((i)&3)*1024)); vhi[i]=vtr(vp_+(((i)>>2)*4096+((i)&3)*1024+512)); }while(0)
  #define KRD(G,j) do{ if(G){ kload2(kf,kp0+sl_next,j); SBAR(); } }while(0)
  #define STEP(C0,C1,P0,P1,t,GK,GV,GL) do{ SBAR(); \
    const lds_cptr vp_=vp0+sl_prev; \
    VRD(0); SBAR(); float sacc=(P0[0]+P0[1]); \
    GAPA(C0=__builtin_amdgcn_mfma_f32_32x32x16_bf16(kf[0],qr[0],negm,0,0,0), P0[2],P0[3],P0[4],P0[5],     pw0[0]=PKW(P0,0), pw0[1]=PKW(P0,2), pw0); \
    VRD(4); SBAR(); GAPA(C1=__builtin_amdgcn_mfma_f32_32x32x16_bf16(kf[1],qr[0],negm,0,0,0), P0[6],P0[7],P0[8],P0[9],     pw0[2]=PKW(P0,4), pw0[3]=PKW(P0,6), pw0); \
    VRD(1); SBAR(); GAPA(C0=__builtin_amdgcn_mfma_f32_32x32x16_bf16(kf[2],qr[1],C0,0,0,0),   P0[10],P0[11],P0[12],P0[13], pw1[0]=PKW(P0,8), pw1[1]=PKW(P0,10), pw1); \
    VRD(5); SBAR(); GAPA(C1=__builtin_amdgcn_mfma_f32_32x32x16_bf16(kf[3],qr[1],C1,0,0,0),   P0[14],P0[15],P1[0],P1[1],   pw1[2]=PKW(P0,12),pw1[3]=PKW(P0,14), pw1); \
    VRD(2); SBAR(); GAPA(C0=__builtin_amdgcn_mfma_f32_32x32x16_bf16(kf[4],qr[2],C0,0,0,0),   P1[2],P1[3],P1[4],P1[5],     pw2[0]=PKW(P1,0), pw2[1]=PKW(P1,2), pw2); \
    VRD(6); SBAR(); GAPA(C1=__builtin_amdgcn_mfma_f32_32x32x16_bf16(kf[5],qr[2],C1,0,0,0),   P1[6],P1[7],P1[8],P1[9],     pw2[2]=PKW(P1,4), pw2[3]=PKW(P1,6), pw2); \
    VRD(3); SBAR(); GAPA(C0=__builtin_amdgcn_mfma_f32_32x32x16_bf16(kf[6],qr[3],C0,0,0,0),   P1[10],P1[11],P1[12],P1[13], pw3[0]=PKW(P1,8), pw3[1]=PKW(P1,10), pw3); \
    VRD(7); SBAR(); GAPA(C1=__builtin_amdgcn_mfma_f32_32x32x16_bf16(kf[7],qr[3],C1,0,0,0),   P1[14],P1[15],0.f,0.f,       pw3[2]=PKW(P1,12),pw3[3]=PKW(P1,14), pw3); \
    l_reg+=sacc; \
    if(GK){DMA_K((t)+3,sl_cur);} if(GV){DMA_V((t)+1,sl_next);} \
    CMASK(C0,C1,t); \
    { float a=MX3(C0[0],C0[1],C1[0]),b=MX3(C0[2],C0[3],C1[1]); a=MX3(a,C1[2],C1[3]); \
      _Pragma("unroll") for(int r=4;r<16;r+=4){a=MX3(a,C0[r],C0[r+1]);b=MX3(b,C0[r+2],C0[r+3]);a=MX3(a,C1[r],C1[r+1]);b=MX3(b,C1[r+2],C1[r+3]);} \
      float rm=__builtin_fmaxf(a,b); { auto rr=__builtin_amdgcn_permlane32_swap(__float_as_uint(rm),__float_as_uint(rm),false,false); rm=__builtin_fmaxf(__uint_as_float(rr[0]),__uint_as_float(rr[1])); } \
      resc=false; \
      if(__builtin_expect(__any(rm>(float)THRL),0)){ const float dl=__builtin_fmaxf(rm,0.f); mhat+=dl; \
        _Pragma("unroll") for(int r=0;r<16;++r){C0[r]-=dl;C1[r]-=dl;} \
        _Pragma("unroll") for(int r=0;r<16;++r)negm[r]=-mhat; asm volatile("":"+v"(negm)); \
        const float f=__builtin_amdgcn_exp2f(-dl); l_reg*=f; if(hi==0)wsf[r32]=f; resc=true; } } \
    SBAR(); \
    GAPB(o[0]=__builtin_amdgcn_mfma_f32_32x32x16_bf16(PAF(0),VFR(0),o[0],0,0,0), C0,0); \
    GAPB(o[1]=__builtin_amdgcn_mfma_f32_32x32x16_bf16(PAF(0),VFR(4),o[1],0,0,0), C0,4); \
    KRD(GL,0); GAPB(o[0]=__builtin_amdgcn_mfma_f32_32x32x16_bf16(PAF(1),VFR(1),o[0],0,0,0), C0,8); \
    KRD(GL,1); GAPB(o[1]=__builtin_amdgcn_mfma_f32_32x32x16_bf16(PAF(1),VFR(5),o[1],0,0,0), C0,12); \
    KRD(GL,2); GAPB(o[0]=__builtin_amdgcn_mfma_f32_32x32x16_bf16(PAF(2),VFR(2),o[0],0,0,0), C1,0); \
    KRD(GL,3); GAPB(o[1]=__builtin_amdgcn_mfma_f32_32x32x16_bf16(PAF(2),VFR(6),o[1],0,0,0), C1,4); \
    GAPB(o[0]=__builtin_amdgcn_mfma_f32_32x32x16_bf16(PAF(3),VFR(3),o[0],0,0,0), C1,8); \
    GAPB(o[1]=__builtin_amdgcn_mfma_f32_32x32x16_bf16(PAF(3),VFR(7),o[1],0,0,0), C1,12); \
    }while(0)
  int t=1;
  for(;t+5<NT;t+=2){
    STEP(pB0,pB1,pA0,pA1,t,true,true,true);     WAIT_BAR(2); RESC(); ROT();
    STEP(pA0,pA1,pB0,pB1,t+1,true,true,true);   WAIT_BAR(2); RESC(); ROT();
  }
  #define ENDW(tt) do{ if((tt)+3<NT){WAIT_BAR(2);} else if((tt)+2<NT){WAIT_BAR(1);} else {WAIT_BAR(0);} }while(0)
  for(;t+1<NT;t+=2){
    STEP(pB0,pB1,pA0,pA1,t,(t+3<NT),(t+1<NT),(t+1<NT));       ENDW(t);   RESC(); ROT();
    STEP(pA0,pA1,pB0,pB1,t+1,(t+4<NT),(t+2<NT),(t+2<NT));     ENDW(t+1); RESC(); ROT();
  }
  if(nKh){
    const bf16*nks=nKh+(long)(ntile0*KVBLK+lane)*DM+wid*8;
    glds16(nks,(unsigned)__builtin_amdgcn_readfirstlane(kdst));
    if(NT%3==0){ const bf16*nvs=nVh+(long)(ntile0*KVBLK+16*(wid&3)+(lane>>2))*DM+(wid>>2)*32+(lane&3)*8; glds16(nvs,(unsigned)__builtin_amdgcn_readfirstlane(vdst)); }
    glds16(nks+(long)KVBLK*DM,(unsigned)__builtin_amdgcn_readfirstlane(kdst+SLOTB)); }
  STEP(pB0,pB1,pA0,pA1,NT-1,false,false,false); RESC();
  { float sacc=pB0[0]+pB0[1]; _Pragma("unroll") for(int r=2;r<16;++r)sacc+=pB0[r]; _Pragma("unroll") for(int r=0;r<16;++r)sacc+=pB1[r]; l_reg+=sacc;
    pw0=(u32x4){PKW(pB0,0),PKW(pB0,2),PKW(pB0,4),PKW(pB0,6)};pw1=(u32x4){PKW(pB0,8),PKW(pB0,10),PKW(pB0,12),PKW(pB0,14)};pw2=(u32x4){PKW(pB1,0),PKW(pB1,2),PKW(pB1,4),PKW(pB1,6)};pw3=(u32x4){PKW(pB1,8),PKW(pB1,10),PKW(pB1,12),PKW(pB1,14)};
    SBAR(); pv(o,vb0+sl_cur,PAF(0),PAF(1),PAF(2),PAF(3)); }
  #undef PKW
  #undef PAF
  #undef VFR
  #undef PIN
  #undef MX3
  #undef GAPA
  #undef GAPB
  #undef EX
  #undef VRD
  #undef KRD
  #undef STEP
  #undef ENDW
  {auto rr=__builtin_amdgcn_permlane32_swap(__float_as_uint(l_reg),__float_as_uint(l_reg),false,false);l_reg=__uint_as_float(rr[0])+__uint_as_float(rr[1]);}
  if(MODE==1) l_reg+=__builtin_amdgcn_exp2f(sink_l2-mhat);
  if(hi==0)wsf[32+r32]=l_reg;asm volatile("s_waitcnt lgkmcnt(0)":::"memory");
  float rli[16];
  #pragma unroll
  for(int r=0;r<16;++r)rli[r]=__builtin_amdgcn_rcpf(wsf[32+crow(r,hi)]);
  bf16*Ow=Oh+(long)(q0+wid*QBLK)*OPITCH;
  { bf16*stg=(bf16*)(shm+LDS_OST)+wid*2048;
    #pragma unroll
    for(int r=0;r<16;++r){const int orow=crow(r,hi);
      #pragma unroll
      for(int d0=0;d0<2;++d0)stg[orow*64+d0*32+r32]=__float2bfloat16(o[d0][r]*rli[r]);}
    asm volatile("s_waitcnt lgkmcnt(0)":::"memory");
    #pragma unroll
    for(int i=0;i<4;++i){const int row=i*8+(lane>>3),ch=lane&7; const u32x4 v=*(const u32x4*)(stg+row*64+ch*8); ATTN_STORE16(Oh,(unsigned)(((q0+wid*QBLK+row)*OPITCH+ch*8)*2),v);} }
  asm volatile("s_waitcnt lgkmcnt(0)\n\ts_barrier":::"memory");
  #undef DMA_K
  #undef DMA_V
  #undef CMASK
  #undef START
  #undef RESC
  #undef ROT
}
#undef SBAR
#undef WAIT_BAR
}
#define GAS __attribute__((address_space(1)))
#define LAS __attribute__((address_space(3)))
typedef unsigned short bf16;
typedef unsigned v4u __attribute__((ext_vector_type(4)));
typedef float f32x4 __attribute__((ext_vector_type(4)));
constexpr int NWAVES = 8;
#ifndef REP_P0
#define REP_P0 1
#endif
#ifndef REP_ATT_E
#define REP_ATT_E 1
#endif
#ifndef REP_ATT_O
#define REP_ATT_O 1
#endif
#ifndef REP_GU
#define REP_GU 1
#endif
#ifndef REP_PROJ
#define REP_PROJ 1
#endif
constexpr int LDS_BYTES = 135168;
static_assert(attn_body::ATTN_LDS_TOTAL <= 131072, "attention LDS inside the ring");

constexpr size_t SZ_WGU = (size_t)NGU * DMODEL * 2, SZ_WD = (size_t)DMODEL * DFF * 2;
constexpr size_t WS_WGU = 0;
constexpr size_t WS_WD = WS_WGU + 4 * SZ_WGU;
constexpr size_t WS_WIN = WS_WD + 4 * SZ_WD;
constexpr size_t WS_WOE = WS_WIN + (size_t)1536 * 1024 * 2;
constexpr size_t WS_WQKV = WS_WOE + (size_t)1024 * 1024 * 2;
constexpr size_t WS_WOO = WS_WQKV + (size_t)3072 * 1024 * 2;
constexpr size_t WS_XB = WS_WOO + (size_t)1024 * 1024 * 2;
constexpr size_t WS_PART = WS_XB + (size_t)SEQ * DMODEL * 2;
constexpr size_t WS_U = WS_PART + (size_t)SEQ * 16 * 4;
constexpr size_t WS_PROJ = WS_U, WS_O = WS_U + (size_t)SEQ * 3072 * 2, WS_END = WS_O + (size_t)SEQ * 1024 * 2;
static_assert(WS_END <= 268435456 && WS_U % 256 == 0, "d_ws map");

struct Args { const float* in[19]; float* out; unsigned char* ws; };
typedef unsigned long long u64;
__device__ __forceinline__ u64 ldptr(LAS u64* PT, int i) { const u64 v = PT[i]; const unsigned lo = __builtin_amdgcn_readfirstlane((unsigned)v), hi = __builtin_amdgcn_readfirstlane((unsigned)(v >> 32)); return ((u64)hi << 32) | lo; }

__device__ __forceinline__ unsigned f2bf(float f) { unsigned u = __builtin_bit_cast(unsigned, f); return (u + 0x7fffu + ((u >> 16) & 1u)) >> 16; }
__device__ __forceinline__ unsigned pk2(float lo, float hi) { return f2bf(lo) | (f2bf(hi) << 16); }
__device__ __forceinline__ float bf2f(unsigned short b) { return __builtin_bit_cast(float, (unsigned)b << 16); }
#define LDS_WAIT() asm volatile("s_waitcnt lgkmcnt(0)" ::: "memory")
__device__ __forceinline__ float wave_sum(float v) {
#pragma unroll
    for (int o = 1; o < 64; o <<= 1) v += __shfl_xor(v, o);
    return v;
}
__device__ __forceinline__ void transpose_item(const float* W, int K, int N, bf16* WT, const float* gain, int mode, LAS float* scr, int item, int lane) {
    const int nblk = N / 32, kb = item / nblk, nb = item % nblk, k0 = 64 * kb, n0 = 32 * nb;
    {
        const int kk8 = lane >> 3, seg = lane & 7;
        f32x4 w[8]; float gk[8];
#pragma unroll
        for (int i = 0; i < 8; ++i) { w[i] = __builtin_nontemporal_load((const GAS f32x4*)(W + (size_t)(k0 + 8 * i + kk8) * N + n0 + 4 * seg)); gk[i] = gain ? gain[k0 + 8 * i + kk8] : 1.f; }
#pragma unroll
        for (int i = 0; i < 8; ++i) { LAS float* d = scr + (8 * i + kk8) * 33 + 4 * seg; const f32x4 v = w[i] * gk[i]; d[0] = v.x; d[1] = v.y; d[2] = v.z; d[3] = v.w; }
    }
    LDS_WAIT(); asm volatile("" ::: "memory");
    const int d0 = (mode == 0) ? n0 : ((n0 >> 7) * 256 + (n0 & 127) + (mode == 2 ? 128 : 0));
    const auto wrs = __builtin_amdgcn_make_buffer_rsrc((void*)WT, 0, 0x7fffffff, 0x00020000);
    const int c = lane & 7;
#pragma unroll
    for (int j = 0; j < 4; ++j) { const int n = (lane >> 3) + 8 * j; const LAS float* s = scr + (8 * c) * 33 + n;
        v4u o; o.x = pk2(s[0 * 33], s[1 * 33]); o.y = pk2(s[2 * 33], s[3 * 33]); o.z = pk2(s[4 * 33], s[5 * 33]); o.w = pk2(s[6 * 33], s[7 * 33]);
        __builtin_amdgcn_raw_buffer_store_b128(o, wrs, (int)((((unsigned)(d0 + n)) * (unsigned)K + k0 + 8 * c) * 2u), 0, 16); }
    LDS_WAIT(); asm volatile("" ::: "memory");
}

__device__ __forceinline__ void cs_of(float ang, float& c, float& s) {
    double t = (double)ang * 0.15915494309189535; t -= __builtin_rint(t); const float r = (float)t;
    c = __builtin_amdgcn_cosf(r); s = __builtin_amdgcn_sinf(r);
}

#define P_IN(i) ((const float*)(const GAS float*)ldptr(PT, (i)))
#define P_WSB(off) ((bf16*)(GAS bf16*)(ldptr(PT, 20) + (off)))
__device__ __forceinline__ void conv_weights(LAS u64* PT, LAS unsigned char* ldsl, const unsigned mask, const int worker, const int nworkers, const int wave, const int lane) {
    LAS float* scr = (LAS float*)(ldsl + wave * 16384);
    bf16* WGU = P_WSB(WS_WGU); bf16* WD = P_WSB(WS_WD);
    constexpr int I_G = 16 * 88, I_D = 44 * 32, I_IN = 16 * 48, I_O = 16 * 32, I_QKV = 16 * 96;
    for (int it = worker; ; it += nworkers) {
        int r = it;
#define CONV_ENTRY(bit, cnt, call) if (mask & (1u << (bit))) { if (r < (cnt)) { call; continue; } r -= (cnt); }
#define FFN_ITEMS(f_, L_, GI, WG, WU, WDN) { const size_t wo = (size_t)(L_) * DMODEL * DFF; \
            CONV_ENTRY(3 * (f_) + 0, I_G, transpose_item(P_IN(WG) + wo, DMODEL, DFF, WGU + (size_t)(f_) * NGU * DMODEL, P_IN(GI) + (L_) * DMODEL, 1, scr, r, lane)) \
            CONV_ENTRY(3 * (f_) + 1, I_G, transpose_item(P_IN(WU) + wo, DMODEL, DFF, WGU + (size_t)(f_) * NGU * DMODEL, P_IN(GI) + (L_) * DMODEL, 2, scr, r, lane)) \
            CONV_ENTRY(3 * (f_) + 2, I_D, transpose_item(P_IN(WDN) + wo, DFF, DMODEL, WD + (size_t)(f_) * DMODEL * DFF, nullptr, 0, scr, r, lane)) }
        FFN_ITEMS(0, 0, 1, 2, 3, 4)
        FFN_ITEMS(1, 0, 6, 7, 8, 9)
        FFN_ITEMS(2, 1, 1, 2, 3, 4)
        FFN_ITEMS(3, 1, 6, 7, 8, 9)
#undef FFN_ITEMS
        CONV_ENTRY(12, I_IN, transpose_item(P_IN(10), DMODEL, 1536, P_WSB(WS_WIN), P_IN(5), 0, scr, r, lane))
        CONV_ENTRY(13, I_O, transpose_item(P_IN(14), DMODEL, DMODEL, P_WSB(WS_WOE), nullptr, 0, scr, r, lane))
        CONV_ENTRY(14, I_QKV, transpose_item(P_IN(15), DMODEL, 3072, P_WSB(WS_WQKV), P_IN(5) + DMODEL, 0, scr, r, lane))
        CONV_ENTRY(15, I_O, transpose_item(P_IN(17), DMODEL, DMODEL, P_WSB(WS_WOO), nullptr, 0, scr, r, lane))
#undef CONV_ENTRY
        break;
    }
}
#undef P_IN
#undef P_WSB
__device__ __forceinline__ void conv_in_tail(LAS u64* PT, LAS unsigned char* ldsl, const unsigned mask, const int nwg, const int G, const int bx, const int wave, const int lane) {
    const int rem = nwg % G, first = rem;
    if (bx >= first) conv_weights(PT, ldsl, mask, (bx - first) * NWAVES + wave, (G - first) * NWAVES, wave, lane);
}
#define RLX_AGENT __ATOMIC_RELAXED, __HIP_MEMORY_SCOPE_AGENT
#define XB_TMO      128
#define XB_XCNT(j)  (256  + 64 * (j))
#define XB_XSUB(j)  (1280 + 64 * (j))
#define XB_XGEN(j)  (2304 + 64 * (j))
#define XB_TOP      3328
#define XB_TOPGEN   3392
#define XCD_BAR_WORDS 3456
#define XB_SPIN_CAP (1u << 18)

__device__ __forceinline__ unsigned xb_ld(unsigned* p)              { return __hip_atomic_load(p, __ATOMIC_RELAXED, __HIP_MEMORY_SCOPE_AGENT); }
__device__ __forceinline__ unsigned xb_add(unsigned* p, unsigned v) { return __hip_atomic_fetch_add(p, v, __ATOMIC_RELAXED, __HIP_MEMORY_SCOPE_AGENT); }
__device__ __forceinline__ unsigned xb_xcc_id() { return (unsigned)__builtin_amdgcn_s_getreg((3 << 11) | 20) & 0xFu; }
#define XB_SPIN(cond, bar) do { unsigned _sp = 0; while (cond) { __builtin_amdgcn_s_sleep(1); \
    if ((++_sp & 255u) == 0u) { if (xb_ld(&(bar)[XB_TMO])) break; if (_sp > XB_SPIN_CAP) { atomicAdd(&(bar)[XB_TMO], 1u); break; } } } } while (0)

struct XcdBarrier {
    unsigned* bar; unsigned x;
    volatile LAS unsigned* st;
};

__device__ __forceinline__ XcdBarrier xcd_barrier_post(unsigned* bar, volatile LAS unsigned* st) {
    XcdBarrier b; b.bar = bar; b.x = xb_xcc_id(); b.st = st;
    if (threadIdx.x == 0) (void)xb_add(&bar[XB_XCNT(b.x)], 1u);
    return b;
}
__device__ __forceinline__ void xcd_barrier_complete(unsigned* bar, unsigned x, unsigned& nloc, unsigned& nx) {
    const unsigned G = gridDim.x * gridDim.y * gridDim.z;
    unsigned sum, cnt, mine, sp = 0u;
    for (;;) {
        sum = 0u; cnt = 0u; mine = 0u;
#pragma unroll
        for (unsigned j = 0; j < 16; ++j) { const unsigned c = xb_ld(&bar[XB_XCNT(j)]); sum += c; cnt += (c > 0u) ? 1u : 0u; mine = (j == x) ? c : mine; }
        if (sum == G) break;
        __builtin_amdgcn_s_sleep(1);
        if ((++sp & 255u) == 0u) { if (xb_ld(&bar[XB_TMO])) break; if (sp > XB_SPIN_CAP) { atomicAdd(&bar[XB_TMO], 1u); break; } }
    }
    nloc = mine > 0u ? mine : 1u; nx = cnt > 0u ? cnt : 1u;
}

__device__ __forceinline__ void xcd_barrier(const XcdBarrier& b) {
    asm volatile("s_waitcnt vmcnt(0)" ::: "memory");
    __syncthreads();
    if (threadIdx.x == 0) {
        unsigned* bar = b.bar;
        __builtin_amdgcn_s_waitcnt(0);
        unsigned nloc = b.st[0], nx = b.st[1];
        if (nloc == 0u) { xcd_barrier_complete(bar, b.x, nloc, nx); b.st[0] = nloc; b.st[1] = nx; }
        const unsigned old = xb_add(&bar[XB_XSUB(b.x)], 1u);
        const unsigned gen = old / nloc;
        if (old + 1u == (gen + 1u) * nloc) {
            __builtin_amdgcn_fence(__ATOMIC_RELEASE, "agent");
            asm volatile("s_waitcnt vmcnt(0)" ::: "memory");
            const unsigned og = xb_add(&bar[XB_TOP], 1u);
            const unsigned tg = og / nx;
            if (og + 1u == (tg + 1u) * nx) xb_add(&bar[XB_TOPGEN], 1u);
            else XB_SPIN(xb_ld(&bar[XB_TOPGEN]) == tg, bar);
            __builtin_amdgcn_fence(__ATOMIC_ACQUIRE, "agent");
            xb_add(&bar[XB_XGEN(b.x)], 1u);
            asm volatile("s_waitcnt vmcnt(0)" ::: "memory");
        } else {
            XB_SPIN(xb_ld(&bar[XB_XGEN(b.x)]) == gen, bar);
            __builtin_amdgcn_fence(__ATOMIC_ACQUIRE, "agent");
            asm volatile("s_waitcnt vmcnt(0)" ::: "memory");
        }
    }
    __syncthreads();
}

constexpr size_t WS_BAR = WS_PART + 512 * 1024;
__global__ void __launch_bounds__(NWAVES * 64, 2) fwd_megakernel(Args args) {
    extern __shared__ __attribute__((aligned(16))) unsigned char lds[];
    cg::grid_group grid = cg::this_grid();
    LAS unsigned char* ldsl = (LAS unsigned char*)lds;
#define FRESH() int tid = threadIdx.x; asm volatile("" : "+v"(tid)); int G = gridDim.x, bx = blockIdx.x; asm volatile("" : "+s"(G), "+s"(bx)); \
    const int lane = tid & 63, wave = __builtin_amdgcn_readfirstlane(tid >> 6); const int gw = bx * NWAVES + wave, NGW = G * NWAVES; (void)lane; (void)gw; (void)NGW;
    LAS u64* PT = (LAS u64*)(ldsl + 131072);
    if (threadIdx.x == 0) {
#pragma unroll
        for (int i = 0; i < 19; ++i) PT[i] = (u64)args.in[i];
        PT[19] = (u64)args.out; PT[20] = (u64)args.ws;
        ((volatile LAS unsigned*)(ldsl + 131072 + 256))[0] = 0u; ((volatile LAS unsigned*)(ldsl + 131072 + 256))[1] = 0u;
    }
    __syncthreads();
    int par = 0;
#define P_IN(i) ((const float*)(const GAS float*)ldptr(PT, (i)))
#define P_OUT ((float*)(GAS float*)ldptr(PT, 19))
#define P_WSB(off) ((bf16*)(GAS bf16*)(ldptr(PT, 20) + (off)))
#define P_SUMQ ((u64*)(GAS u64*)(ldptr(PT, 20) + WS_PART))

#ifndef NO_P0
    {
        FRESH();
        bf16* XB = P_WSB(WS_XB); u64* SUMQ = P_SUMQ;
        for (int rep = 0; rep < REP_P0; ++rep) {
        conv_weights(PT, ldsl, 0x0003u, gw, NGW, wave, lane);
        if (bx == 0) { unsigned* bw = (unsigned*)(GAS unsigned*)(ldptr(PT, 20) + WS_BAR); for (int i = tid; i < XCD_BAR_WORDS; i += NWAVES * 64) bw[i] = 0u; }
        const float* x = P_IN(0); const auto xrs = __builtin_amdgcn_make_buffer_rsrc((void*)XB, 0, 0x7fffffff, 0x00020000);
        for (int m0 = gw; m0 < SEQ; m0 += 2 * NGW) {
            f32x4 v[2][4]; float s[2];
#pragma unroll
            for (int q = 0; q < 2; ++q) { const int m = m0 + q * NGW; const GAS f32x4* xr = (const GAS f32x4*)(x + (size_t)(m < SEQ ? m : m0) * DMODEL) + lane;
#pragma unroll
                for (int j = 0; j < 4; ++j) v[q][j] = xr[64 * j]; }
#pragma unroll
            for (int q = 0; q < 2; ++q) { const int m = m0 + q * NGW; s[q] = 0.f;
#pragma unroll
                for (int j = 0; j < 4; ++j) s[q] += (v[q][j].x * v[q][j].x + v[q][j].y * v[q][j].y) + (v[q][j].z * v[q][j].z + v[q][j].w * v[q][j].w);
                s[q] = wave_sum(s[q]);
                if (m < SEQ) {
#pragma unroll
                    for (int j = 0; j < 4; ++j) { typedef unsigned v2u __attribute__((ext_vector_type(2))); const v2u w2 = {pk2(v[q][j].x, v[q][j].y), pk2(v[q][j].z, v[q][j].w)};
                        __builtin_amdgcn_raw_buffer_store_b64(w2, xrs, (int)(((unsigned)m * DMODEL + 256u * j + 4u * lane) * 2u), 0, 16); }
                    if (lane == 0) { SUMQ[m] = (unsigned long long)(s[q] * 1048576.f); SUMQ[SEQ + m] = 0ull; }
                } }
        }
        }
    }
    grid.sync();
    { XcdBarrier b0 = xcd_barrier_post((unsigned*)(GAS unsigned*)(ldptr(PT, 20) + WS_BAR), (volatile LAS unsigned*)(ldsl + 131072 + 256)); (void)b0; }
#define GRID_BAR() do { XcdBarrier b_; b_.bar = (unsigned*)(GAS unsigned*)(ldptr(PT, 20) + WS_BAR); b_.x = xb_xcc_id(); b_.st = (volatile LAS unsigned*)(ldsl + 131072 + 256); xcd_barrier(b_); } while (0)
#endif

#pragma unroll 1
    for (int L = 0; L < 2; ++L) {
#pragma unroll 1
        for (int h2 = 0; h2 < 2; ++h2) {
            const int f = 2 * L + h2;
#ifndef NO_GU
            {
                FRESH();
                u64* SUMQ = P_SUMQ; pg8::Gemm g{P_WSB(WS_XB), P_WSB(WS_WGU) + (size_t)f * NGU * DMODEL, SEQ, NGU, DMODEL}; pg8::StaticOrder S; S.init(SEQ, NGU, G, bx);
                pg8::EpiGU E{P_WSB(WS_U), SUMQ + par * SEQ, SUMQ + (par ^ 1) * SEQ};
                for (int rep = 0; rep < ((f == 0) ? REP_GU : 1); ++rep)
                pg8::gemm_phase<pg8::EpiGU, pg8::StaticOrder, true, true>(ldsl, g, S, E);
                { const unsigned cm = (f == 0) ? 0x301Cu : (f == 1) ? 0x02C0u : (f == 2) ? 0xCC00u : 0u; if (cm) conv_in_tail(PT, ldsl, cm, (SEQ / 256) * (NGU / 256), G, bx, wave, lane); }
            }
#endif
            GRID_BAR();
#ifndef NO_DOWN
            {
                FRESH();
                u64* SUMQ = P_SUMQ; pg8::Gemm g{P_WSB(WS_U), P_WSB(WS_WD) + (size_t)f * DMODEL * DFF, SEQ, DMODEL, DFF}; pg8::StaticOrder S; S.init(SEQ, DMODEL, G, bx);
                if (f == 0) { pg8::EpiRes<true> E{P_IN(0), P_WSB(WS_XB), SUMQ + (par ^ 1) * SEQ, 0.5f}; pg8::gemm_phase<pg8::EpiRes<true>, pg8::StaticOrder, true, true>(ldsl, g, S, E); }
                else { pg8::EpiRes<false> E{nullptr, P_WSB(WS_XB), SUMQ + (par ^ 1) * SEQ, 0.5f}; pg8::gemm_phase<pg8::EpiRes<false>, pg8::StaticOrder, true, true>(ldsl, g, S, E); }
                par ^= 1;
            }
#endif
            GRID_BAR();
            if (h2 == 1) continue;
            const int NPROJ = (L == 0) ? 1536 : 3072;
#ifndef NO_PROJ
            {
                FRESH();
                u64* SUMQ = P_SUMQ; pg8::Gemm g{P_WSB(WS_XB), (L == 0) ? P_WSB(WS_WIN) : P_WSB(WS_WQKV), SEQ, NPROJ, DMODEL}; pg8::StaticOrder S; S.init(SEQ, NPROJ, G, bx);
                pg8::EpiProj E{P_WSB(WS_PROJ), (unsigned)NPROJ, SUMQ + par * SEQ, SUMQ + (par ^ 1) * SEQ, (L == 0) ? 0 : 1024, QSCALE};
                for (int rep = 0; rep < REP_PROJ; ++rep)
                pg8::gemm_phase<pg8::EpiProj, pg8::StaticOrder, true, true>(ldsl, g, S, E);
                if (L == 0) conv_in_tail(PT, ldsl, 0x0120u, (SEQ / 256) * (1536 / 256), G, bx, wave, lane);
            }
#endif
            GRID_BAR();
            if (L == 0) {
#ifndef NO_POST
                {
                FRESH();
                const int seg = lane & 7, ts = lane >> 3;
                const float* pq = P_IN(11); const float* pk = P_IN(12); bf16* PROJ = P_WSB(WS_PROJ);
                float i32[8], i64[8], gq[8], gk[8];
#pragma unroll
                for (int j = 0; j < 8; ++j) {
                    i32[j] = (float)::exp2(-(double)(8 * (seg & 1) + j) * (2.0 / 32.0) * 13.287712379549449);
                    i64[j] = (float)::exp2(-(double)(8 * (seg & 3) + j) * (2.0 / 64.0) * 13.287712379549449);
                    gq[j] = pq[8 * seg + j]; gk[j] = pk[8 * seg + j]; }
                const auto prs = __builtin_amdgcn_make_buffer_rsrc((void*)PROJ, 0, 0x7fffffff, 0x00020000);
                for (int grp = gw; grp < SEQ / 8; grp += NGW) {
                    const int tok = grp * 8 + ts;
                    GAS v4u* row = (GAS v4u*)(PROJ + (size_t)tok * 1536) + seg;
                    v4u ra[10], rb[10];
#pragma unroll
                    for (int i = 0; i < 10; ++i) { ra[i] = row[8 * i]; rb[i] = row[96 + 8 * i]; }
                    float ca[8], sa[8], cb[8], sb[8];
                    const float pa = (float)((seg < 4) ? (tok >> 6) : (tok & 63)), pb = (float)tok;
#pragma unroll
                    for (int j = 0; j < 8; ++j) { cs_of(pa * i32[j], ca[j], sa[j]); cs_of(pb * i64[j], cb[j], sb[j]); }
#pragma unroll
                    for (int i = 0; i < 10; ++i) {
                        {
                            float v[8]; const v4u w = ra[i];
                            v[0] = __builtin_bit_cast(float, w.x << 16); v[1] = __builtin_bit_cast(float, w.x & 0xffff0000u); v[2] = __builtin_bit_cast(float, w.y << 16); v[3] = __builtin_bit_cast(float, w.y & 0xffff0000u);
                            v[4] = __builtin_bit_cast(float, w.z << 16); v[5] = __builtin_bit_cast(float, w.z & 0xffff0000u); v[6] = __builtin_bit_cast(float, w.w << 16); v[7] = __builtin_bit_cast(float, w.w & 0xffff0000u);
                            float ss = ((v[0] * v[0] + v[1] * v[1]) + (v[2] * v[2] + v[3] * v[3])) + ((v[4] * v[4] + v[5] * v[5]) + (v[6] * v[6] + v[7] * v[7]));
                            ss += __shfl_xor(ss, 1); ss += __shfl_xor(ss, 2); ss += __shfl_xor(ss, 4);
                            const float rs = __builtin_amdgcn_rsqf(ss * (1.f / 64.f) + RMS_EPS) * ((i < 8) ? QSCALE : 1.f);
                            float o[8];
#pragma unroll
                            for (int j = 0; j < 8; ++j) { const float nv = v[j] * rs * ((i < 8) ? gq[j] : gk[j]); const float pr = __shfl_xor(nv, 2);
                                o[j] = (seg & 2) ? (pr * sa[j] + nv * ca[j]) : (nv * ca[j] - pr * sa[j]); }
                            v4u r; r.x = pk2(o[0], o[1]); r.y = pk2(o[2], o[3]); r.z = pk2(o[4], o[5]); r.w = pk2(o[6], o[7]);
                            __builtin_amdgcn_raw_buffer_store_b128(r, prs, (int)(((unsigned)tok * 1536u + 64u * i + 8u * seg) * 2u), 0, 16);
                        }
                        {
                            float v[8]; const v4u w = rb[i];
                            v[0] = __builtin_bit_cast(float, w.x << 16); v[1] = __builtin_bit_cast(float, w.x & 0xffff0000u); v[2] = __builtin_bit_cast(float, w.y << 16); v[3] = __builtin_bit_cast(float, w.y & 0xffff0000u);
                            v[4] = __builtin_bit_cast(float, w.z << 16); v[5] = __builtin_bit_cast(float, w.z & 0xffff0000u); v[6] = __builtin_bit_cast(float, w.w << 16); v[7] = __builtin_bit_cast(float, w.w & 0xffff0000u);
                            const float qs = (i < 8) ? QSCALE : 1.f;
                            float o[8];
#pragma unroll
                            for (int j = 0; j < 8; ++j) { const float nv = v[j] * qs; const float pr = __shfl_xor(nv, 4);
                                o[j] = (seg & 4) ? (pr * sb[j] + nv * cb[j]) : (nv * cb[j] - pr * sb[j]); }
                            v4u r; r.x = pk2(o[0], o[1]); r.y = pk2(o[2], o[3]); r.z = pk2(o[4], o[5]); r.w = pk2(o[6], o[7]);
                            __builtin_amdgcn_raw_buffer_store_b128(r, prs, (int)(((unsigned)tok * 1536u + 768u + 64u * i + 8u * seg) * 2u), 0, 16);
                        }
                    }
                }
                }
                GRID_BAR();
#endif
                FRESH();
                {
                const attn_body::bf16* P = (const attn_body::bf16*)P_WSB(WS_PROJ); attn_body::bf16* O = (attn_body::bf16*)P_WSB(WS_O);
#define EVEN_KV(u_, kc_, vc_, t0_) { const int uu_ = (u_) & 511, h_ = uu_ & 7, qb_ = uu_ >> 3, kvh_ = h_ >> 2; \
                    if ((u_) < 512) { kc_ = 512 + kvh_ * 64; vc_ = 640 + kvh_ * 64; t0_ = 0; } else { kc_ = 1280 + kvh_ * 64; vc_ = 1408 + kvh_ * 64; t0_ = min(max(qb_ * 4 - 2, 0), 248); } }
                bool pre = false;
                for (int u = bx; u < 1024; u += G) {
                    const int uu = u & 511, h = uu & 7, qb = uu >> 3;
                    int kc, vc, t0; EVEN_KV(u, kc, vc, t0)
                    const int un = u + G; int nkc = 0, nvc = 0, nt0 = 0; const bool hn = un < 1024; if (hn) EVEN_KV(un, nkc, nvc, nt0)
                    const attn_body::bf16* nK = hn ? P + nkc : nullptr; const attn_body::bf16* nV = hn ? P + nvc : nullptr;
                    if (u < 512) attn_body::attn_unit<0, 8>(P + h * 64, P + kc, P + vc, O + h * 64, 1536, qb * 256, 0, 256, 0.f, nullptr, false, pre, false, nK, nV, nt0, (char*)lds);
                    else attn_body::attn_unit<1, 8>(P + 768 + h * 64, P + kc, P + vc, O + 512 + h * 64, 1536, qb * 256, t0, 8, P_IN(13)[h] * LOG2E, nullptr, false, pre, false, nK, nV, nt0, (char*)lds);
                    pre = hn;
                }
#ifdef PROBE_B2
                for (int u = bx + 512; u < 1024; u += G) {
                    const int uu = u & 511, h = uu & 7, qb = uu >> 3; int kc, vc, t0; EVEN_KV(u, kc, vc, t0)
                    attn_body::attn_unit<1, 8>(P + 768 + h * 64, P + kc, P + vc, O + 512 + h * 64, 1536, qb * 256, t0, 8, P_IN(13)[h] * LOG2E, nullptr, false, false, false, nullptr, nullptr, 0, (char*)lds);
                }
#endif
#undef EVEN_KV
                }
            } else {
                FRESH();
                int hb = -1;
#ifdef PROBE_NA24
                for (int u = bx; u < 1024; u += G) {
                    const int h = u & 15, qb = u >> 4; const int t0 = min(max(qb * 4 - 4, 0), 232);
                    const attn_body::bf16* P = (const attn_body::bf16*)P_WSB(WS_PROJ); attn_body::bf16* O = (attn_body::bf16*)P_WSB(WS_O);
                    attn_body::attn_unit<2, 8>(P + h * 64, P + 1024 + h * 64, P + 2048 + h * 64, O + h * 64, 3072, qb * 256, t0, 24, 0.f, P_IN(16) + h * 465, h != hb, false, false, nullptr, nullptr, 0, (char*)lds); hb = h;
                }
#endif
                {
                const attn_body::bf16* P = (const attn_body::bf16*)P_WSB(WS_PROJ); attn_body::bf16* O = (attn_body::bf16*)P_WSB(WS_O);
                bool pre = false;
                for (int u = bx; u < 1024; u += G) {
                    const int h = u & 15, qb = u >> 4; const int t0 = min(max(qb * 4 - 4, 0), 244);
                    const int un = u + G; const bool hn = un < 1024; const int nh = un & 15, nqb = un >> 4, nt0 = min(max(nqb * 4 - 4, 0), 244);
                    attn_body::attn_unit<2, 8>(P + h * 64, P + 1024 + h * 64, P + 2048 + h * 64, O + h * 64, 3072, qb * 256, t0, 12, 0.f, P_IN(16) + h * 465, h != hb, pre, pre,
                                               hn ? P + 1024 + nh * 64 : nullptr, hn ? P + 2048 + nh * 64 : nullptr, nt0, (char*)lds); hb = h;
                    pre = hn;
                }
                }
            }
            GRID_BAR();
#ifndef NO_OUT
            {
                FRESH();
                u64* SUMQ = P_SUMQ; float* OUT = P_OUT; pg8::Gemm g{P_WSB(WS_O), (L == 0) ? P_WSB(WS_WOE) : P_WSB(WS_WOO), SEQ, DMODEL, DMODEL}; pg8::StaticOrder S; S.init(SEQ, DMODEL, G, bx);
                pg8::EpiRes<false> E{nullptr, P_WSB(WS_XB), SUMQ + (par ^ 1) * SEQ, 1.0f}; par ^= 1;
                pg8::gemm_phase<pg8::EpiRes<false>, pg8::StaticOrder, true, true>(ldsl, g, S, E);
            }
#endif
            GRID_BAR();
        }
    }
    {
        FRESH();
        const float* fg = P_IN(18); u64* SUMQ = P_SUMQ; float* OUT = P_OUT; const bf16* XB = P_WSB(WS_XB);
        f32x4 gv[4];
#pragma unroll
        for (int j = 0; j < 2; ++j) { gv[2 * j] = ((const GAS f32x4*)fg)[128 * j + 2 * lane]; gv[2 * j + 1] = ((const GAS f32x4*)fg)[128 * j + 2 * lane + 1]; }
        for (int m0 = gw; m0 < SEQ; m0 += 4 * NGW) {
            v4u w[4][2]; float sc[4];
#pragma unroll
            for (int q = 0; q < 4; ++q) { const int m = (m0 + q * NGW < SEQ) ? m0 + q * NGW : m0; sc[q] = pg8::row_scale(SUMQ + par * SEQ, m);
                const GAS v4u* xr = (const GAS v4u*)(XB + (size_t)m * DMODEL) + lane; w[q][0] = xr[0]; w[q][1] = xr[64]; }
#pragma unroll
            for (int q = 0; q < 4; ++q) { const int m = m0 + q * NGW; if (m < SEQ) {
                GAS f32x4* orow = (GAS f32x4*)(OUT + (size_t)m * DMODEL);
#pragma unroll
                for (int j = 0; j < 2; ++j) { const v4u ww = w[q][j];
                    const f32x4 a = {__builtin_bit_cast(float, ww.x << 16), __builtin_bit_cast(float, ww.x & 0xffff0000u), __builtin_bit_cast(float, ww.y << 16), __builtin_bit_cast(float, ww.y & 0xffff0000u)};
                    const f32x4 b = {__builtin_bit_cast(float, ww.z << 16), __builtin_bit_cast(float, ww.z & 0xffff0000u), __builtin_bit_cast(float, ww.w << 16), __builtin_bit_cast(float, ww.w & 0xffff0000u)};
                    orow[128 * j + 2 * lane] = a * sc[q] * gv[2 * j]; orow[128 * j + 2 * lane + 1] = b * sc[q] * gv[2 * j + 1]; } } }
        }
    }
}

extern "C" void kernel_launch(void* const* d_in, const int* in_sizes, int n_in, void* d_out, int out_size, void* d_ws, size_t ws_size, hipStream_t stream) {
    static int grid = 0;
    if (grid == 0) {
        if (n_in != 19 || out_size != SEQ * DMODEL || ws_size < WS_END) { fprintf(stderr, "kernel_launch: unexpected shapes (n_in %d, out %d, ws %zu < %zu)\n", n_in, out_size, ws_size, (size_t)WS_END); grid = -1; return; }
        int dev = 0, cus = 0, per_cu = 0;
        (void)hipGetDevice(&dev);
        (void)hipDeviceGetAttribute(&cus, hipDeviceAttributeMultiprocessorCount, dev);
        if (hipFuncSetAttribute((const void*)fwd_megakernel, hipFuncAttributeMaxDynamicSharedMemorySize, LDS_BYTES) != hipSuccess) { fprintf(stderr, "kernel_launch: hipFuncSetAttribute failed\n"); grid = -1; return; }
        if (hipOccupancyMaxActiveBlocksPerMultiprocessor(&per_cu, (const void*)fwd_megakernel, NWAVES * 64, LDS_BYTES) != hipSuccess || per_cu < 1) { fprintf(stderr, "kernel_launch: occupancy query failed (%d)\n", per_cu); (void)hipGetLastError(); per_cu = 1; }
        grid = cus * per_cu;
        fprintf(stderr, "kernel_launch: %d CUs x %d = grid %d\n", cus, per_cu, grid);
    }
    if (grid < 0) return;
    Args a{};
    for (int i = 0; i < 19; ++i) a.in[i] = (const float*)d_in[i];
    a.out = (float*)d_out; a.ws = (unsigned char*)d_ws;
    void* kargs[] = {&a};
    hipError_t e = hipLaunchCooperativeKernel((const void*)fwd_megakernel, dim3(grid), dim3(NWAVES * 64), kargs, LDS_BYTES, stream);
    if (e != hipSuccess) fprintf(stderr, "kernel_launch: cooperative launch failed: %s (grid %d)\n", hipGetErrorString(e), grid);
}
```

```cpp
#include <hip/hip_runtime.h>
#include <hip/hip_cooperative_groups.h>
#include <hip/hip_bf16.h>
#include <cstdio>
#include <cstdint>
#include <cmath>
namespace cg = cooperative_groups;

constexpr int SEQ = 16384, DMODEL = 1024, DFF = 2816, NGU = 2 * DFF;
constexpr float RMS_EPS = 1e-6f;
constexpr float LOG2E = 1.4426950408889634f;
constexpr float QSCALE = 0.125f * 1.4426950408889634f;

namespace pg8 {
#define PG8_LAS __attribute__((address_space(3)))
typedef unsigned short bf16_t;
typedef short bf16x8 __attribute__((ext_vector_type(8)));
typedef float f32x4 __attribute__((ext_vector_type(4)));
typedef unsigned u32x4 __attribute__((ext_vector_type(4)));
#define WT_RSRC(base) __builtin_amdgcn_make_buffer_rsrc((void*)(base), 0, 0x7fffffff, 0x00020000)
#define WT_STORE16(rsrc, byteoff, v) __builtin_amdgcn_raw_buffer_store_b128((v), (rsrc), (int)(byteoff), 0, 16)
constexpr int BM = 256, BK = 64, HALF = 128, HTB = HALF * BK * 2  , STAGE_BYTES = 8 * HTB, NXCD = 8, WGM = 8;

__host__ __device__ __forceinline__ int lds_byte(int r, int c) { const int st = (r >> 4) * 2 + (c >> 5), rr = r & 15, cc = c & 31, ob = rr * 64 + cc * 2; return st * 1024 + (ob ^ (((ob >> 9) & 1) << 5)); }
__host__ __device__ __forceinline__ void stage_rc(int b, int& R, int& C) { const int st = b / 1024, sb = b % 1024, swz = sb ^ (((sb >> 9) & 1) << 5); R = (st >> 1) * 16 + swz / 64; C = (st & 1) * 32 + (swz % 64) / 2; }
__host__ __device__ __forceinline__ int perm32(int rho) { const int n = rho >> 4, i = rho & 15; return 8 * (i >> 2) + 4 * n + (i & 3); }

struct Unit { int pm, pn; };
struct Gemm { const bf16_t* A; const bf16_t* Bt; int M, N, K; };

struct StaticOrder {
    int nM, nN, nwg, G, c;
    __host__ __device__ void init(int M, int N, int G_, int c_) { nM = M / BM; nN = N / BM; nwg = nM * nN; G = G_; c = c_; }
    __host__ __device__ bool next(int i, Unit& u) const {
        const long L = (long)i * G + c; if (L >= nwg) return false;
        int wgid = (int)L; { const int q = nwg / NXCD, r = nwg % NXCD, xcd = wgid % NXCD, off = wgid / NXCD; wgid = (xcd < r ? xcd * (q + 1) : r * (q + 1) + (xcd - r) * q) + off; }
        const int nig = WGM * nN, gid = wgid / nig, fm = gid * WGM, gsz = (nM - fm) < WGM ? (nM - fm) : WGM;
        u.pm = fm + ((wgid % nig) % gsz); u.pn = (wgid % nig) / gsz; return true;
    }
    __device__ __forceinline__ void a_ready(const Unit&) const {}
    __device__ __forceinline__ void done(const Unit&) const {}
};

__device__ __forceinline__ unsigned cvt_pk_bf16(float lo, float hi) { unsigned r; asm volatile("v_cvt_pk_bf16_f32 %0, %1, %2" : "=v"(r) : "v"(lo), "v"(hi)); return r; }
typedef unsigned long long u64;
__device__ __forceinline__ float row_scale(const u64* sq, unsigned row) {
    return __builtin_amdgcn_rsqf((float)sq[row] * (1.f / (1048576.f * 1024.f)) + 1e-6f);
}
constexpr int SCALE_LDS = 131072 + 1024;
__device__ __forceinline__ float silu_mul(float g, float u) { return g * u * __builtin_amdgcn_rcpf(1.f + __builtin_amdgcn_exp2f(-1.4426950408889634f * g)); }

struct EpiGU {
    static constexpr bool PERM = true, AFTER_DRAIN = false, HAS_PRE = true, IS_FINAL = false;
    bf16_t* ACT; const u64* sq; u64* sqz;
    __device__ __forceinline__ void pre_first(const Unit& u, PG8_LAS unsigned char* lds, int tid) const {
        if (tid < 256) ((PG8_LAS float*)(lds + SCALE_LDS))[tid] = row_scale(sq, u.pm * BM + tid);
    }
    __device__ __forceinline__ void operator()(const f32x4 (&acc)[2][2][4][2], const Unit& u, const Unit& nx, bool has_next, int par, PG8_LAS unsigned char* lds, int tid, int wr, int wc, int fr, int fq) const {
        u64 nsq = 0; const bool ld = has_next && tid < 256; if (ld) nsq = sq[nx.pm * BM + tid];
        const PG8_LAS float* sc = (const PG8_LAS float*)(lds + SCALE_LDS) + par * 256;
        const unsigned rl0 = wr * 64 + fr, row0 = u.pm * BM + rl0, col0 = u.pn * 128 + wc * 32 + 8 * fq; const auto rs_ = WT_RSRC(ACT);
        const bool zr = (u.pn == 0) && (wc == 0) && (fq == 0);
#pragma unroll
        for (int ai = 0; ai < 2; ++ai) {
#pragma unroll
            for (int m = 0; m < 4; ++m) { const unsigned row = row0 + ai * HALF + m * 16; const float s = sc[rl0 + ai * HALF + m * 16]; if (zr) sqz[row] = 0ull;
                const f32x4 g0 = acc[ai][0][m][0] * s, g1 = acc[ai][0][m][1] * s, u0 = acc[ai][1][m][0] * s, u1 = acc[ai][1][m][1] * s;
                u32x4 w; w.x = cvt_pk_bf16(silu_mul(g0[0], u0[0]), silu_mul(g0[1], u0[1])); w.y = cvt_pk_bf16(silu_mul(g0[2], u0[2]), silu_mul(g0[3], u0[3]));
                w.z = cvt_pk_bf16(silu_mul(g1[0], u1[0]), silu_mul(g1[1], u1[1])); w.w = cvt_pk_bf16(silu_mul(g1[2], u1[2]), silu_mul(g1[3], u1[3]));
                WT_STORE16(rs_, (row * 2816u + col0) * 2u, w); }
            __builtin_amdgcn_sched_barrier(0);
        }
        if (ld) ((PG8_LAS float*)(lds + SCALE_LDS))[(par ^ 1) * 256 + tid] = __builtin_amdgcn_rsqf((float)nsq * (1.f / (1048576.f * 1024.f)) + 1e-6f);
    }
};
template <bool F32IN> struct EpiRes {
    static constexpr bool PERM = true, AFTER_DRAIN = false, HAS_PRE = false, IS_FINAL = false;
    const float* in_f32; bf16_t* xb; u64* sqa; float alpha;
    __device__ __forceinline__ void finish(const f32x4& v0, const f32x4& v1, unsigned off, float& ss) const {
        u32x4 w; w.x = cvt_pk_bf16(v0[0], v0[1]); w.y = cvt_pk_bf16(v0[2], v0[3]); w.z = cvt_pk_bf16(v1[0], v1[1]); w.w = cvt_pk_bf16(v1[2], v1[3]);
        WT_STORE16(WT_RSRC(xb), off * 2u, w);
        ss += ((v0[0] * v0[0] + v0[1] * v0[1]) + (v0[2] * v0[2] + v0[3] * v0[3])) + ((v1[0] * v1[0] + v1[1] * v1[1]) + (v1[2] * v1[2] + v1[3] * v1[3]));
    }
    __device__ __forceinline__ void operator()(const f32x4 (&acc)[2][2][4][2], const Unit& u, int wr, int wc, int fr, int fq) const {
        const unsigned row0 = u.pm * BM + wr * 64 + fr, col0 = u.pn * BM + wc * 32 + 8 * fq;
        if constexpr (F32IN) {
#pragma unroll
            for (int ai = 0; ai < 2; ++ai)
#pragma unroll
                for (int mp = 0; mp < 2; ++mp) {
                    f32x4 o[2][2][2];
#pragma unroll
                    for (int mm = 0; mm < 2; ++mm)
#pragma unroll
                        for (int bj = 0; bj < 2; ++bj) { const unsigned off = (row0 + ai * HALF + (2 * mp + mm) * 16) * 1024u + col0 + bj * HALF;
                            o[mm][bj][0] = *(const f32x4*)(in_f32 + off); o[mm][bj][1] = *(const f32x4*)(in_f32 + (off + 4u)); }
#pragma unroll
                    for (int mm = 0; mm < 2; ++mm) { const int m = 2 * mp + mm; const unsigned row = row0 + ai * HALF + m * 16; float ss = 0.f;
#pragma unroll
                        for (int bj = 0; bj < 2; ++bj) finish(o[mm][bj][0] + acc[ai][bj][m][0] * alpha, o[mm][bj][1] + acc[ai][bj][m][1] * alpha, row * 1024u + col0 + bj * HALF, ss);
                        ss += __shfl_xor(ss, 16); ss += __shfl_xor(ss, 32);
                        if (fq == 0) atomicAdd(sqa + row, (u64)(ss * 1048576.f)); }
                    __builtin_amdgcn_sched_barrier(0);
                }
        } else {
            u32x4 t[2][4][2];
#pragma unroll
            for (int ai = 0; ai < 2; ++ai)
#pragma unroll
                for (int m = 0; m < 4; ++m)
#pragma unroll
                    for (int bj = 0; bj < 2; ++bj) t[ai][m][bj] = *(const u32x4*)(xb + ((row0 + ai * HALF + m * 16) * 1024u + col0 + bj * HALF));
            __builtin_amdgcn_sched_barrier(0);
#pragma unroll
            for (int ai = 0; ai < 2; ++ai) {
#pragma unroll
                for (int m = 0; m < 4; ++m) { const unsigned row = row0 + ai * HALF + m * 16; float ss = 0.f;
#pragma unroll
                    for (int bj = 0; bj < 2; ++bj) { const u32x4 w0 = t[ai][m][bj];
                        const f32x4 o0 = {__builtin_bit_cast(float, w0.x << 16), __builtin_bit_cast(float, w0.x & 0xffff0000u), __builtin_bit_cast(float, w0.y << 16), __builtin_bit_cast(float, w0.y & 0xffff0000u)};
                        const f32x4 o1 = {__builtin_bit_cast(float, w0.z << 16), __builtin_bit_cast(float, w0.z & 0xffff0000u), __builtin_bit_cast(float, w0.w << 16), __builtin_bit_cast(float, w0.w & 0xffff0000u)};
                        finish(o0 + acc[ai][bj][m][0] * alpha, o1 + acc[ai][bj][m][1] * alpha, row * 1024u + col0 + bj * HALF, ss); }
                    ss += __shfl_xor(ss, 16); ss += __shfl_xor(ss, 32);
                    if (fq == 0) atomicAdd(sqa + row, (u64)(ss * 1048576.f)); }
                __builtin_amdgcn_sched_barrier(0);
            }
        }
    }
};
struct EpiFinal {
    static constexpr bool PERM = true, AFTER_DRAIN = false, HAS_PRE = false, IS_FINAL = true;
    const bf16_t* xb; float* out; u64* sqa; unsigned* cnt; const float* gain; float alpha;
    __device__ __forceinline__ void fin(f32x4 (&acc)[2][2][4][2], const Unit& u, int tid, int wr, int wc, int fr, int fq) const {
        const unsigned row0 = u.pm * BM + wr * 64 + fr, col0 = u.pn * BM + wc * 32 + 8 * fq;
        {
            u32x4 t[2][4][2];
#pragma unroll
            for (int ai = 0; ai < 2; ++ai)
#pragma unroll
                for (int m = 0; m < 4; ++m)
#pragma unroll
                    for (int bj = 0; bj < 2; ++bj) t[ai][m][bj] = *(const u32x4*)(xb + ((row0 + ai * HALF + m * 16) * 1024u + col0 + bj * HALF));
            __builtin_amdgcn_sched_barrier(0);
#pragma unroll
            for (int ai = 0; ai < 2; ++ai)
#pragma unroll
                for (int m = 0; m < 4; ++m) { const unsigned row = row0 + ai * HALF + m * 16; float ss = 0.f;
#pragma unroll
                    for (int bj = 0; bj < 2; ++bj) { const u32x4 w0 = t[ai][m][bj];
                        const f32x4 o0 = {__builtin_bit_cast(float, w0.x << 16), __builtin_bit_cast(float, w0.x & 0xffff0000u), __builtin_bit_cast(float, w0.y << 16), __builtin_bit_cast(float, w0.y & 0xffff0000u)};
                        const f32x4 o1 = {__builtin_bit_cast(float, w0.z << 16), __builtin_bit_cast(float, w0.z & 0xffff0000u), __builtin_bit_cast(float, w0.w << 16), __builtin_bit_cast(float, w0.w & 0xffff0000u)};
                        const f32x4 v0 = o0 + acc[ai][bj][m][0] * alpha, v1 = o1 + acc[ai][bj][m][1] * alpha;
                        acc[ai][bj][m][0] = v0; acc[ai][bj][m][1] = v1;
                        ss += ((v0[0] * v0[0] + v0[1] * v0[1]) + (v0[2] * v0[2] + v0[3] * v0[3])) + ((v1[0] * v1[0] + v1[1] * v1[1]) + (v1[2] * v1[2] + v1[3] * v1[3])); }
                    ss += __shfl_xor(ss, 16); ss += __shfl_xor(ss, 32);
                    if (fq == 0) atomicAdd(sqa + row, (u64)(ss * 1048576.f)); }
        }
        asm volatile("s_waitcnt vmcnt(0)" ::: "memory");
        __builtin_amdgcn_s_barrier();
        unsigned* cw = cnt + 64 * u.pm;
        if (tid == 0) (void)__hip_atomic_fetch_add(cw, 1u, __ATOMIC_RELAXED, __HIP_MEMORY_SCOPE_AGENT);
        if (tid < 64) {
            unsigned sp = 0;
            while ((unsigned)__builtin_amdgcn_readfirstlane(__hip_atomic_load(cw, __ATOMIC_RELAXED, __HIP_MEMORY_SCOPE_AGENT)) < 4u) { __builtin_amdgcn_s_sleep(1); if (++sp > (1u << 20)) break; }
            __builtin_amdgcn_fence(__ATOMIC_ACQUIRE, "agent");
            asm volatile("s_waitcnt vmcnt(0)" ::: "memory");
        }
        asm volatile("" ::: "memory"); __builtin_amdgcn_s_barrier(); asm volatile("" ::: "memory");
        f32x4 gv[2][2];
#pragma unroll
        for (int bj = 0; bj < 2; ++bj) { gv[bj][0] = *(const f32x4*)(gain + col0 + bj * HALF); gv[bj][1] = *(const f32x4*)(gain + col0 + bj * HALF + 4); }
#pragma unroll
        for (int ai = 0; ai < 2; ++ai)
#pragma unroll
            for (int m = 0; m < 4; ++m) { const unsigned row = row0 + ai * HALF + m * 16;
                const u64 tot = __hip_atomic_load(sqa + row, __ATOMIC_RELAXED, __HIP_MEMORY_SCOPE_AGENT);
                const float sc = __builtin_amdgcn_rsqf((float)tot * (1.f / (1048576.f * 1024.f)) + 1e-6f);
#pragma unroll
                for (int bj = 0; bj < 2; ++bj) { const unsigned off = row * 1024u + col0 + bj * HALF;
                    *(f32x4*)(out + off) = acc[ai][bj][m][0] * sc * gv[bj][0]; *(f32x4*)(out + (off + 4u)) = acc[ai][bj][m][1] * sc * gv[bj][1]; } }
    }
};
struct EpiNull {
    static constexpr bool PERM = true, AFTER_DRAIN = false, HAS_PRE = false, IS_FINAL = false;
    float* sink;
    __device__ __forceinline__ void operator()(const f32x4 (&acc)[2][2][4][2], const Unit& u, int wr, int wc, int fr, int fq) const {
        float s = 0.f;
#pragma unroll
        for (int a = 0; a < 2; ++a)
#pragma unroll
            for (int b = 0; b < 2; ++b)
#pragma unroll
                for (int m = 0; m < 4; ++m)
#pragma unroll
                    for (int n = 0; n < 2; ++n) s += acc[a][b][m][n][0] + acc[a][b][m][n][1] + acc[a][b][m][n][2] + acc[a][b][m][n][3];
        if (s == 123.456f) sink[0] = s;
    }
};
struct EpiProj {
    static constexpr bool PERM = true, AFTER_DRAIN = false, HAS_PRE = true, IS_FINAL = false;
    bf16_t* O; unsigned ldc; const u64* sq; u64* sqz; int qcols; float qscale;
    __device__ __forceinline__ void pre_first(const Unit& u, PG8_LAS unsigned char* lds, int tid) const {
        if (tid < 256) ((PG8_LAS float*)(lds + SCALE_LDS))[tid] = row_scale(sq, u.pm * BM + tid);
    }
    __device__ __forceinline__ void operator()(const f32x4 (&acc)[2][2][4][2], const Unit& u, const Unit& nx, bool has_next, int par, PG8_LAS unsigned char* lds, int tid, int wr, int wc, int fr, int fq) const {
        u64 nsq = 0; const bool ld = has_next && tid < 256; if (ld) nsq = sq[nx.pm * BM + tid];
        const PG8_LAS float* sc = (const PG8_LAS float*)(lds + SCALE_LDS) + par * 256;
        const unsigned rl0 = wr * 64 + fr, row0 = u.pm * BM + rl0, col0 = u.pn * BM + wc * 32 + 8 * fq; const auto rs_ = WT_RSRC(O);
        const float cs = (u.pn * BM < qcols) ? qscale : 1.f;
        const bool zr = (u.pn == 0) && (wc == 0) && (fq == 0);
#pragma unroll
        for (int ai = 0; ai < 2; ++ai) {
#pragma unroll
            for (int m = 0; m < 4; ++m) { const unsigned row = row0 + ai * HALF + m * 16; const float s = sc[rl0 + ai * HALF + m * 16] * cs; if (zr) sqz[row] = 0ull;
#pragma unroll
                for (int bj = 0; bj < 2; ++bj) { const f32x4 v0 = acc[ai][bj][m][0] * s, v1 = acc[ai][bj][m][1] * s;
                    u32x4 w; w.x = cvt_pk_bf16(v0[0], v0[1]); w.y = cvt_pk_bf16(v0[2], v0[3]); w.z = cvt_pk_bf16(v1[0], v1[1]); w.w = cvt_pk_bf16(v1[2], v1[3]);
                    WT_STORE16(rs_, (row * ldc + col0 + bj * HALF) * 2u, w); } }
            __builtin_amdgcn_sched_barrier(0);
        }
        if (ld) ((PG8_LAS float*)(lds + SCALE_LDS))[(par ^ 1) * 256 + tid] = __builtin_amdgcn_rsqf((float)nsq * (1.f / (1048576.f * 1024.f)) + 1e-6f);
    }
};
template <class Epi, class Sched, bool ALIGN_EPI = false, bool SP2 = false>
__device__ __forceinline__ void gemm_phase(PG8_LAS unsigned char* lds, Gemm g, const Sched& S, const Epi& E) {
    asm volatile("" : "+s"(g.A), "+s"(g.Bt));
    int tid = threadIdx.x; asm volatile("" : "+v"(tid));
    const int wid = __builtin_amdgcn_readfirstlane(tid >> 6), lane = tid & 63, wr = wid >> 2, wc = wid & 3, fr = lane & 15, fq = lane >> 4;
    const int K = g.K, nt = K / BK;
    unsigned voffA[2], voffB[2];
#pragma unroll
    for (int i = 0; i < 2; ++i) { int R, C; stage_rc(tid * 16 + i * 8192, R, C); const int Rb = Epi::PERM ? ((R & ~31) + perm32(R & 31)) : R;
        voffA[i] = (unsigned)(R * K + C) * 2u; voffB[i] = (unsigned)(Rb * K + C) * 2u; }
    const size_t kstep = (size_t)(BK * 2);
    const size_t hstep = (size_t)HALF * K * 2;
    const size_t tstep = 2 * hstep;
    const unsigned ldsw = (unsigned)wid * 1024u;
    const int aoff = lds_byte(wr * 64 + fr, fq * 8), boff = lds_byte(wc * 32 + fr, fq * 8);
#define PG8_SA(b, h) (((b) * 2 + (h)) * HTB)
#define PG8_SB(b, h) ((4 + (b) * 2 + (h)) * HTB)
#define PG8_STAGE(bufoff, gbase, voff) do { _Pragma("unroll") for (int _i = 0; _i < 2; ++_i) \
        __builtin_amdgcn_global_load_lds((const unsigned*)((const char*)(gbase) + (voff)[_i]), (PG8_LAS unsigned*)(lds + (bufoff) + ldsw + _i * 8192), 16, 0, 0); } while (0)
#define PG8_LDA(dst, b, h) do { _Pragma("unroll") for (int m = 0; m < 4; ++m) _Pragma("unroll") for (int k = 0; k < 2; ++k) dst[m][k] = *(const PG8_LAS bf16x8*)(lds + PG8_SA(b, h) + aoff + m * 2048 + k * 1024); } while (0)
#define PG8_LDB(dst, b, h) do { _Pragma("unroll") for (int n = 0; n < 2; ++n) _Pragma("unroll") for (int k = 0; k < 2; ++k) dst[n][k] = *(const PG8_LAS bf16x8*)(lds + PG8_SB(b, h) + boff + n * 2048 + k * 1024); } while (0)
#define PG8_MMA(ai, bj, At, Bt) do { __builtin_amdgcn_s_setprio(1); _Pragma("unroll") for (int m = 0; m < 4; ++m) _Pragma("unroll") for (int n = 0; n < 2; ++n) _Pragma("unroll") for (int k = 0; k < 2; ++k) \
        acc[ai][bj][m][n] = __builtin_amdgcn_mfma_f32_16x16x32_bf16(Bt[n][k], At[m][k], acc[ai][bj][m][n], 0, 0, 0); __builtin_amdgcn_s_setprio(0); } while (0)
#define PG8_WAIT_V(n) asm volatile("s_waitcnt vmcnt(" #n ")" ::: "memory")
#define PG8_WAIT_L(n) asm volatile("s_waitcnt lgkmcnt(" #n ")" ::: "memory")
#define PG8_BAR __builtin_amdgcn_s_barrier()
#define PG8_SCHED __builtin_amdgcn_sched_barrier(0)
    Unit cur, nxt; int ui = 0;
    if (!S.next(0, cur)) return;
    f32x4 acc[2][2][4][2];
#pragma unroll
    for (int a = 0; a < 2; ++a)
#pragma unroll
        for (int b = 0; b < 2; ++b)
#pragma unroll
            for (int m = 0; m < 4; ++m)
#pragma unroll
                for (int n = 0; n < 2; ++n) acc[a][b][m][n] = (f32x4){0.f, 0.f, 0.f, 0.f};
    bf16x8 At[4][2], B0[2][2], B1[2][2];
    const char* cA = (const char*)g.A + (size_t)cur.pm * tstep; const char* cB = (const char*)g.Bt + (size_t)cur.pn * tstep;
    S.a_ready(cur);
    if constexpr (Epi::HAS_PRE) E.pre_first(cur, lds, tid);
    if constexpr (SP2) {
        PG8_STAGE(PG8_SB(0, 0), cB, voffB); PG8_STAGE(PG8_SB(0, 1), cB + hstep, voffB); PG8_STAGE(PG8_SA(0, 0), cA, voffA); PG8_STAGE(PG8_SA(0, 1), cA + hstep, voffA);
        if (wr == 1) PG8_BAR;
        PG8_WAIT_V(2); PG8_BAR;
        PG8_STAGE(PG8_SB(1, 0), cB + kstep, voffB); PG8_STAGE(PG8_SA(1, 0), cA + kstep, voffA); PG8_STAGE(PG8_SB(1, 1), cB + hstep + kstep, voffB);
        PG8_WAIT_V(6); PG8_BAR;
    } else {
        PG8_STAGE(PG8_SB(0, 0), cB, voffB); PG8_STAGE(PG8_SA(0, 0), cA, voffA); PG8_STAGE(PG8_SB(0, 1), cB + hstep, voffB); PG8_STAGE(PG8_SA(0, 1), cA + hstep, voffA);
        if (wr == 1) PG8_BAR;
        PG8_WAIT_V(4); PG8_BAR;
        PG8_STAGE(PG8_SB(1, 0), cB + kstep, voffB); PG8_STAGE(PG8_SA(1, 0), cA + kstep, voffA); PG8_STAGE(PG8_SB(1, 1), cB + hstep + kstep, voffB);
        PG8_WAIT_V(6); PG8_BAR;
    }
    for (;;) {
        const bool has_next = S.next(ui + 1, nxt);
        const char* nA = has_next ? (const char*)g.A + (size_t)nxt.pm * tstep : cA; const char* nB = has_next ? (const char*)g.Bt + (size_t)nxt.pn * tstep : cB;
        for (int t = 0; t < nt; t += 2) {
            const bool last = (t == nt - 2);
            const char* a1 = cA + (size_t)(t + 1) * kstep;
            const char* a2 = last ? nA : cA + (size_t)(t + 2) * kstep; const char* b2 = last ? nB : cB + (size_t)(t + 2) * kstep;
            const char* a3 = a2 + kstep; const char* b3 = b2 + kstep;
            if (last && has_next) S.a_ready(nxt);
            if constexpr (SP2) {
            PG8_LDB(B0, 0, 0); PG8_LDB(B1, 0, 1); PG8_SCHED; PG8_LDA(At, 0, 0); PG8_STAGE(PG8_SA(1, 1), a1 + hstep, voffA);
            PG8_WAIT_V(8); PG8_WAIT_L(0); PG8_BAR; PG8_MMA(0, 0, At, B0); PG8_MMA(0, 1, At, B1); PG8_BAR; PG8_SCHED;
            PG8_LDA(At, 0, 1); PG8_STAGE(PG8_SB(0, 0), b2, voffB); PG8_STAGE(PG8_SB(0, 1), b2 + hstep, voffB); PG8_STAGE(PG8_SA(0, 0), a2, voffA);
            PG8_WAIT_V(8); PG8_WAIT_L(0); PG8_BAR; PG8_MMA(1, 0, At, B0); PG8_MMA(1, 1, At, B1); PG8_BAR; PG8_SCHED;
            PG8_LDB(B0, 1, 0); PG8_LDB(B1, 1, 1); PG8_SCHED; PG8_LDA(At, 1, 0); PG8_STAGE(PG8_SA(0, 1), a2 + hstep, voffA);
            PG8_WAIT_V(8); PG8_WAIT_L(0); PG8_BAR; PG8_MMA(0, 0, At, B0); PG8_MMA(0, 1, At, B1); PG8_BAR; PG8_SCHED;
            PG8_LDA(At, 1, 1); PG8_STAGE(PG8_SB(1, 0), b3, voffB); PG8_STAGE(PG8_SB(1, 1), b3 + hstep, voffB); PG8_STAGE(PG8_SA(1, 0), a3, voffA);
            PG8_WAIT_V(8); PG8_WAIT_L(0); PG8_BAR; PG8_MMA(1, 0, At, B0); PG8_MMA(1, 1, At, B1); PG8_BAR; PG8_SCHED;
            } else {
            PG8_LDB(B0, 0, 0); PG8_SCHED; PG8_LDA(At, 0, 0); PG8_STAGE(PG8_SA(1, 1), a1 + hstep, voffA);
            PG8_WAIT_L(8); PG8_BAR; PG8_WAIT_L(0); PG8_MMA(0, 0, At, B0); PG8_BAR; PG8_SCHED;
            PG8_LDB(B1, 0, 1); PG8_STAGE(PG8_SB(0, 0), b2, voffB);
            PG8_BAR; PG8_WAIT_L(0); PG8_MMA(0, 1, At, B1); PG8_BAR;
            PG8_LDA(At, 0, 1); PG8_STAGE(PG8_SA(0, 0), a2, voffA);
            PG8_BAR; PG8_WAIT_L(0); PG8_MMA(1, 0, At, B0); PG8_BAR; PG8_SCHED;
            PG8_STAGE(PG8_SB(0, 1), b2 + hstep, voffB);
            PG8_WAIT_V(6); PG8_BAR; PG8_MMA(1, 1, At, B1); PG8_BAR;
            PG8_LDB(B0, 1, 0); PG8_SCHED; PG8_LDA(At, 1, 0); PG8_STAGE(PG8_SA(0, 1), a2 + hstep, voffA);
            PG8_WAIT_L(8); PG8_BAR; PG8_WAIT_L(0); PG8_MMA(0, 0, At, B0); PG8_BAR; PG8_SCHED;
            PG8_LDB(B1, 1, 1); PG8_STAGE(PG8_SB(1, 0), b3, voffB);
            PG8_BAR; PG8_WAIT_L(0); PG8_MMA(0, 1, At, B1); PG8_BAR;
            PG8_LDA(At, 1, 1); PG8_STAGE(PG8_SA(1, 0), a3, voffA);
            PG8_BAR; PG8_WAIT_L(0); PG8_MMA(1, 0, At, B0); PG8_BAR; PG8_SCHED;
            PG8_STAGE(PG8_SB(1, 1), b3 + hstep, voffB);
            PG8_WAIT_V(6); PG8_BAR; PG8_MMA(1, 1, At, B1); PG8_BAR;
            }
        }
        if constexpr (ALIGN_EPI) { if (wr == 0) PG8_BAR; }
        if constexpr (Epi::HAS_PRE) { E(acc, cur, nxt, has_next, ui & 1, lds, tid, wr, wc, fr, fq); S.done(cur); }
        else if constexpr (Epi::IS_FINAL) { E.fin(acc, cur, tid, wr, wc, fr, fq); S.done(cur); }
        else if constexpr (!Epi::AFTER_DRAIN) { E(acc, cur, wr, wc, fr, fq); S.done(cur); }
        if (!has_next) break;
#pragma unroll
        for (int a = 0; a < 2; ++a)
#pragma unroll
            for (int b = 0; b < 2; ++b)
#pragma unroll
                for (int m = 0; m < 4; ++m)
#pragma unroll
                    for (int n = 0; n < 2; ++n) acc[a][b][m][n] = (f32x4){0.f, 0.f, 0.f, 0.f};
        cur = nxt; cA = nA; cB = nB; ++ui;
        if constexpr (ALIGN_EPI) { if (wr == 1) PG8_BAR; }
    }
    PG8_WAIT_V(0);
    if constexpr (!ALIGN_EPI) { if (wr == 0) PG8_BAR; }
    PG8_BAR;
    if constexpr (Epi::AFTER_DRAIN) { E.fused(acc, cur, wr, wc, fr, fq, lds, wid, lane); S.done(cur); }
#undef PG8_SA
#undef PG8_SB
#undef PG8_STAGE
#undef PG8_LDA
#undef PG8_LDB
#undef PG8_MMA
#undef PG8_WAIT_V
#undef PG8_WAIT_L
#undef PG8_BAR
#undef PG8_SCHED
}
}
namespace attn_body {
using bf16=__hip_bfloat16;
using bf16x8=__attribute__((ext_vector_type(8)))short;
using s16x4=__attribute__((ext_vector_type(4)))short;
using f32x16=__attribute__((ext_vector_type(16)))float;
using u32x4=__attribute__((ext_vector_type(4)))unsigned;
constexpr int BATCH=2,NHEAD=16,SEQ=8192,D=64,DM=NHEAD*D;
constexpr int NW=8,QBLK=32,QB=QBLK*NW,KVBLK=64,NQB=SEQ/QB;
constexpr int ATTN_PITCH=DM, ATTN_UNIT_ROWS=QB;
__device__ __forceinline__ int crow(int r,int hi){return (r&3)+8*(r>>2)+4*hi;}
#define SBAR() __builtin_amdgcn_sched_barrier(0)
constexpr int NSLOT=3, SLOTB=8192;
constexpr int LDS_K=0, LDS_V=NSLOT*SLOTB, LDS_WS=2*NSLOT*SLOTB, LDS_OST=LDS_WS+NW*64*4, LDS_BYTES=LDS_OST+NW*4096;
constexpr float C2=0.125f*1.4426950408889634f;
__device__ __forceinline__ void glds16(const void*gsrc,unsigned lds_dst){unsigned keep;
  asm volatile("s_mov_b32 %0, m0\n\ts_mov_b32 m0, %2\n\ts_nop 0\n\tglobal_load_lds_dwordx4 %1, off\n\ts_mov_b32 m0, %0":"=&s"(keep):"v"(gsrc),"s"(lds_dst):"memory");}
__device__ __forceinline__ float max3f(float a,float b,float c){float r;asm("v_max3_f32 %0, %1, %2, %3":"=v"(r):"v"(a),"v"(b),"v"(c));return r;}
__device__ __forceinline__ float max2f(float a,float b){float r;asm("v_max_f32_e32 %0, %1, %2":"=v"(r):"v"(a),"v"(b));return r;}
__device__ __forceinline__ float fadd_s(float a,float b){float r;asm("v_add_f32_e32 %0, %1, %2":"=v"(r):"v"(a),"v"(b));return r;}
__device__ __forceinline__ float fsub_s(float a,float b){float r;asm("v_sub_f32_e32 %0, %1, %2":"=v"(r):"v"(a),"v"(b));return r;}
typedef float f32x2_t __attribute__((ext_vector_type(2))); typedef __bf16 bf16x2_t __attribute__((ext_vector_type(2)));
__device__ __forceinline__ unsigned cvtpk_s(float lo,float hi){f32x2_t v={lo,hi};bf16x2_t b=__builtin_convertvector(v,bf16x2_t);return __builtin_bit_cast(unsigned,b);}
#define WAIT_BAR(N) asm volatile("s_waitcnt vmcnt(" #N ") lgkmcnt(0)\n\ts_barrier":::"memory")

__device__ __forceinline__ void qkt(f32x16&p0,f32x16&p1,const char*Kslot,const bf16x8*qr,const f32x16&negm,int r32,int hi){
  const char*kb=Kslot+hi*1024+r32*16;
  #pragma unroll
  for(int d0=0;d0<4;++d0){
    const bf16x8 b0=*reinterpret_cast<const bf16x8*>(kb+d0*2048);
    const bf16x8 b1=*reinterpret_cast<const bf16x8*>(kb+d0*2048+512);
    if(d0==0){p0=__builtin_amdgcn_mfma_f32_32x32x16_bf16(b0,qr[0],negm,0,0,0);p1=__builtin_amdgcn_mfma_f32_32x32x16_bf16(b1,qr[0],negm,0,0,0);}
    else{p0=__builtin_amdgcn_mfma_f32_32x32x16_bf16(b0,qr[d0],p0,0,0,0);p1=__builtin_amdgcn_mfma_f32_32x32x16_bf16(b1,qr[d0],p1,0,0,0);}}
}
typedef __attribute__((address_space(3))) const char* lds_cptr;
typedef short v4i16_t __attribute__((ext_vector_type(4)));
__device__ __forceinline__ void kload8(bf16x8*kf,lds_cptr kp){
  kf[0]=*(const __attribute__((address_space(3))) bf16x8*)(kp);      kf[1]=*(const __attribute__((address_space(3))) bf16x8*)(kp+512);
  kf[2]=*(const __attribute__((address_space(3))) bf16x8*)(kp+2048); kf[3]=*(const __attribute__((address_space(3))) bf16x8*)(kp+2560);
  kf[4]=*(const __attribute__((address_space(3))) bf16x8*)(kp+4096); kf[5]=*(const __attribute__((address_space(3))) bf16x8*)(kp+4608);
  kf[6]=*(const __attribute__((address_space(3))) bf16x8*)(kp+6144); kf[7]=*(const __attribute__((address_space(3))) bf16x8*)(kp+6656);
}
__device__ __forceinline__ void kload2(bf16x8*kf,lds_cptr kp,int j){ kf[2*j]=*(const __attribute__((address_space(3))) bf16x8*)(kp+j*2048); kf[2*j+1]=*(const __attribute__((address_space(3))) bf16x8*)(kp+j*2048+512); }
__device__ __forceinline__ s16x4 vtr(lds_cptr p){ return __builtin_bit_cast(s16x4,__builtin_amdgcn_ds_read_tr16_b64_v4i16((__attribute__((address_space(3))) v4i16_t*)p)); }
__device__ __forceinline__ float rowmax(const f32x16&p0,const f32x16&p1){
  float a=max3f(p0[0],p0[1],p1[0]),b=max3f(p0[2],p0[3],p1[1]);a=max3f(a,p1[2],p1[3]);
  #pragma unroll
  for(int r=4;r<16;r+=4){a=max3f(a,p0[r],p0[r+1]);b=max3f(b,p0[r+2],p0[r+3]);a=max3f(a,p1[r],p1[r+1]);b=max3f(b,p1[r+2],p1[r+3]);}
  const float m=max2f(a,b);
  auto rr=__builtin_amdgcn_permlane32_swap(__float_as_uint(m),__float_as_uint(m),false,false);
  return max2f(__uint_as_float(rr[0]),__uint_as_float(rr[1]));
}
__device__ __forceinline__ void pv(f32x16*o,int vb,bf16x8 pa0,bf16x8 pa1,bf16x8 pa2,bf16x8 pa3){
  #pragma unroll
  for(int d0=0;d0<2;++d0){s16x4 lo[4],hi[4];
    #pragma unroll
    for(int ks=0;ks<4;++ks){
      asm volatile("ds_read_b64_tr_b16 %0,%1 offset:%c2":"=&v"(lo[ks]):"v"(vb),"i"(d0*4096+ks*1024):"memory");
      asm volatile("ds_read_b64_tr_b16 %0,%1 offset:%c2":"=&v"(hi[ks]):"v"(vb),"i"(d0*4096+ks*1024+512):"memory");}
    asm volatile("s_waitcnt lgkmcnt(0)":::"memory");SBAR();
    #define PK(k) (bf16x8){lo[k][0],lo[k][1],lo[k][2],lo[k][3],hi[k][0],hi[k][1],hi[k][2],hi[k][3]}
    o[d0]=__builtin_amdgcn_mfma_f32_32x32x16_bf16(pa0,PK(0),o[d0],0,0,0);
    o[d0]=__builtin_amdgcn_mfma_f32_32x32x16_bf16(pa1,PK(1),o[d0],0,0,0);
    o[d0]=__builtin_amdgcn_mfma_f32_32x32x16_bf16(pa2,PK(2),o[d0],0,0,0);
    o[d0]=__builtin_amdgcn_mfma_f32_32x32x16_bf16(pa3,PK(3),o[d0],0,0,0);
    #undef PK
  }
}
constexpr int NA_DR=656, NA_TAB=15*NA_DR;
constexpr int LDS_BIAS=LDS_BYTES+1024, ATTN_LDS_TOTAL=LDS_BIAS+NA_TAB*4+2048;
constexpr int OPITCH=1024;
typedef __attribute__((address_space(3))) float* lds_fptr;
template<int MODE> __device__ __forceinline__ void amask(f32x16&p0,f32x16&p1,const int kt,const int qpos,const int hi,lds_fptr bias,const int tb0,const int tb1,const int qrow){
  if(MODE==1){
    const int kb=kt*64+4*hi, lo=qpos-128, hq=qpos+128;
    #pragma unroll
    for(int r=0;r<16;++r){const int kv=kb+(r&3)+8*(r>>2); if(kv<lo||kv>hq)p0[r]=-INFINITY; if(kv+32<lo||kv+32>hq)p1[r]=-INFINITY;}
  }
  if(MODE==2){
    const int rs=min(max(qrow-4,0),248);
    if(kt<rs||kt>=rs+8){
      #pragma unroll
      for(int r=0;r<16;++r){p0[r]=-INFINITY;p1[r]=-INFINITY;}
    } else {
      const int dr=kt-qrow+7; lds_fptr b0=bias+dr*NA_DR+tb0, b1=bias+dr*NA_DR+tb1;
      #pragma unroll
      for(int r=0;r<16;++r){const int o=(r&3)+8*(r>>2); p0[r]+=b0[o]; p1[r]+=b1[o];}
    }
  }
}
#define ATTN_STORE16(base,byteoff,v) __builtin_amdgcn_raw_buffer_store_b128((v), __builtin_amdgcn_make_buffer_rsrc((void*)(base), 0, 0x7fffffff, 0x00020000), (int)(byteoff), 0, 16)
template<int MODE,int THRL> __device__ __forceinline__ void attn_unit(const bf16*Qh,const bf16*__restrict__ Kh,const bf16*__restrict__ Vh,bf16*Oh,const int DM,const int q0,const int tile0,const int NT,const float sink_l2,const float*biasg,const bool build,const bool pre,const bool preV,const bf16*nKh,const bf16*nVh,const int ntile0,char*shm){
  int tid=threadIdx.x; asm volatile("":"+v"(tid)); const int lane=tid&63,r32=lane&31,hi=lane>>5; const int wid=__builtin_amdgcn_readfirstlane(tid>>6);
  const bf16*Qw=Qh+(long)(q0+wid*QBLK)*DM;
  const unsigned lds0=(unsigned)(uintptr_t)shm;
  float*wsf=(float*)(shm+LDS_WS)+wid*64;
  const bf16*ksrc=Kh+(long)(tile0*KVBLK+lane)*DM+wid*8;
  const bf16*vsrc=Vh+(long)(tile0*KVBLK+16*(wid&3)+(lane>>2))*DM+(wid>>2)*32+(lane&3)*8;
  const unsigned kdst=lds0+LDS_K+wid*1024, vdst=lds0+LDS_V+wid*1024;
  #define DMA_K(t,slot) glds16(ksrc+(long)(t)*KVBLK*DM,(unsigned)__builtin_amdgcn_readfirstlane(kdst+(slot)))
  #define DMA_V(t,slot) glds16(vsrc+(long)(t)*KVBLK*DM,(unsigned)__builtin_amdgcn_readfirstlane(vdst+(slot)))
  const int vb0=(int)(lds0+LDS_V)+((lane>>4)&1)*32+(lane&3)*8+(4*hi+((lane&15)>>2))*64;
  const char*Kbase=shm+LDS_K; bf16x8 kf[8];
  const lds_cptr shm3=(lds_cptr)shm; const lds_cptr kp0=shm3+LDS_K+hi*1024+r32*16; const lds_cptr vp0=shm3+LDS_V+((lane>>4)&1)*32+(lane&3)*8+(4*hi+((lane&15)>>2))*64;
  lds_fptr biasl=(lds_fptr)((lds_cptr)shm+LDS_BIAS);
  if(MODE==2&&build){
    lds_fptr stg=biasl+NA_TAB; if(tid<465) stg[tid]=biasg[tid]*1.4426950408889634f;
    asm volatile("s_waitcnt vmcnt(0) lgkmcnt(0)\n\ts_barrier":::"memory");
    for(int e=tid;e<NA_TAB;e+=512){ const int dr=e/NA_DR, w=e-dr*NA_DR; int idx=-1;
      if(w<112){ if(w>=48&&w<64) idx=w-41; } else if(w<144){ } else if(w<400){ const int q=(w-144)>>5, kc=(w-144)&31; if(kc<16) idx=kc-q+15; } else { const int q=(w-400)>>5, j=(w-400)&31; if(j>=16) idx=j-q-9; }
      biasl[e]=(idx>=0)?stg[dr*31+idx]:-INFINITY; } }
  if(!pre){DMA_K(0,0);} if(!preV){DMA_V(0,0);} if(!pre){DMA_K(1,SLOTB);}
  bf16x8 qr[4];
  #pragma unroll
  for(int d0=0;d0<4;++d0)qr[d0]=*reinterpret_cast<const bf16x8*>(&Qw[(long)r32*DM+d0*16+hi*8]);
  float mhat=0.f,l_reg=0.f;f32x16 o[2];o[0]=f32x16{};o[1]=f32x16{};f32x16 negm=f32x16{};asm volatile("":"+v"(negm));
  const int qpos=q0+wid*QBLK+r32; const int qrow=(q0>>6)+(wid>>1);
  int tb0=0,tb1=0; if(MODE==2){ const int qc=qpos&63; if(qc<8){tb0=144+qc*32;tb1=112;} else if(qc>=56){tb0=112;tb1=400+(qc-56)*32;} else {tb0=56-qc;tb1=tb0+32;} tb0+=4*hi;tb1+=4*hi; }
  #define CMASK(P0,P1,t) amask<MODE>(P0,P1,tile0+(t),qpos,hi,biasl,tb0,tb1,qrow)
  bool resc=false;
  #define START(P0,P1) do{ const float rm=rowmax(P0,P1); resc=false; \
    { const float dl=(MODE==0)?rm:__builtin_fmaxf(rm,-64.f); mhat=fadd_s(mhat,dl); \
      _Pragma("unroll") for(int r=0;r<16;++r){P0[r]=fsub_s(P0[r],dl);P1[r]=fsub_s(P1[r],dl);} \
      _Pragma("unroll") for(int r=0;r<16;++r)negm[r]=-mhat; asm volatile("":"+v"(negm)); } \
    _Pragma("unroll") for(int r=0;r<16;++r)P0[r]=__builtin_amdgcn_exp2f(P0[r]); }while(0)
  #define RESC() do{ if(resc){ asm volatile("s_waitcnt lgkmcnt(0)":::"memory"); \
      _Pragma("unroll") for(int d_=0;d_<2;++d_) _Pragma("unroll") for(int r=0;r<16;++r)o[d_][r]*=wsf[crow(r,hi)]; } }while(0)
  f32x16 pA0,pA1,pB0,pB1;
  int sl_prev=0,sl_cur=0,sl_next=SLOTB;
  #define ROT() do{sl_prev=sl_cur;sl_cur=sl_next;sl_next=(sl_next==(NSLOT-1)*SLOTB)?0:sl_next+SLOTB;}while(0)
  DMA_K(2,2*SLOTB);
  WAIT_BAR(3);
  qkt(pA0,pA1,Kbase,qr,negm,r32,hi);asm volatile("s_nop 15\n\ts_nop 7":"+v"(pA0),"+v"(pA1));CMASK(pA0,pA1,0);
  START(pA0,pA1);
  _Pragma("unroll") for(int r=0;r<16;++r)pA1[r]=__builtin_amdgcn_exp2f(pA1[r]);
  WAIT_BAR(0);
  DMA_K(3,0);DMA_V(1,SLOTB);
  ROT();
  kload8(kf,kp0+sl_cur);
  WAIT_BAR(2);
  s16x4 vlo[8],vhi[8]; u32x4 pw0,pw1,pw2,pw3;
  #define PKW(P,B) cvtpk_s(P[B],P[B+1])
  #define PAF(k) __builtin_bit_cast(bf16x8,pw##k)
  #define VFR(i) (bf16x8){vlo[i][0],vlo[i][1],vlo[i][2],vlo[i][3],vhi[i][0],vhi[i][1],vhi[i][2],vhi[i][3]}
  #define PIN(x) asm volatile("":"+v"(x))
  #define MX3(a,b,c) __builtin_fmaxf(__builtin_fmaxf((a),(b)),(c))
  #define GAPA(MF,A0,A1,A2,A3,W0,W1,PW) do{ MF; sacc+=A0; sacc+=A1; sacc+=A2; sacc+=A3; PIN(sacc); W0; W1; PIN(PW); SBAR(); }while(0)
  #define EX(v) __builtin_amdgcn_exp2f(v)
  #define GAPB(MF,X,B) do{ MF; X[B]=EX(X[B]); X[B+1]=EX(X[B+1]); X[B+2]=EX(X[B+2]); X[B+3]=EX(X[B+3]); PIN(X); SBAR(); }while(0)
  #define VRD(i) do{ vlo[i]=vtr(vp_+(((i)>>2)*4096+((i)&3)*1024)); vhi[i]=vtr(vp_+(((i)>>2)*4096+((i)&3)*1024+512)); }while(0)
  #define KRD(G,j) do{ if(G){ kload2(kf,kp0+sl_next,j); SBAR(); } }while(0)
  #define STEP(C0,C1,P0,P1,t,GK,GV,GL) do{ SBAR(); \
    const lds_cptr vp_=vp0+sl_prev; \
    VRD(0); SBAR(); float sacc=(P0[0]+P0[1]); \
    GAPA(C0=__builtin_amdgcn_mfma_f32_32x32x16_bf16(kf[0],qr[0],negm,0,0,0), P0[2],P0[3],P0[4],P0[5],     pw0[0]=PKW(P0,0), pw0[1]=PKW(P0,2), pw0); \
    VRD(4); SBAR(); GAPA(C1=__builtin_amdgcn_mfma_f32_32x32x16_bf16(kf[1],qr[0],negm,0,0,0), P0[6],P0[7],P0[8],P0[9],     pw0[2]=PKW(P0,4), pw0[3]=PKW(P0,6), pw0); \
    VRD(1); SBAR(); GAPA(C0=__builtin_amdgcn_mfma_f32_32x32x16_bf16(kf[2],qr[1],C0,0,0,0),   P0[10],P0[11],P0[12],P0[13], pw1[0]=PKW(P0,8), pw1[1]=PKW(P0,10), pw1); \
    VRD(5); SBAR(); GAPA(C1=__builtin_amdgcn_mfma_f32_32x32x16_bf16(kf[3],qr[1],C1,0,0,0),   P0[14],P0[15],P1[0],P1[1],   pw1[2]=PKW(P0,12),pw1[3]=PKW(P0,14), pw1); \
    VRD(2); SBAR(); GAPA(C0=__builtin_amdgcn_mfma_f32_32x32x16_bf16(kf[4],qr[2],C0,0,0,0),   P1[2],P1[3],P1[4],P1[5],     pw2[0]=PKW(P1,0), pw2[1]=PKW(P1,2), pw2); \
    VRD(6); SBAR(); GAPA(C1=__builtin_amdgcn_mfma_f32_32x32x16_bf16(kf[5],qr[2],C1,0,0,0),   P1[6],P1[7],P1[8],P1[9],     pw2[2]=PKW(P1,4), pw2[3]=PKW(P1,6), pw2); \
    VRD(3); SBAR(); GAPA(C0=__builtin_amdgcn_mfma_f32_32x32x16_bf16(kf[6],qr[3],C0,0,0,0),   P1[10],P1[11],P1[12],P1[13], pw3[0]=PKW(P1,8), pw3[1]=PKW(P1,10), pw3); \
    VRD(7); SBAR(); GAPA(C1=__builtin_amdgcn_mfma_f32_32x32x16_bf16(kf[7],qr[3],C1,0,0,0),   P1[14],P1[15],0.f,0.f,       pw3[2]=PKW(P1,12),pw3[3]=PKW(P1,14), pw3); \
    l_reg+=sacc; \
    if(GK){DMA_K((t)+3,sl_cur);} if(GV){DMA_V((t)+1,sl_next);} \
    CMASK(C0,C1,t); \
    { float a=MX3(C0[0],C0[1],C1[0]),b=MX3(C0[2],C0[3],C1[1]); a=MX3(a,C1[2],C1[3]); \
      _Pragma("unroll") for(int r=4;r<16;r+=4){a=MX3(a,C0[r],C0[r+1]);b=MX3(b,C0[r+2],C0[r+3]);a=MX3(a,C1[r],C1[r+1]);b=MX3(b,C1[r+2],C1[r+3]);} \
      float rm=__builtin_fmaxf(a,b); { auto rr=__builtin_amdgcn_permlane32_swap(__float_as_uint(rm),__float_as_uint(rm),false,false); rm=__builtin_fmaxf(__uint_as_float(rr[0]),__uint_as_float(rr[1])); } \
      resc=false; \
      if(__builtin_expect(__any(rm>(float)THRL),0)){ const float dl=__builtin_fmaxf(rm,0.f); mhat+=dl; \
        _Pragma("unroll") for(int r=0;r<16;++r){C0[r]-=dl;C1[r]-=dl;} \
        _Pragma("unroll") for(int r=0;r<16;++r)negm[r]=-mhat; asm volatile("":"+v"(negm)); \
        const float f=__builtin_amdgcn_exp2f(-dl); l_reg*=f; if(hi==0)wsf[r32]=f; resc=true; } } \
    SBAR(); \
    GAPB(o[0]=__builtin_amdgcn_mfma_f32_32x32x16_bf16(PAF(0),VFR(0),o[0],0,0,0), C0,0); \
    GAPB(o[1]=__builtin_amdgcn_mfma_f32_32x32x16_bf16(PAF(0),VFR(4),o[1],0,0,0), C0,4); \
    KRD(GL,0); GAPB(o[0]=__builtin_amdgcn_mfma_f32_32x32x16_bf16(PAF(1),VFR(1),o[0],0,0,0), C0,8); \
    KRD(GL,1); GAPB(o[1]=__builtin_amdgcn_mfma_f32_32x32x16_bf16(PAF(1),VFR(5),o[1],0,0,0), C0,12); \
    KRD(GL,2); GAPB(o[0]=__builtin_amdgcn_mfma_f32_32x32x16_bf16(PAF(2),VFR(2),o[0],0,0,0), C1,0); \
    KRD(GL,3); GAPB(o[1]=__builtin_amdgcn_mfma_f32_32x32x16_bf16(PAF(2),VFR(6),o[1],0,0,0), C1,4); \
    GAPB(o[0]=__builtin_amdgcn_mfma_f32_32x32x16_bf16(PAF(3),VFR(3),o[0],0,0,0), C1,8); \
    GAPB(o[1]=__builtin_amdgcn_mfma_f32_32x32x16_bf16(PAF(3),VFR(7),o[1],0,0,0), C1,12); \
    }while(0)
  int t=1;
  for(;t+5<NT;t+=2){
    STEP(pB0,pB1,pA0,pA1,t,true,true,true);     WAIT_BAR(2); RESC(); ROT();
    STEP(pA0,pA1,pB0,pB1,t+1,true,true,true);   WAIT_BAR(2); RESC(); ROT();
  }
  #define ENDW(tt) do{ if((tt)+3<NT){WAIT_BAR(2);} else if((tt)+2<NT){WAIT_BAR(1);} else {WAIT_BAR(0);} }while(0)
  for(;t+1<NT;t+=2){
    STEP(pB0,pB1,pA0,pA1,t,(t+3<NT),(t+1<NT),(t+1<NT));       ENDW(t);   RESC(); ROT();
    STEP(pA0,pA1,pB0,pB1,t+1,(t+4<NT),(t+2<NT),(t+2<NT));     ENDW(t+1); RESC(); ROT();
  }
  if(nKh){
    const bf16*nks=nKh+(long)(ntile0*KVBLK+lane)*DM+wid*8;
    glds16(nks,(unsigned)__builtin_amdgcn_readfirstlane(kdst));
    if(NT%3==0){ const bf16*nvs=nVh+(long)(ntile0*KVBLK+16*(wid&3)+(lane>>2))*DM+(wid>>2)*32+(lane&3)*8; glds16(nvs,(unsigned)__builtin_amdgcn_readfirstlane(vdst)); }
    glds16(nks+(long)KVBLK*DM,(unsigned)__builtin_amdgcn_readfirstlane(kdst+SLOTB)); }
  STEP(pB0,pB1,pA0,pA1,NT-1,false,false,false); RESC();
  { float sacc=pB0[0]+pB0[1]; _Pragma("unroll") for(int r=2;r<16;++r)sacc+=pB0[r]; _Pragma("unroll") for(int r=0;r<16;++r)sacc+=pB1[r]; l_reg+=sacc;
    pw0=(u32x4){PKW(pB0,0),PKW(pB0,2),PKW(pB0,4),PKW(pB0,6)};pw1=(u32x4){PKW(pB0,8),PKW(pB0,10),PKW(pB0,12),PKW(pB0,14)};pw2=(u32x4){PKW(pB1,0),PKW(pB1,2),PKW(pB1,4),PKW(pB1,6)};pw3=(u32x4){PKW(pB1,8),PKW(pB1,10),PKW(pB1,12),PKW(pB1,14)};
    SBAR(); pv(o,vb0+sl_cur,PAF(0),PAF(1),PAF(2),PAF(3)); }
  #undef PKW
  #undef PAF
  #undef VFR
  #undef PIN
  #undef MX3
  #undef GAPA
  #undef GAPB
  #undef EX
  #undef VRD
  #undef KRD
  #undef STEP
  #undef ENDW
  {auto rr=__builtin_amdgcn_permlane32_swap(__float_as_uint(l_reg),__float_as_uint(l_reg),false,false);l_reg=__uint_as_float(rr[0])+__uint_as_float(rr[1]);}
  if(MODE==1) l_reg+=__builtin_amdgcn_exp2f(sink_l2-mhat);
  if(hi==0)wsf[32+r32]=l_reg;asm volatile("s_waitcnt lgkmcnt(0)":::"memory");
  float rli[16];
  #pragma unroll
  for(int r=0;r<16;++r)rli[r]=__builtin_amdgcn_rcpf(wsf[32+crow(r,hi)]);
  bf16*Ow=Oh+(long)(q0+wid*QBLK)*OPITCH;
  { bf16*stg=(bf16*)(shm+LDS_OST)+wid*2048;
    #pragma unroll
    for(int r=0;r<16;++r){const int orow=crow(r,hi);
      #pragma unroll
      for(int d0=0;d0<2;++d0)stg[orow*64+d0*32+r32]=__float2bfloat16(o[d0][r]*rli[r]);}
    asm volatile("s_waitcnt lgkmcnt(0)":::"memory");
    #pragma unroll
    for(int i=0;i<4;++i){const int row=i*8+(lane>>3),ch=lane&7; const u32x4 v=*(const u32x4*)(stg+row*64+ch*8); ATTN_STORE16(Oh,(unsigned)(((q0+wid*QBLK+row)*OPITCH+ch*8)*2),v);} }
  asm volatile("s_waitcnt lgkmcnt(0)\n\ts_barrier":::"memory");
  #undef DMA_K
  #undef DMA_V
  #undef CMASK
  #undef START
  #undef RESC
  #undef ROT
}
#undef SBAR
#undef WAIT_BAR
}
#define GAS __attribute__((address_space(1)))
#define LAS __attribute__((address_space(3)))
typedef unsigned short bf16;
typedef unsigned v4u __attribute__((ext_vector_type(4)));
typedef float f32x4 __attribute__((ext_vector_type(4)));
constexpr int NWAVES = 8;
#ifndef REP_P0
#define REP_P0 1
#endif
#ifndef REP_ATT_E
#define REP_ATT_E 1
#endif
#ifndef REP_ATT_O
#define REP_ATT_O 1
#endif
#ifndef REP_GU
#define REP_GU 1
#endif
#ifndef REP_PROJ
#define REP_PROJ 1
#endif
constexpr int LDS_BYTES = 135168;
static_assert(attn_body::ATTN_LDS_TOTAL <= 131072, "attention LDS inside the ring");

constexpr size_t SZ_WGU = (size_t)NGU * DMODEL * 2, SZ_WD = (size_t)DMODEL * DFF * 2;
constexpr size_t WS_WGU = 0;
constexpr size_t WS_WD = WS_WGU + 4 * SZ_WGU;
constexpr size_t WS_WIN = WS_WD + 4 * SZ_WD;
constexpr size_t WS_WOE = WS_WIN + (size_t)1536 * 1024 * 2;
constexpr size_t WS_WQKV = WS_WOE + (size_t)1024 * 1024 * 2;
constexpr size_t WS_WOO = WS_WQKV + (size_t)3072 * 1024 * 2;
constexpr size_t WS_XB = WS_WOO + (size_t)1024 * 1024 * 2;
constexpr size_t WS_PART = WS_XB + (size_t)SEQ * DMODEL * 2;
constexpr size_t WS_U = WS_PART + (size_t)SEQ * 16 * 4;
constexpr size_t WS_PROJ = WS_U, WS_O = WS_U + (size_t)SEQ * 3072 * 2, WS_END = WS_O + (size_t)SEQ * 1024 * 2;
static_assert(WS_END <= 268435456 && WS_U % 256 == 0, "d_ws map");

struct Args { const float* in[19]; float* out; unsigned char* ws; };
typedef unsigned long long u64;
__device__ __forceinline__ u64 ldptr(LAS u64* PT, int i) { const u64 v = PT[i]; const unsigned lo = __builtin_amdgcn_readfirstlane((unsigned)v), hi = __builtin_amdgcn_readfirstlane((unsigned)(v >> 32)); return ((u64)hi << 32) | lo; }

__device__ __forceinline__ unsigned f2bf(float f) { unsigned u = __builtin_bit_cast(unsigned, f); return (u + 0x7fffu + ((u >> 16) & 1u)) >> 16; }
__device__ __forceinline__ unsigned pk2(float lo, float hi) { return f2bf(lo) | (f2bf(hi) << 16); }
__device__ __forceinline__ float bf2f(unsigned short b) { return __builtin_bit_cast(float, (unsigned)b << 16); }
#define LDS_WAIT() asm volatile("s_waitcnt lgkmcnt(0)" ::: "memory")
__device__ __forceinline__ float wave_sum(float v) {
#pragma unroll
    for (int o = 1; o < 64; o <<= 1) v += __shfl_xor(v, o);
    return v;
}
__device__ __forceinline__ void transpose_item(const float* W, int K, int N, bf16* WT, const float* gain, int mode, LAS float* scr, int item, int lane) {
    const int nblk = N / 32, kb = item / nblk, nb = item % nblk, k0 = 64 * kb, n0 = 32 * nb;
    {
        const int kk8 = lane >> 3, seg = lane & 7;
        f32x4 w[8]; float gk[8];
#pragma unroll
        for (int i = 0; i < 8; ++i) { w[i] = __builtin_nontemporal_load((const GAS f32x4*)(W + (size_t)(k0 + 8 * i + kk8) * N + n0 + 4 * seg)); gk[i] = gain ? gain[k0 + 8 * i + kk8] : 1.f; }
#pragma unroll
        for (int i = 0; i < 8; ++i) { LAS float* d = scr + (8 * i + kk8) * 33 + 4 * seg; const f32x4 v = w[i] * gk[i]; d[0] = v.x; d[1] = v.y; d[2] = v.z; d[3] = v.w; }
    }
    LDS_WAIT(); asm volatile("" ::: "memory");
    const int d0 = (mode == 0) ? n0 : ((n0 >> 7) * 256 + (n0 & 127) + (mode == 2 ? 128 : 0));
    const auto wrs = __builtin_amdgcn_make_buffer_rsrc((void*)WT, 0, 0x7fffffff, 0x00020000);
    const int c = lane & 7;
#pragma unroll
    for (int j = 0; j < 4; ++j) { const int n = (lane >> 3) + 8 * j; const LAS float* s = scr + (8 * c) * 33 + n;
        v4u o; o.x = pk2(s[0 * 33], s[1 * 33]); o.y = pk2(s[2 * 33], s[3 * 33]); o.z = pk2(s[4 * 33], s[5 * 33]); o.w = pk2(s[6 * 33], s[7 * 33]);
        __builtin_amdgcn_raw_buffer_store_b128(o, wrs, (int)((((unsigned)(d0 + n)) * (unsigned)K + k0 + 8 * c) * 2u), 0, 16); }
    LDS_WAIT(); asm volatile("" ::: "memory");
}

__device__ __forceinline__ void cs_of(float ang, float& c, float& s) {
    double t = (double)ang * 0.15915494309189535; t -= __builtin_rint(t); const float r = (float)t;
    c = __builtin_amdgcn_cosf(r); s = __builtin_amdgcn_sinf(r);
}

#define P_IN(i) ((const float*)(const GAS float*)ldptr(PT, (i)))
#define P_WSB(off) ((bf16*)(GAS bf16*)(ldptr(PT, 20) + (off)))
__device__ __forceinline__ void conv_weights(LAS u64* PT, LAS unsigned char* ldsl, const unsigned mask, const int worker, const int nworkers, const int wave, const int lane) {
    LAS float* scr = (LAS float*)(ldsl + wave * 16384);
    bf16* WGU = P_WSB(WS_WGU); bf16* WD = P_WSB(WS_WD);
    constexpr int I_G = 16 * 88, I_D = 44 * 32, I_IN = 16 * 48, I_O = 16 * 32, I_QKV = 16 * 96;
    for (int it = worker; ; it += nworkers) {
        int r = it;
#define CONV_ENTRY(bit, cnt, call) if (mask & (1u << (bit))) { if (r < (cnt)) { call; continue; } r -= (cnt); }
#define FFN_ITEMS(f_, L_, GI, WG, WU, WDN) { const size_t wo = (size_t)(L_) * DMODEL * DFF; \
            CONV_ENTRY(3 * (f_) + 0, I_G, transpose_item(P_IN(WG) + wo, DMODEL, DFF, WGU + (size_t)(f_) * NGU * DMODEL, P_IN(GI) + (L_) * DMODEL, 1, scr, r, lane)) \
            CONV_ENTRY(3 * (f_) + 1, I_G, transpose_item(P_IN(WU) + wo, DMODEL, DFF, WGU + (size_t)(f_) * NGU * DMODEL, P_IN(GI) + (L_) * DMODEL, 2, scr, r, lane)) \
            CONV_ENTRY(3 * (f_) + 2, I_D, transpose_item(P_IN(WDN) + wo, DFF, DMODEL, WD + (size_t)(f_) * DMODEL * DFF, nullptr, 0, scr, r, lane)) }
        FFN_ITEMS(0, 0, 1, 2, 3, 4)
        FFN_ITEMS(1, 0, 6, 7, 8, 9)
        FFN_ITEMS(2, 1, 1, 2, 3, 4)
        FFN_ITEMS(3, 1, 6, 7, 8, 9)
#undef FFN_ITEMS
        CONV_ENTRY(12, I_IN, transpose_item(P_IN(10), DMODEL, 1536, P_WSB(WS_WIN), P_IN(5), 0, scr, r, lane))
        CONV_ENTRY(13, I_O, transpose_item(P_IN(14), DMODEL, DMODEL, P_WSB(WS_WOE), nullptr, 0, scr, r, lane))
        CONV_ENTRY(14, I_QKV, transpose_item(P_IN(15), DMODEL, 3072, P_WSB(WS_WQKV), P_IN(5) + DMODEL, 0, scr, r, lane))
        CONV_ENTRY(15, I_O, transpose_item(P_IN(17), DMODEL, DMODEL, P_WSB(WS_WOO), nullptr, 0, scr, r, lane))
#undef CONV_ENTRY
        break;
    }
}
#undef P_IN
#undef P_WSB
__device__ __forceinline__ void conv_in_tail(LAS u64* PT, LAS unsigned char* ldsl, const unsigned mask, const int nwg, const int G, const int bx, const int wave, const int lane) {
    const int rem = nwg % G, first = rem;
    if (bx >= first) conv_weights(PT, ldsl, mask, (bx - first) * NWAVES + wave, (G - first) * NWAVES, wave, lane);
}
#define RLX_AGENT __ATOMIC_RELAXED, __HIP_MEMORY_SCOPE_AGENT
#define XB_TMO      128
#define XB_XCNT(j)  (256  + 64 * (j))
#define XB_XSUB(j)  (1280 + 64 * (j))
#define XB_XGEN(j)  (2304 + 64 * (j))
#define XB_TOP      3328
#define XB_TOPGEN   3392
#define XCD_BAR_WORDS 3456
#define XB_SPIN_CAP (1u << 18)

__device__ __forceinline__ unsigned xb_ld(unsigned* p)              { return __hip_atomic_load(p, __ATOMIC_RELAXED, __HIP_MEMORY_SCOPE_AGENT); }
__device__ __forceinline__ unsigned xb_add(unsigned* p, unsigned v) { return __hip_atomic_fetch_add(p, v, __ATOMIC_RELAXED, __HIP_MEMORY_SCOPE_AGENT); }
__device__ __forceinline__ unsigned xb_xcc_id() { return (unsigned)__builtin_amdgcn_s_getreg((3 << 11) | 20) & 0xFu; }
#define XB_SPIN(cond, bar) do { unsigned _sp = 0; while (cond) { __builtin_amdgcn_s_sleep(1); \
    if ((++_sp & 255u) == 0u) { if (xb_ld(&(bar)[XB_TMO])) break; if (_sp > XB_SPIN_CAP) { atomicAdd(&(bar)[XB_TMO], 1u); break; } } } } while (0)

struct XcdBarrier {
    unsigned* bar; unsigned x;
    volatile LAS unsigned* st;
};

__device__ __forceinline__ XcdBarrier xcd_barrier_post(unsigned* bar, volatile LAS unsigned* st) {
    XcdBarrier b; b.bar = bar; b.x = xb_xcc_id(); b.st = st;
    if (threadIdx.x == 0) (void)xb_add(&bar[XB_XCNT(b.x)], 1u);
    return b;
}
__device__ __forceinline__ void xcd_barrier_complete(unsigned* bar, unsigned x, unsigned& nloc, unsigned& nx) {
    const unsigned G = gridDim.x * gridDim.y * gridDim.z;
    unsigned sum, cnt, mine, sp = 0u;
    for (;;) {
        sum = 0u; cnt = 0u; mine = 0u;
#pragma unroll
        for (unsigned j = 0; j < 16; ++j) { const unsigned c = xb_ld(&bar[XB_XCNT(j)]); sum += c; cnt += (c > 0u) ? 1u : 0u; mine = (j == x) ? c : mine; }
        if (sum == G) break;
        __builtin_amdgcn_s_sleep(1);
        if ((++sp & 255u) == 0u) { if (xb_ld(&bar[XB_TMO])) break; if (sp > XB_SPIN_CAP) { atomicAdd(&bar[XB_TMO], 1u); break; } }
    }
    nloc = mine > 0u ? mine : 1u; nx = cnt > 0u ? cnt : 1u;
}

__device__ __forceinline__ void xcd_barrier(const XcdBarrier& b) {
    asm volatile("s_waitcnt vmcnt(0)" ::: "memory");
    __syncthreads();
    if (threadIdx.x == 0) {
        unsigned* bar = b.bar;
        __builtin_amdgcn_s_waitcnt(0);
        unsigned nloc = b.st[0], nx = b.st[1];
        if (nloc == 0u) { xcd_barrier_complete(bar, b.x, nloc, nx); b.st[0] = nloc; b.st[1] = nx; }
        const unsigned old = xb_add(&bar[XB_XSUB(b.x)], 1u);
        const unsigned gen = old / nloc;
        if (old + 1u == (gen + 1u) * nloc) {
            __builtin_amdgcn_fence(__ATOMIC_RELEASE, "agent");
            asm volatile("s_waitcnt vmcnt(0)" ::: "memory");
            const unsigned og = xb_add(&bar[XB_TOP], 1u);
            const unsigned tg = og / nx;
            if (og + 1u == (tg + 1u) * nx) xb_add(&bar[XB_TOPGEN], 1u);
            else XB_SPIN(xb_ld(&bar[XB_TOPGEN]) == tg, bar);
            __builtin_amdgcn_fence(__ATOMIC_ACQUIRE, "agent");
            xb_add(&bar[XB_XGEN(b.x)], 1u);
            asm volatile("s_waitcnt vmcnt(0)" ::: "memory");
        } else {
            XB_SPIN(xb_ld(&bar[XB_XGEN(b.x)]) == gen, bar);
            __builtin_amdgcn_fence(__ATOMIC_ACQUIRE, "agent");
            asm volatile("s_waitcnt vmcnt(0)" ::: "memory");
        }
    }
    __syncthreads();
}

constexpr size_t WS_BAR = WS_PART + 512 * 1024;
__global__ void __launch_bounds__(NWAVES * 64, 2) fwd_megakernel(Args args) {
    extern __shared__ __attribute__((aligned(16))) unsigned char lds[];
    cg::grid_group grid = cg::this_grid();
    LAS unsigned char* ldsl = (LAS unsigned char*)lds;
#define FRESH() int tid = threadIdx.x; asm volatile("" : "+v"(tid)); int G = gridDim.x, bx = blockIdx.x; asm volatile("" : "+s"(G), "+s"(bx)); \
    const int lane = tid & 63, wave = __builtin_amdgcn_readfirstlane(tid >> 6); const int gw = bx * NWAVES + wave, NGW = G * NWAVES; (void)lane; (void)gw; (void)NGW;
    LAS u64* PT = (LAS u64*)(ldsl + 131072);
    if (threadIdx.x == 0) {
#pragma unroll
        for (int i = 0; i < 19; ++i) PT[i] = (u64)args.in[i];
        PT[19] = (u64)args.out; PT[20] = (u64)args.ws;
        ((volatile LAS unsigned*)(ldsl + 131072 + 256))[0] = 0u; ((volatile LAS unsigned*)(ldsl + 131072 + 256))[1] = 0u;
    }
    __syncthreads();
    int par = 0;
#define P_IN(i) ((const float*)(const GAS float*)ldptr(PT, (i)))
#define P_OUT ((float*)(GAS float*)ldptr(PT, 19))
#define P_WSB(off) ((bf16*)(GAS bf16*)(ldptr(PT, 20) + (off)))
#define P_SUMQ ((u64*)(GAS u64*)(ldptr(PT, 20) + WS_PART))

#ifndef NO_P0
    {
        FRESH();
        bf16* XB = P_WSB(WS_XB); u64* SUMQ = P_SUMQ;
        for (int rep = 0; rep < REP_P0; ++rep) {
        conv_weights(PT, ldsl, 0x0003u, gw, NGW, wave, lane);
        if (bx == 0) { unsigned* bw = (unsigned*)(GAS unsigned*)(ldptr(PT, 20) + WS_BAR); for (int i = tid; i < XCD_BAR_WORDS + 64 * 64; i += NWAVES * 64) bw[i] = 0u; }
        const float* x = P_IN(0); const auto xrs = __builtin_amdgcn_make_buffer_rsrc((void*)XB, 0, 0x7fffffff, 0x00020000);
        for (int m0 = gw; m0 < SEQ; m0 += 2 * NGW) {
            f32x4 v[2][4]; float s[2];
#pragma unroll
            for (int q = 0; q < 2; ++q) { const int m = m0 + q * NGW; const GAS f32x4* xr = (const GAS f32x4*)(x + (size_t)(m < SEQ ? m : m0) * DMODEL) + lane;
#pragma unroll
                for (int j = 0; j < 4; ++j) v[q][j] = xr[64 * j]; }
#pragma unroll
            for (int q = 0; q < 2; ++q) { const int m = m0 + q * NGW; s[q] = 0.f;
#pragma unroll
                for (int j = 0; j < 4; ++j) s[q] += (v[q][j].x * v[q][j].x + v[q][j].y * v[q][j].y) + (v[q][j].z * v[q][j].z + v[q][j].w * v[q][j].w);
                s[q] = wave_sum(s[q]);
                if (m < SEQ) {
#pragma unroll
                    for (int j = 0; j < 4; ++j) { typedef unsigned v2u __attribute__((ext_vector_type(2))); const v2u w2 = {pk2(v[q][j].x, v[q][j].y), pk2(v[q][j].z, v[q][j].w)};
                        __builtin_amdgcn_raw_buffer_store_b64(w2, xrs, (int)(((unsigned)m * DMODEL + 256u * j + 4u * lane) * 2u), 0, 16); }
                    if (lane == 0) { SUMQ[m] = (unsigned long long)(s[q] * 1048576.f); SUMQ[SEQ + m] = 0ull; }
                } }
        }
        }
    }
    grid.sync();
    { XcdBarrier b0 = xcd_barrier_post((unsigned*)(GAS unsigned*)(ldptr(PT, 20) + WS_BAR), (volatile LAS unsigned*)(ldsl + 131072 + 256)); (void)b0; }
#define GRID_BAR() do { XcdBarrier b_; b_.bar = (unsigned*)(GAS unsigned*)(ldptr(PT, 20) + WS_BAR); b_.x = xb_xcc_id(); b_.st = (volatile LAS unsigned*)(ldsl + 131072 + 256); xcd_barrier(b_); } while (0)
#endif

#pragma unroll 1
    for (int L = 0; L < 2; ++L) {
#pragma unroll 1
        for (int h2 = 0; h2 < 2; ++h2) {
            const int f = 2 * L + h2;
#ifndef NO_GU
            {
                FRESH();
                u64* SUMQ = P_SUMQ; pg8::Gemm g{P_WSB(WS_XB), P_WSB(WS_WGU) + (size_t)f * NGU * DMODEL, SEQ, NGU, DMODEL}; pg8::StaticOrder S; S.init(SEQ, NGU, G, bx);
                pg8::EpiGU E{P_WSB(WS_U), SUMQ + par * SEQ, SUMQ + (par ^ 1) * SEQ};
                for (int rep = 0; rep < ((f == 0) ? REP_GU : 1); ++rep)
                pg8::gemm_phase<pg8::EpiGU, pg8::StaticOrder, true, true>(ldsl, g, S, E);
                { const unsigned cm = (f == 0) ? 0x301Cu : (f == 1) ? 0x02C0u : (f == 2) ? 0xCC00u : 0u; if (cm) conv_in_tail(PT, ldsl, cm, (SEQ / 256) * (NGU / 256), G, bx, wave, lane); }
            }
#endif
            GRID_BAR();
#ifndef NO_DOWN
            {
                FRESH();
                u64* SUMQ = P_SUMQ; pg8::Gemm g{P_WSB(WS_U), P_WSB(WS_WD) + (size_t)f * DMODEL * DFF, SEQ, DMODEL, DFF}; pg8::StaticOrder S; S.init(SEQ, DMODEL, G, bx);
                if (f == 0) { pg8::EpiRes<true> E{P_IN(0), P_WSB(WS_XB), SUMQ + (par ^ 1) * SEQ, 0.5f}; pg8::gemm_phase<pg8::EpiRes<true>, pg8::StaticOrder, true, true>(ldsl, g, S, E); }
                else if (f == 3) { pg8::EpiFinal E{P_WSB(WS_XB), P_OUT, SUMQ + (par ^ 1) * SEQ, (unsigned*)(GAS unsigned*)(ldptr(PT, 20) + WS_BAR) + XCD_BAR_WORDS, P_IN(18), 0.5f};
                    pg8::gemm_phase<pg8::EpiFinal, pg8::StaticOrder, true, true>(ldsl, g, S, E); }
                else { pg8::EpiRes<false> E{nullptr, P_WSB(WS_XB), SUMQ + (par ^ 1) * SEQ, 0.5f}; pg8::gemm_phase<pg8::EpiRes<false>, pg8::StaticOrder, true, true>(ldsl, g, S, E); }
                par ^= 1;
            }
#endif
            if (f == 3) break;
            GRID_BAR();
            if (h2 == 1) continue;
            const int NPROJ = (L == 0) ? 1536 : 3072;
#ifndef NO_PROJ
            {
                FRESH();
                u64* SUMQ = P_SUMQ; pg8::Gemm g{P_WSB(WS_XB), (L == 0) ? P_WSB(WS_WIN) : P_WSB(WS_WQKV), SEQ, NPROJ, DMODEL}; pg8::StaticOrder S; S.init(SEQ, NPROJ, G, bx);
                pg8::EpiProj E{P_WSB(WS_PROJ), (unsigned)NPROJ, SUMQ + par * SEQ, SUMQ + (par ^ 1) * SEQ, (L == 0) ? 0 : 1024, QSCALE};
                for (int rep = 0; rep < REP_PROJ; ++rep)
                pg8::gemm_phase<pg8::EpiProj, pg8::StaticOrder, true, true>(ldsl, g, S, E);
                if (L == 0) conv_in_tail(PT, ldsl, 0x0120u, (SEQ / 256) * (1536 / 256), G, bx, wave, lane);
            }
#endif
            GRID_BAR();
            if (L == 0) {
#ifndef NO_POST
                {
                FRESH();
                const int seg = lane & 7, ts = lane >> 3;
                const float* pq = P_IN(11); const float* pk = P_IN(12); bf16* PROJ = P_WSB(WS_PROJ);
                float i32[8], i64[8], gq[8], gk[8];
#pragma unroll
                for (int j = 0; j < 8; ++j) {
                    i32[j] = (float)::exp2(-(double)(8 * (seg & 1) + j) * (2.0 / 32.0) * 13.287712379549449);
                    i64[j] = (float)::exp2(-(double)(8 * (seg & 3) + j) * (2.0 / 64.0) * 13.287712379549449);
                    gq[j] = pq[8 * seg + j]; gk[j] = pk[8 * seg + j]; }
                const auto prs = __builtin_amdgcn_make_buffer_rsrc((void*)PROJ, 0, 0x7fffffff, 0x00020000);
                for (int grp = gw; grp < SEQ / 8; grp += NGW) {
                    const int tok = grp * 8 + ts;
                    GAS v4u* row = (GAS v4u*)(PROJ + (size_t)tok * 1536) + seg;
                    v4u ra[10], rb[10];
#pragma unroll
                    for (int i = 0; i < 10; ++i) { ra[i] = row[8 * i]; rb[i] = row[96 + 8 * i]; }
                    float ca[8], sa[8], cb[8], sb[8];
                    const float pa = (float)((seg < 4) ? (tok >> 6) : (tok & 63)), pb = (float)tok;
#pragma unroll
                    for (int j = 0; j < 8; ++j) { cs_of(pa * i32[j], ca[j], sa[j]); cs_of(pb * i64[j], cb[j], sb[j]); }
#pragma unroll
                    for (int i = 0; i < 10; ++i) {
                        {
                            float v[8]; const v4u w = ra[i];
                            v[0] = __builtin_bit_cast(float, w.x << 16); v[1] = __builtin_bit_cast(float, w.x & 0xffff0000u); v[2] = __builtin_bit_cast(float, w.y << 16); v[3] = __builtin_bit_cast(float, w.y & 0xffff0000u);
                            v[4] = __builtin_bit_cast(float, w.z << 16); v[5] = __builtin_bit_cast(float, w.z & 0xffff0000u); v[6] = __builtin_bit_cast(float, w.w << 16); v[7] = __builtin_bit_cast(float, w.w & 0xffff0000u);
                            float ss = ((v[0] * v[0] + v[1] * v[1]) + (v[2] * v[2] + v[3] * v[3])) + ((v[4] * v[4] + v[5] * v[5]) + (v[6] * v[6] + v[7] * v[7]));
                            ss += __shfl_xor(ss, 1); ss += __shfl_xor(ss, 2); ss += __shfl_xor(ss, 4);
                            const float rs = __builtin_amdgcn_rsqf(ss * (1.f / 64.f) + RMS_EPS) * ((i < 8) ? QSCALE : 1.f);
                            float o[8];
#pragma unroll
                            for (int j = 0; j < 8; ++j) { const float nv = v[j] * rs * ((i < 8) ? gq[j] : gk[j]); const float pr = __shfl_xor(nv, 2);
                                o[j] = (seg & 2) ? (pr * sa[j] + nv * ca[j]) : (nv * ca[j] - pr * sa[j]); }
                            v4u r; r.x = pk2(o[0], o[1]); r.y = pk2(o[2], o[3]); r.z = pk2(o[4], o[5]); r.w = pk2(o[6], o[7]);
                            __builtin_amdgcn_raw_buffer_store_b128(r, prs, (int)(((unsigned)tok * 1536u + 64u * i + 8u * seg) * 2u), 0, 16);
                        }
                        {
                            float v[8]; const v4u w = rb[i];
                            v[0] = __builtin_bit_cast(float, w.x << 16); v[1] = __builtin_bit_cast(float, w.x & 0xffff0000u); v[2] = __builtin_bit_cast(float, w.y << 16); v[3] = __builtin_bit_cast(float, w.y & 0xffff0000u);
                            v[4] = __builtin_bit_cast(float, w.z << 16); v[5] = __builtin_bit_cast(float, w.z & 0xffff0000u); v[6] = __builtin_bit_cast(float, w.w << 16); v[7] = __builtin_bit_cast(float, w.w & 0xffff0000u);
                            const float qs = (i < 8) ? QSCALE : 1.f;
                            float o[8];
#pragma unroll
                            for (int j = 0; j < 8; ++j) { const float nv = v[j] * qs; const float pr = __shfl_xor(nv, 4);
                                o[j] = (seg & 4) ? (pr * sb[j] + nv * cb[j]) : (nv * cb[j] - pr * sb[j]); }
                            v4u r; r.x = pk2(o[0], o[1]); r.y = pk2(o[2], o[3]); r.z = pk2(o[4], o[5]); r.w = pk2(o[6], o[7]);
                            __builtin_amdgcn_raw_buffer_store_b128(r, prs, (int)(((unsigned)tok * 1536u + 768u + 64u * i + 8u * seg) * 2u), 0, 16);
                        }
                    }
                }
                }
                GRID_BAR();
#endif
                FRESH();
                {
                const attn_body::bf16* P = (const attn_body::bf16*)P_WSB(WS_PROJ); attn_body::bf16* O = (attn_body::bf16*)P_WSB(WS_O);
#define EVEN_KV(u_, kc_, vc_, t0_) { const int uu_ = (u_) & 511, h_ = uu_ & 7, qb_ = uu_ >> 3, kvh_ = h_ >> 2; \
                    if ((u_) < 512) { kc_ = 512 + kvh_ * 64; vc_ = 640 + kvh_ * 64; t0_ = 0; } else { kc_ = 1280 + kvh_ * 64; vc_ = 1408 + kvh_ * 64; t0_ = min(max(qb_ * 4 - 2, 0), 248); } }
                bool pre = false;
                for (int u = bx; u < 1024; u += G) {
                    const int uu = u & 511, h = uu & 7, qb = uu >> 3;
                    int kc, vc, t0; EVEN_KV(u, kc, vc, t0)
                    const int un = u + G; int nkc = 0, nvc = 0, nt0 = 0; const bool hn = un < 1024; if (hn) EVEN_KV(un, nkc, nvc, nt0)
                    const attn_body::bf16* nK = hn ? P + nkc : nullptr; const attn_body::bf16* nV = hn ? P + nvc : nullptr;
                    if (u < 512) attn_body::attn_unit<0, 8>(P + h * 64, P + kc, P + vc, O + h * 64, 1536, qb * 256, 0, 256, 0.f, nullptr, false, pre, false, nK, nV, nt0, (char*)lds);
                    else attn_body::attn_unit<1, 8>(P + 768 + h * 64, P + kc, P + vc, O + 512 + h * 64, 1536, qb * 256, t0, 8, P_IN(13)[h] * LOG2E, nullptr, false, pre, false, nK, nV, nt0, (char*)lds);
                    pre = hn;
                }
#ifdef PROBE_B2
                for (int u = bx + 512; u < 1024; u += G) {
                    const int uu = u & 511, h = uu & 7, qb = uu >> 3; int kc, vc, t0; EVEN_KV(u, kc, vc, t0)
                    attn_body::attn_unit<1, 8>(P + 768 + h * 64, P + kc, P + vc, O + 512 + h * 64, 1536, qb * 256, t0, 8, P_IN(13)[h] * LOG2E, nullptr, false, false, false, nullptr, nullptr, 0, (char*)lds);
                }
#endif
#undef EVEN_KV
                }
            } else {
                FRESH();
                int hb = -1;
#ifdef PROBE_NA24
                for (int u = bx; u < 1024; u += G) {
                    const int h = u & 15, qb = u >> 4; const int t0 = min(max(qb * 4 - 4, 0), 232);
                    const attn_body::bf16* P = (const attn_body::bf16*)P_WSB(WS_PROJ); attn_body::bf16* O = (attn_body::bf16*)P_WSB(WS_O);
                    attn_body::attn_unit<2, 8>(P + h * 64, P + 1024 + h * 64, P + 2048 + h * 64, O + h * 64, 3072, qb * 256, t0, 24, 0.f, P_IN(16) + h * 465, h != hb, false, false, nullptr, nullptr, 0, (char*)lds); hb = h;
                }
#endif
                {
                const attn_body::bf16* P = (const attn_body::bf16*)P_WSB(WS_PROJ); attn_body::bf16* O = (attn_body::bf16*)P_WSB(WS_O);
                bool pre = false;
                for (int u = bx; u < 1024; u += G) {
                    const int h = u & 15, qb = u >> 4; const int t0 = min(max(qb * 4 - 4, 0), 244);
                    const int un = u + G; const bool hn = un < 1024; const int nh = un & 15, nqb = un >> 4, nt0 = min(max(nqb * 4 - 4, 0), 244);
                    attn_body::attn_unit<2, 8>(P + h * 64, P + 1024 + h * 64, P + 2048 + h * 64, O + h * 64, 3072, qb * 256, t0, 12, 0.f, P_IN(16) + h * 465, h != hb, pre, pre,
                                               hn ? P + 1024 + nh * 64 : nullptr, hn ? P + 2048 + nh * 64 : nullptr, nt0, (char*)lds); hb = h;
                    pre = hn;
                }
                }
            }
            GRID_BAR();
#ifndef NO_OUT
            {
                FRESH();
                u64* SUMQ = P_SUMQ; float* OUT = P_OUT; pg8::Gemm g{P_WSB(WS_O), (L == 0) ? P_WSB(WS_WOE) : P_WSB(WS_WOO), SEQ, DMODEL, DMODEL}; pg8::StaticOrder S; S.init(SEQ, DMODEL, G, bx);
                pg8::EpiRes<false> E{nullptr, P_WSB(WS_XB), SUMQ + (par ^ 1) * SEQ, 1.0f}; par ^= 1;
                pg8::gemm_phase<pg8::EpiRes<false>, pg8::StaticOrder, true, true>(ldsl, g, S, E);
            }
#endif
            GRID_BAR();
        }
    }
}

extern "C" void kernel_launch(void* const* d_in, const int* in_sizes, int n_in, void* d_out, int out_size, void* d_ws, size_t ws_size, hipStream_t stream) {
    static int grid = 0;
    if (grid == 0) {
        if (n_in != 19 || out_size != SEQ * DMODEL || ws_size < WS_END) { fprintf(stderr, "kernel_launch: unexpected shapes (n_in %d, out %d, ws %zu < %zu)\n", n_in, out_size, ws_size, (size_t)WS_END); grid = -1; return; }
        int dev = 0, cus = 0, per_cu = 0;
        (void)hipGetDevice(&dev);
        (void)hipDeviceGetAttribute(&cus, hipDeviceAttributeMultiprocessorCount, dev);
        if (hipFuncSetAttribute((const void*)fwd_megakernel, hipFuncAttributeMaxDynamicSharedMemorySize, LDS_BYTES) != hipSuccess) { fprintf(stderr, "kernel_launch: hipFuncSetAttribute failed\n"); grid = -1; return; }
        if (hipOccupancyMaxActiveBlocksPerMultiprocessor(&per_cu, (const void*)fwd_megakernel, NWAVES * 64, LDS_BYTES) != hipSuccess || per_cu < 1) { fprintf(stderr, "kernel_launch: occupancy query failed (%d)\n", per_cu); (void)hipGetLastError(); per_cu = 1; }
        grid = cus * per_cu;
        fprintf(stderr, "kernel_launch: %d CUs x %d = grid %d\n", cus, per_cu, grid);
    }
    if (grid < 0) return;
    Args a{};
    for (int i = 0; i < 19; ++i) a.in[i] = (const float*)d_in[i];
    a.out = (float*)d_out; a.ws = (unsigned char*)d_ws;
    void* kargs[] = {&a};
    hipError_t e = hipLaunchCooperativeKernel((const void*)fwd_megakernel, dim3(grid), dim3(NWAVES * 64), kargs, LDS_BYTES, stream);
    if (e != hipSuccess) fprintf(stderr, "kernel_launch: cooperative launch failed: %s (grid %d)\n", hipGetErrorString(e), grid);
}
```

```cpp
#include <hip/hip_runtime.h>
#include <hip/hip_cooperative_groups.h>
#include <hip/hip_bf16.h>
#include <cstdio>
#include <cstdint>
#include <cmath>
namespace cg = cooperative_groups;

constexpr int SEQ = 16384, DMODEL = 1024, DFF = 2816, NGU = 2 * DFF;
constexpr float RMS_EPS = 1e-6f;
constexpr float LOG2E = 1.4426950408889634f;
constexpr float QSCALE = 0.125f * 1.4426950408889634f;

namespace pg8 {
#define PG8_LAS __attribute__((address_space(3)))
typedef unsigned short bf16_t;
typedef short bf16x8 __attribute__((ext_vector_type(8)));
typedef float f32x4 __attribute__((ext_vector_type(4)));
typedef unsigned u32x4 __attribute__((ext_vector_type(4)));
#define WT_RSRC(base) __builtin_amdgcn_make_buffer_rsrc((void*)(base), 0, 0x7fffffff, 0x00020000)
#define WT_STORE16(rsrc, byteoff, v) __builtin_amdgcn_raw_buffer_store_b128((v), (rsrc), (int)(byteoff), 0, 16)
constexpr int BM = 256, BK = 64, HALF = 128, HTB = HALF * BK * 2  , STAGE_BYTES = 8 * HTB, NXCD = 8, WGM = 8;

__host__ __device__ __forceinline__ int lds_byte(int r, int c) { const int st = (r >> 4) * 2 + (c >> 5), rr = r & 15, cc = c & 31, ob = rr * 64 + cc * 2; return st * 1024 + (ob ^ (((ob >> 9) & 1) << 5)); }
__host__ __device__ __forceinline__ void stage_rc(int b, int& R, int& C) { const int st = b / 1024, sb = b % 1024, swz = sb ^ (((sb >> 9) & 1) << 5); R = (st >> 1) * 16 + swz / 64; C = (st & 1) * 32 + (swz % 64) / 2; }
__host__ __device__ __forceinline__ int perm32(int rho) { const int n = rho >> 4, i = rho & 15; return 8 * (i >> 2) + 4 * n + (i & 3); }

struct Unit { int pm, pn; };
struct Gemm { const bf16_t* A; const bf16_t* Bt; int M, N, K; };

struct StaticOrder {
    int nM, nN, nwg, G, c;
    __host__ __device__ void init(int M, int N, int G_, int c_) { nM = M / BM; nN = N / BM; nwg = nM * nN; G = G_; c = c_; }
    __host__ __device__ bool next(int i, Unit& u) const {
        const long L = (long)i * G + c; if (L >= nwg) return false;
        int wgid = (int)L; { const int q = nwg / NXCD, r = nwg % NXCD, xcd = wgid % NXCD, off = wgid / NXCD; wgid = (xcd < r ? xcd * (q + 1) : r * (q + 1) + (xcd - r) * q) + off; }
        const int nig = WGM * nN, gid = wgid / nig, fm = gid * WGM, gsz = (nM - fm) < WGM ? (nM - fm) : WGM;
        u.pm = fm + ((wgid % nig) % gsz); u.pn = (wgid % nig) / gsz; return true;
    }
    __device__ __forceinline__ void a_ready(const Unit&) const {}
    __device__ __forceinline__ void done(const Unit&) const {}
};

__device__ __forceinline__ unsigned cvt_pk_bf16(float lo, float hi) { unsigned r; asm volatile("v_cvt_pk_bf16_f32 %0, %1, %2" : "=v"(r) : "v"(lo), "v"(hi)); return r; }
typedef unsigned long long u64;
__device__ __forceinline__ float row_scale(const u64* sq, unsigned row) {
    return __builtin_amdgcn_rsqf((float)sq[row] * (1.f / (1048576.f * 1024.f)) + 1e-6f);
}
constexpr int SCALE_LDS = 131072 + 1024;
__device__ __forceinline__ float silu_mul(float g, float u) { return g * u * __builtin_amdgcn_rcpf(1.f + __builtin_amdgcn_exp2f(-1.4426950408889634f * g)); }

struct EpiGU {
    static constexpr bool PERM = true, AFTER_DRAIN = false, HAS_PRE = true, IS_FINAL = false;
    bf16_t* ACT; const u64* sq; u64* sqz;
    __device__ __forceinline__ void pre_first(const Unit& u, PG8_LAS unsigned char* lds, int tid) const {
        if (tid < 256) ((PG8_LAS float*)(lds + SCALE_LDS))[tid] = row_scale(sq, u.pm * BM + tid);
    }
    __device__ __forceinline__ void operator()(const f32x4 (&acc)[2][2][4][2], const Unit& u, const Unit& nx, bool has_next, int par, PG8_LAS unsigned char* lds, int tid, int wr, int wc, int fr, int fq) const {
        u64 nsq = 0; const bool ld = has_next && tid < 256; if (ld) nsq = sq[nx.pm * BM + tid];
        const PG8_LAS float* sc = (const PG8_LAS float*)(lds + SCALE_LDS) + par * 256;
        const unsigned rl0 = wr * 64 + fr, row0 = u.pm * BM + rl0, col0 = u.pn * 128 + wc * 32 + 8 * fq; const auto rs_ = WT_RSRC(ACT);
        const bool zr = (u.pn == 0) && (wc == 0) && (fq == 0);
#pragma unroll
        for (int ai = 0; ai < 2; ++ai) {
#pragma unroll
            for (int m = 0; m < 4; ++m) { const unsigned row = row0 + ai * HALF + m * 16; const float s = sc[rl0 + ai * HALF + m * 16]; if (zr) sqz[row] = 0ull;
                const f32x4 g0 = acc[ai][0][m][0] * s, g1 = acc[ai][0][m][1] * s, u0 = acc[ai][1][m][0] * s, u1 = acc[ai][1][m][1] * s;
                u32x4 w; w.x = cvt_pk_bf16(silu_mul(g0[0], u0[0]), silu_mul(g0[1], u0[1])); w.y = cvt_pk_bf16(silu_mul(g0[2], u0[2]), silu_mul(g0[3], u0[3]));
                w.z = cvt_pk_bf16(silu_mul(g1[0], u1[0]), silu_mul(g1[1], u1[1])); w.w = cvt_pk_bf16(silu_mul(g1[2], u1[2]), silu_mul(g1[3], u1[3]));
                WT_STORE16(rs_, (row * 2816u + col0) * 2u, w); }
            __builtin_amdgcn_sched_barrier(0);
        }
        if (ld) ((PG8_LAS float*)(lds + SCALE_LDS))[(par ^ 1) * 256 + tid] = __builtin_amdgcn_rsqf((float)nsq * (1.f / (1048576.f * 1024.f)) + 1e-6f);
    }
};
template <bool F32IN> struct EpiRes {
    static constexpr bool PERM = true, AFTER_DRAIN = false, HAS_PRE = false, IS_FINAL = false;
    const float* in_f32; bf16_t* xb; u64* sqa; float alpha;
    __device__ __forceinline__ void finish(const f32x4& v0, const f32x4& v1, unsigned off, float& ss) const {
        u32x4 w; w.x = cvt_pk_bf16(v0[0], v0[1]); w.y = cvt_pk_bf16(v0[2], v0[3]); w.z = cvt_pk_bf16(v1[0], v1[1]); w.w = cvt_pk_bf16(v1[2], v1[3]);
        WT_STORE16(WT_RSRC(xb), off * 2u, w);
        ss += ((v0[0] * v0[0] + v0[1] * v0[1]) + (v0[2] * v0[2] + v0[3] * v0[3])) + ((v1[0] * v1[0] + v1[1] * v1[1]) + (v1[2] * v1[2] + v1[3] * v1[3]));
    }
    __device__ __forceinline__ void operator()(const f32x4 (&acc)[2][2][4][2], const Unit& u, int wr, int wc, int fr, int fq) const {
        const unsigned row0 = u.pm * BM + wr * 64 + fr, col0 = u.pn * BM + wc * 32 + 8 * fq;
        if constexpr (F32IN) {
#pragma unroll
            for (int ai = 0; ai < 2; ++ai)
#pragma unroll
                for (int mp = 0; mp < 2; ++mp) {
                    f32x4 o[2][2][2];
#pragma unroll
                    for (int mm = 0; mm < 2; ++mm)
#pragma unroll
                        for (int bj = 0; bj < 2; ++bj) { const unsigned off = (row0 + ai * HALF + (2 * mp + mm) * 16) * 1024u + col0 + bj * HALF;
                            o[mm][bj][0] = *(const f32x4*)(in_f32 + off); o[mm][bj][1] = *(const f32x4*)(in_f32 + (off + 4u)); }
#pragma unroll
                    for (int mm = 0; mm < 2; ++mm) { const int m = 2 * mp + mm; const unsigned row = row0 + ai * HALF + m * 16; float ss = 0.f;
#pragma unroll
                        for (int bj = 0; bj < 2; ++bj) finish(o[mm][bj][0] + acc[ai][bj][m][0] * alpha, o[mm][bj][1] + acc[ai][bj][m][1] * alpha, row * 1024u + col0 + bj * HALF, ss);
                        ss += __shfl_xor(ss, 16); ss += __shfl_xor(ss, 32);
                        if (fq == 0) atomicAdd(sqa + row, (u64)(ss * 1048576.f)); }
                    __builtin_amdgcn_sched_barrier(0);
                }
        } else {
            u32x4 t[2][4][2];
#pragma unroll
            for (int ai = 0; ai < 2; ++ai)
#pragma unroll
                for (int m = 0; m < 4; ++m)
#pragma unroll
                    for (int bj = 0; bj < 2; ++bj) t[ai][m][bj] = *(const u32x4*)(xb + ((row0 + ai * HALF + m * 16) * 1024u + col0 + bj * HALF));
            __builtin_amdgcn_sched_barrier(0);
#pragma unroll
            for (int ai = 0; ai < 2; ++ai) {
#pragma unroll
                for (int m = 0; m < 4; ++m) { const unsigned row = row0 + ai * HALF + m * 16; float ss = 0.f;
#pragma unroll
                    for (int bj = 0; bj < 2; ++bj) { const u32x4 w0 = t[ai][m][bj];
                        const f32x4 o0 = {__builtin_bit_cast(float, w0.x << 16), __builtin_bit_cast(float, w0.x & 0xffff0000u), __builtin_bit_cast(float, w0.y << 16), __builtin_bit_cast(float, w0.y & 0xffff0000u)};
                        const f32x4 o1 = {__builtin_bit_cast(float, w0.z << 16), __builtin_bit_cast(float, w0.z & 0xffff0000u), __builtin_bit_cast(float, w0.w << 16), __builtin_bit_cast(float, w0.w & 0xffff0000u)};
                        finish(o0 + acc[ai][bj][m][0] * alpha, o1 + acc[ai][bj][m][1] * alpha, row * 1024u + col0 + bj * HALF, ss); }
                    ss += __shfl_xor(ss, 16); ss += __shfl_xor(ss, 32);
                    if (fq == 0) atomicAdd(sqa + row, (u64)(ss * 1048576.f)); }
                __builtin_amdgcn_sched_barrier(0);
            }
        }
    }
};
__device__ __forceinline__ void cs_f64(float ang, float& c, float& s) {
    double t = (double)ang * 0.15915494309189535; t -= __builtin_rint(t); const float r = (float)t;
    c = __builtin_amdgcn_cosf(r); s = __builtin_amdgcn_sinf(r);
}
struct EpiProjEven {
    static constexpr bool PERM = true, AFTER_DRAIN = false, HAS_PRE = true, IS_FINAL = false;
    bf16_t* O; const u64* sq; u64* sqz; const float* gq; const float* gk; const float* rope; float qscale;
    __device__ __forceinline__ void pre_first(const Unit& u, PG8_LAS unsigned char* lds, int tid) const {
        if (tid < 256) ((PG8_LAS float*)(lds + SCALE_LDS))[tid] = row_scale(sq, u.pm * BM + tid);
    }
    __device__ __forceinline__ void operator()(const f32x4 (&acc)[2][2][4][2], const Unit& u, const Unit& nx, bool has_next, int par, PG8_LAS unsigned char* lds, int tid, int wr, int wc, int fr, int fq) const {
        u64 nsq = 0; const bool ld = has_next && tid < 256; if (ld) nsq = sq[nx.pm * BM + tid];
        const PG8_LAS float* sc = (const PG8_LAS float*)(lds + SCALE_LDS) + par * 256;
        const unsigned rl0 = wr * 64 + fr, row0 = u.pm * BM + rl0; const auto rs_ = WT_RSRC(O);
        const int hs = u.pn * 4 + wc;
        const unsigned ocol = 64u * hs + 8u * fq;
        const bool zr = (u.pn == 0) && (wc == 0) && (fq == 0);
        const bool isq = (hs < 8) || (hs >= 12 && hs < 20);
        const float qs = isq ? qscale : 1.f;
        const bool hi32 = (fq & 2) != 0;
        if (hs < 10) {
            const float* gp = (hs < 8) ? gq : gk;
            f32x4 g[2][2], iv[2];
#pragma unroll
            for (int bj = 0; bj < 2; ++bj)
#pragma unroll
                for (int n = 0; n < 2; ++n) g[bj][n] = *(const f32x4*)(gp + 32 * bj + 8 * fq + 4 * n);
#pragma unroll
            for (int n = 0; n < 2; ++n) iv[n] = *(const f32x4*)(rope + 8 * (fq & 1) + 4 * n) * 0.15915494309189535f;
#pragma unroll
            for (int ai = 0; ai < 2; ++ai) {
#pragma unroll
                for (int m = 0; m < 4; ++m) { const unsigned row = row0 + ai * HALF + m * 16; const float s = sc[rl0 + ai * HALF + m * 16]; if (zr) sqz[row] = 0ull;
                    f32x4 v[2][2]; float ss = 0.f;
#pragma unroll
                    for (int bj = 0; bj < 2; ++bj)
#pragma unroll
                        for (int n = 0; n < 2; ++n) { v[bj][n] = acc[ai][bj][m][n] * s; ss += (v[bj][n][0] * v[bj][n][0] + v[bj][n][1] * v[bj][n][1]) + (v[bj][n][2] * v[bj][n][2] + v[bj][n][3] * v[bj][n][3]); }
                    ss += __shfl_xor(ss, 16); ss += __shfl_xor(ss, 32);
                    const float rs = __builtin_amdgcn_rsqf(ss * (1.f / 64.f) + 1e-6f) * qs;
#pragma unroll
                    for (int bj = 0; bj < 2; ++bj) { const float pos = (float)(bj ? (row & 63u) : (row >> 6)); float o[8];
#pragma unroll
                        for (int n = 0; n < 2; ++n)
#pragma unroll
                            for (int j = 0; j < 4; ++j) { const float nv = v[bj][n][j] * rs * g[bj][n][j];
                                const auto rr = __builtin_amdgcn_permlane32_swap(__builtin_bit_cast(unsigned, nv), __builtin_bit_cast(unsigned, nv), false, false);
                                const float pr = __builtin_bit_cast(float, hi32 ? rr[0] : rr[1]);
                                const float rev = pos * iv[n][j]; const float c = __builtin_amdgcn_cosf(rev), sn = __builtin_amdgcn_sinf(rev);
                                o[4 * n + j] = hi32 ? (pr * sn + nv * c) : (nv * c - pr * sn); }
                        u32x4 w; w.x = cvt_pk_bf16(o[0], o[1]); w.y = cvt_pk_bf16(o[2], o[3]); w.z = cvt_pk_bf16(o[4], o[5]); w.w = cvt_pk_bf16(o[6], o[7]);
                        WT_STORE16(rs_, (row * 1536u + ocol + 32u * bj) * 2u, w); } }
                __builtin_amdgcn_sched_barrier(0);
            }
        } else if (hs >= 12 && hs < 22) {
            f32x4 iv[2];
#pragma unroll
            for (int n = 0; n < 2; ++n) iv[n] = *(const f32x4*)(rope + 16 + 8 * fq + 4 * n);
#pragma unroll
            for (int ai = 0; ai < 2; ++ai) {
#pragma unroll
                for (int m = 0; m < 4; ++m) { const unsigned row = row0 + ai * HALF + m * 16; const float s = sc[rl0 + ai * HALF + m * 16] * qs; if (zr) sqz[row] = 0ull;
                    float o1[8], o2[8]; const float pos = (float)row;
#pragma unroll
                    for (int n = 0; n < 2; ++n)
#pragma unroll
                        for (int j = 0; j < 4; ++j) { float c, sn; cs_f64(pos * iv[n][j], c, sn);
                            const float x1 = acc[ai][0][m][n][j] * s, x2 = acc[ai][1][m][n][j] * s;
                            o1[4 * n + j] = x1 * c - x2 * sn; o2[4 * n + j] = x1 * sn + x2 * c; }
                    u32x4 w; w.x = cvt_pk_bf16(o1[0], o1[1]); w.y = cvt_pk_bf16(o1[2], o1[3]); w.z = cvt_pk_bf16(o1[4], o1[5]); w.w = cvt_pk_bf16(o1[6], o1[7]);
                    WT_STORE16(rs_, (row * 1536u + ocol) * 2u, w);
                    w.x = cvt_pk_bf16(o2[0], o2[1]); w.y = cvt_pk_bf16(o2[2], o2[3]); w.z = cvt_pk_bf16(o2[4], o2[5]); w.w = cvt_pk_bf16(o2[6], o2[7]);
                    WT_STORE16(rs_, (row * 1536u + ocol + 32u) * 2u, w); }
                __builtin_amdgcn_sched_barrier(0);
            }
        } else {
#pragma unroll
            for (int ai = 0; ai < 2; ++ai) {
#pragma unroll
                for (int m = 0; m < 4; ++m) { const unsigned row = row0 + ai * HALF + m * 16; const float s = sc[rl0 + ai * HALF + m * 16]; if (zr) sqz[row] = 0ull;
#pragma unroll
                    for (int bj = 0; bj < 2; ++bj) { const f32x4 v0 = acc[ai][bj][m][0] * s, v1 = acc[ai][bj][m][1] * s;
                        u32x4 w; w.x = cvt_pk_bf16(v0[0], v0[1]); w.y = cvt_pk_bf16(v0[2], v0[3]); w.z = cvt_pk_bf16(v1[0], v1[1]); w.w = cvt_pk_bf16(v1[2], v1[3]);
                        WT_STORE16(rs_, (row * 1536u + ocol + 32u * bj) * 2u, w); } }
                __builtin_amdgcn_sched_barrier(0);
            }
        }
        if (ld) ((PG8_LAS float*)(lds + SCALE_LDS))[(par ^ 1) * 256 + tid] = __builtin_amdgcn_rsqf((float)nsq * (1.f / (1048576.f * 1024.f)) + 1e-6f);
    }
};
struct EpiFinal {
    static constexpr bool PERM = true, AFTER_DRAIN = false, HAS_PRE = false, IS_FINAL = true;
    const bf16_t* xb; float* out; u64* sqa; unsigned* cnt; const float* gain; float alpha;
    __device__ __forceinline__ void fin(f32x4 (&acc)[2][2][4][2], const Unit& u, int tid, int wr, int wc, int fr, int fq) const {
        const unsigned row0 = u.pm * BM + wr * 64 + fr, col0 = u.pn * BM + wc * 32 + 8 * fq;
        {
            u32x4 t[2][4][2];
#pragma unroll
            for (int ai = 0; ai < 2; ++ai)
#pragma unroll
                for (int m = 0; m < 4; ++m)
#pragma unroll
                    for (int bj = 0; bj < 2; ++bj) t[ai][m][bj] = *(const u32x4*)(xb + ((row0 + ai * HALF + m * 16) * 1024u + col0 + bj * HALF));
            __builtin_amdgcn_sched_barrier(0);
#pragma unroll
            for (int ai = 0; ai < 2; ++ai)
#pragma unroll
                for (int m = 0; m < 4; ++m) { const unsigned row = row0 + ai * HALF + m * 16; float ss = 0.f;
#pragma unroll
                    for (int bj = 0; bj < 2; ++bj) { const u32x4 w0 = t[ai][m][bj];
                        const f32x4 o0 = {__builtin_bit_cast(float, w0.x << 16), __builtin_bit_cast(float, w0.x & 0xffff0000u), __builtin_bit_cast(float, w0.y << 16), __builtin_bit_cast(float, w0.y & 0xffff0000u)};
                        const f32x4 o1 = {__builtin_bit_cast(float, w0.z << 16), __builtin_bit_cast(float, w0.z & 0xffff0000u), __builtin_bit_cast(float, w0.w << 16), __builtin_bit_cast(float, w0.w & 0xffff0000u)};
                        const f32x4 v0 = o0 + acc[ai][bj][m][0] * alpha, v1 = o1 + acc[ai][bj][m][1] * alpha;
                        acc[ai][bj][m][0] = v0; acc[ai][bj][m][1] = v1;
                        ss += ((v0[0] * v0[0] + v0[1] * v0[1]) + (v0[2] * v0[2] + v0[3] * v0[3])) + ((v1[0] * v1[0] + v1[1] * v1[1]) + (v1[2] * v1[2] + v1[3] * v1[3])); }
                    ss += __shfl_xor(ss, 16); ss += __shfl_xor(ss, 32);
                    if (fq == 0) atomicAdd(sqa + row, (u64)(ss * 1048576.f)); }
        }
        asm volatile("s_waitcnt vmcnt(0)" ::: "memory");
        __builtin_amdgcn_s_barrier();
        unsigned* cw = cnt + 64 * u.pm;
        if (tid == 0) (void)__hip_atomic_fetch_add(cw, 1u, __ATOMIC_RELAXED, __HIP_MEMORY_SCOPE_AGENT);
        if (tid < 64) {
            unsigned sp = 0;
            while ((unsigned)__builtin_amdgcn_readfirstlane(__hip_atomic_load(cw, __ATOMIC_RELAXED, __HIP_MEMORY_SCOPE_AGENT)) < 4u) { __builtin_amdgcn_s_sleep(1); if (++sp > (1u << 20)) break; }
            __builtin_amdgcn_fence(__ATOMIC_ACQUIRE, "agent");
            asm volatile("s_waitcnt vmcnt(0)" ::: "memory");
        }
        asm volatile("" ::: "memory"); __builtin_amdgcn_s_barrier(); asm volatile("" ::: "memory");
        f32x4 gv[2][2];
#pragma unroll
        for (int bj = 0; bj < 2; ++bj) { gv[bj][0] = *(const f32x4*)(gain + col0 + bj * HALF); gv[bj][1] = *(const f32x4*)(gain + col0 + bj * HALF + 4); }
#pragma unroll
        for (int ai = 0; ai < 2; ++ai)
#pragma unroll
            for (int m = 0; m < 4; ++m) { const unsigned row = row0 + ai * HALF + m * 16;
                const u64 tot = __hip_atomic_load(sqa + row, __ATOMIC_RELAXED, __HIP_MEMORY_SCOPE_AGENT);
                const float sc = __builtin_amdgcn_rsqf((float)tot * (1.f / (1048576.f * 1024.f)) + 1e-6f);
#pragma unroll
                for (int bj = 0; bj < 2; ++bj) { const unsigned off = row * 1024u + col0 + bj * HALF;
                    *(f32x4*)(out + off) = acc[ai][bj][m][0] * sc * gv[bj][0]; *(f32x4*)(out + (off + 4u)) = acc[ai][bj][m][1] * sc * gv[bj][1]; } }
    }
};
struct EpiNull {
    static constexpr bool PERM = true, AFTER_DRAIN = false, HAS_PRE = false, IS_FINAL = false;
    float* sink;
    __device__ __forceinline__ void operator()(const f32x4 (&acc)[2][2][4][2], const Unit& u, int wr, int wc, int fr, int fq) const {
        float s = 0.f;
#pragma unroll
        for (int a = 0; a < 2; ++a)
#pragma unroll
            for (int b = 0; b < 2; ++b)
#pragma unroll
                for (int m = 0; m < 4; ++m)
#pragma unroll
                    for (int n = 0; n < 2; ++n) s += acc[a][b][m][n][0] + acc[a][b][m][n][1] + acc[a][b][m][n][2] + acc[a][b][m][n][3];
        if (s == 123.456f) sink[0] = s;
    }
};
struct EpiProj {
    static constexpr bool PERM = true, AFTER_DRAIN = false, HAS_PRE = true, IS_FINAL = false;
    bf16_t* O; unsigned ldc; const u64* sq; u64* sqz; int qcols; float qscale;
    __device__ __forceinline__ void pre_first(const Unit& u, PG8_LAS unsigned char* lds, int tid) const {
        if (tid < 256) ((PG8_LAS float*)(lds + SCALE_LDS))[tid] = row_scale(sq, u.pm * BM + tid);
    }
    __device__ __forceinline__ void operator()(const f32x4 (&acc)[2][2][4][2], const Unit& u, const Unit& nx, bool has_next, int par, PG8_LAS unsigned char* lds, int tid, int wr, int wc, int fr, int fq) const {
        u64 nsq = 0; const bool ld = has_next && tid < 256; if (ld) nsq = sq[nx.pm * BM + tid];
        const PG8_LAS float* sc = (const PG8_LAS float*)(lds + SCALE_LDS) + par * 256;
        const unsigned rl0 = wr * 64 + fr, row0 = u.pm * BM + rl0, col0 = u.pn * BM + wc * 32 + 8 * fq; const auto rs_ = WT_RSRC(O);
        const float cs = (u.pn * BM < qcols) ? qscale : 1.f;
        const bool zr = (u.pn == 0) && (wc == 0) && (fq == 0);
#pragma unroll
        for (int ai = 0; ai < 2; ++ai) {
#pragma unroll
            for (int m = 0; m < 4; ++m) { const unsigned row = row0 + ai * HALF + m * 16; const float s = sc[rl0 + ai * HALF + m * 16] * cs; if (zr) sqz[row] = 0ull;
#pragma unroll
                for (int bj = 0; bj < 2; ++bj) { const f32x4 v0 = acc[ai][bj][m][0] * s, v1 = acc[ai][bj][m][1] * s;
                    u32x4 w; w.x = cvt_pk_bf16(v0[0], v0[1]); w.y = cvt_pk_bf16(v0[2], v0[3]); w.z = cvt_pk_bf16(v1[0], v1[1]); w.w = cvt_pk_bf16(v1[2], v1[3]);
                    WT_STORE16(rs_, (row * ldc + col0 + bj * HALF) * 2u, w); } }
            __builtin_amdgcn_sched_barrier(0);
        }
        if (ld) ((PG8_LAS float*)(lds + SCALE_LDS))[(par ^ 1) * 256 + tid] = __builtin_amdgcn_rsqf((float)nsq * (1.f / (1048576.f * 1024.f)) + 1e-6f);
    }
};
template <class Epi, class Sched, bool ALIGN_EPI = false, bool SP2 = false>
__device__ __forceinline__ void gemm_phase(PG8_LAS unsigned char* lds, Gemm g, const Sched& S, const Epi& E) {
    asm volatile("" : "+s"(g.A), "+s"(g.Bt));
    int tid = threadIdx.x; asm volatile("" : "+v"(tid));
    const int wid = __builtin_amdgcn_readfirstlane(tid >> 6), lane = tid & 63, wr = wid >> 2, wc = wid & 3, fr = lane & 15, fq = lane >> 4;
    const int K = g.K, nt = K / BK;
    unsigned voffA[2], voffB[2];
#pragma unroll
    for (int i = 0; i < 2; ++i) { int R, C; stage_rc(tid * 16 + i * 8192, R, C); const int Rb = Epi::PERM ? ((R & ~31) + perm32(R & 31)) : R;
        voffA[i] = (unsigned)(R * K + C) * 2u; voffB[i] = (unsigned)(Rb * K + C) * 2u; }
    const size_t kstep = (size_t)(BK * 2);
    const size_t hstep = (size_t)HALF * K * 2;
    const size_t tstep = 2 * hstep;
    const unsigned ldsw = (unsigned)wid * 1024u;
    const int aoff = lds_byte(wr * 64 + fr, fq * 8), boff = lds_byte(wc * 32 + fr, fq * 8);
#define PG8_SA(b, h) (((b) * 2 + (h)) * HTB)
#define PG8_SB(b, h) ((4 + (b) * 2 + (h)) * HTB)
#define PG8_STAGE(bufoff, gbase, voff) do { _Pragma("unroll") for (int _i = 0; _i < 2; ++_i) \
        __builtin_amdgcn_global_load_lds((const unsigned*)((const char*)(gbase) + (voff)[_i]), (PG8_LAS unsigned*)(lds + (bufoff) + ldsw + _i * 8192), 16, 0, 0); } while (0)
#define PG8_LDA(dst, b, h) do { _Pragma("unroll") for (int m = 0; m < 4; ++m) _Pragma("unroll") for (int k = 0; k < 2; ++k) dst[m][k] = *(const PG8_LAS bf16x8*)(lds + PG8_SA(b, h) + aoff + m * 2048 + k * 1024); } while (0)
#define PG8_LDB(dst, b, h) do { _Pragma("unroll") for (int n = 0; n < 2; ++n) _Pragma("unroll") for (int k = 0; k < 2; ++k) dst[n][k] = *(const PG8_LAS bf16x8*)(lds + PG8_SB(b, h) + boff + n * 2048 + k * 1024); } while (0)
#define PG8_MMA(ai, bj, At, Bt) do { __builtin_amdgcn_s_setprio(1); _Pragma("unroll") for (int m = 0; m < 4; ++m) _Pragma("unroll") for (int n = 0; n < 2; ++n) _Pragma("unroll") for (int k = 0; k < 2; ++k) \
        acc[ai][bj][m][n] = __builtin_amdgcn_mfma_f32_16x16x32_bf16(Bt[n][k], At[m][k], acc[ai][bj][m][n], 0, 0, 0); __builtin_amdgcn_s_setprio(0); } while (0)
#define PG8_WAIT_V(n) asm volatile("s_waitcnt vmcnt(" #n ")" ::: "memory")
#define PG8_WAIT_L(n) asm volatile("s_waitcnt lgkmcnt(" #n ")" ::: "memory")
#define PG8_BAR __builtin_amdgcn_s_barrier()
#define PG8_SCHED __builtin_amdgcn_sched_barrier(0)
    Unit cur, nxt; int ui = 0;
    if (!S.next(0, cur)) return;
    f32x4 acc[2][2][4][2];
#pragma unroll
    for (int a = 0; a < 2; ++a)
#pragma unroll
        for (int b = 0; b < 2; ++b)
#pragma unroll
            for (int m = 0; m < 4; ++m)
#pragma unroll
                for (int n = 0; n < 2; ++n) acc[a][b][m][n] = (f32x4){0.f, 0.f, 0.f, 0.f};
    bf16x8 At[4][2], B0[2][2], B1[2][2];
    const char* cA = (const char*)g.A + (size_t)cur.pm * tstep; const char* cB = (const char*)g.Bt + (size_t)cur.pn * tstep;
    S.a_ready(cur);
    if constexpr (Epi::HAS_PRE) E.pre_first(cur, lds, tid);
    if constexpr (SP2) {
        PG8_STAGE(PG8_SB(0, 0), cB, voffB); PG8_STAGE(PG8_SB(0, 1), cB + hstep, voffB); PG8_STAGE(PG8_SA(0, 0), cA, voffA); PG8_STAGE(PG8_SA(0, 1), cA + hstep, voffA);
        if (wr == 1) PG8_BAR;
        PG8_WAIT_V(2); PG8_BAR;
        PG8_STAGE(PG8_SB(1, 0), cB + kstep, voffB); PG8_STAGE(PG8_SA(1, 0), cA + kstep, voffA); PG8_STAGE(PG8_SB(1, 1), cB + hstep + kstep, voffB);
        PG8_WAIT_V(6); PG8_BAR;
    } else {
        PG8_STAGE(PG8_SB(0, 0), cB, voffB); PG8_STAGE(PG8_SA(0, 0), cA, voffA); PG8_STAGE(PG8_SB(0, 1), cB + hstep, voffB); PG8_STAGE(PG8_SA(0, 1), cA + hstep, voffA);
        if (wr == 1) PG8_BAR;
        PG8_WAIT_V(4); PG8_BAR;
        PG8_STAGE(PG8_SB(1, 0), cB + kstep, voffB); PG8_STAGE(PG8_SA(1, 0), cA + kstep, voffA); PG8_STAGE(PG8_SB(1, 1), cB + hstep + kstep, voffB);
        PG8_WAIT_V(6); PG8_BAR;
    }
    for (;;) {
        const bool has_next = S.next(ui + 1, nxt);
        const char* nA = has_next ? (const char*)g.A + (size_t)nxt.pm * tstep : cA; const char* nB = has_next ? (const char*)g.Bt + (size_t)nxt.pn * tstep : cB;
        for (int t = 0; t < nt; t += 2) {
            const bool last = (t == nt - 2);
            const char* a1 = cA + (size_t)(t + 1) * kstep;
            const char* a2 = last ? nA : cA + (size_t)(t + 2) * kstep; const char* b2 = last ? nB : cB + (size_t)(t + 2) * kstep;
            const char* a3 = a2 + kstep; const char* b3 = b2 + kstep;
            if (last && has_next) S.a_ready(nxt);
            if constexpr (SP2) {
            PG8_LDB(B0, 0, 0); PG8_LDB(B1, 0, 1); PG8_SCHED; PG8_LDA(At, 0, 0); PG8_STAGE(PG8_SA(1, 1), a1 + hstep, voffA);
            PG8_WAIT_V(8); PG8_WAIT_L(0); PG8_BAR; PG8_MMA(0, 0, At, B0); PG8_MMA(0, 1, At, B1); PG8_BAR; PG8_SCHED;
            PG8_LDA(At, 0, 1); PG8_STAGE(PG8_SB(0, 0), b2, voffB); PG8_STAGE(PG8_SB(0, 1), b2 + hstep, voffB); PG8_STAGE(PG8_SA(0, 0), a2, voffA);
            PG8_WAIT_V(8); PG8_WAIT_L(0); PG8_BAR; PG8_MMA(1, 0, At, B0); PG8_MMA(1, 1, At, B1); PG8_BAR; PG8_SCHED;
            PG8_LDB(B0, 1, 0); PG8_LDB(B1, 1, 1); PG8_SCHED; PG8_LDA(At, 1, 0); PG8_STAGE(PG8_SA(0, 1), a2 + hstep, voffA);
            PG8_WAIT_V(8); PG8_WAIT_L(0); PG8_BAR; PG8_MMA(0, 0, At, B0); PG8_MMA(0, 1, At, B1); PG8_BAR; PG8_SCHED;
            PG8_LDA(At, 1, 1); PG8_STAGE(PG8_SB(1, 0), b3, voffB); PG8_STAGE(PG8_SB(1, 1), b3 + hstep, voffB); PG8_STAGE(PG8_SA(1, 0), a3, voffA);
            PG8_WAIT_V(8); PG8_WAIT_L(0); PG8_BAR; PG8_MMA(1, 0, At, B0); PG8_MMA(1, 1, At, B1); PG8_BAR; PG8_SCHED;
            } else {
            PG8_LDB(B0, 0, 0); PG8_SCHED; PG8_LDA(At, 0, 0); PG8_STAGE(PG8_SA(1, 1), a1 + hstep, voffA);
            PG8_WAIT_L(8); PG8_BAR; PG8_WAIT_L(0); PG8_MMA(0, 0, At, B0); PG8_BAR; PG8_SCHED;
            PG8_LDB(B1, 0, 1); PG8_STAGE(PG8_SB(0, 0), b2, voffB);
            PG8_BAR; PG8_WAIT_L(0); PG8_MMA(0, 1, At, B1); PG8_BAR;
            PG8_LDA(At, 0, 1); PG8_STAGE(PG8_SA(0, 0), a2, voffA);
            PG8_BAR; PG8_WAIT_L(0); PG8_MMA(1, 0, At, B0); PG8_BAR; PG8_SCHED;
            PG8_STAGE(PG8_SB(0, 1), b2 + hstep, voffB);
            PG8_WAIT_V(6); PG8_BAR; PG8_MMA(1, 1, At, B1); PG8_BAR;
            PG8_LDB(B0, 1, 0); PG8_SCHED; PG8_LDA(At, 1, 0); PG8_STAGE(PG8_SA(0, 1), a2 + hstep, voffA);
            PG8_WAIT_L(8); PG8_BAR; PG8_WAIT_L(0); PG8_MMA(0, 0, At, B0); PG8_BAR; PG8_SCHED;
            PG8_LDB(B1, 1, 1); PG8_STAGE(PG8_SB(1, 0), b3, voffB);
            PG8_BAR; PG8_WAIT_L(0); PG8_MMA(0, 1, At, B1); PG8_BAR;
            PG8_LDA(At, 1, 1); PG8_STAGE(PG8_SA(1, 0), a3, voffA);
            PG8_BAR; PG8_WAIT_L(0); PG8_MMA(1, 0, At, B0); PG8_BAR; PG8_SCHED;
            PG8_STAGE(PG8_SB(1, 1), b3 + hstep, voffB);
            PG8_WAIT_V(6); PG8_BAR; PG8_MMA(1, 1, At, B1); PG8_BAR;
            }
        }
        if constexpr (ALIGN_EPI) { if (wr == 0) PG8_BAR; }
        if constexpr (Epi::HAS_PRE) { E(acc, cur, nxt, has_next, ui & 1, lds, tid, wr, wc, fr, fq); S.done(cur); }
        else if constexpr (Epi::IS_FINAL) { E.fin(acc, cur, tid, wr, wc, fr, fq); S.done(cur); }
        else if constexpr (!Epi::AFTER_DRAIN) { E(acc, cur, wr, wc, fr, fq); S.done(cur); }
        if (!has_next) break;
#pragma unroll
        for (int a = 0; a < 2; ++a)
#pragma unroll
            for (int b = 0; b < 2; ++b)
#pragma unroll
                for (int m = 0; m < 4; ++m)
#pragma unroll
                    for (int n = 0; n < 2; ++n) acc[a][b][m][n] = (f32x4){0.f, 0.f, 0.f, 0.f};
        cur = nxt; cA = nA; cB = nB; ++ui;
        if constexpr (ALIGN_EPI) { if (wr == 1) PG8_BAR; }
    }
    PG8_WAIT_V(0);
    if constexpr (!ALIGN_EPI) { if (wr == 0) PG8_BAR; }
    PG8_BAR;
    if constexpr (Epi::AFTER_DRAIN) { E.fused(acc, cur, wr, wc, fr, fq, lds, wid, lane); S.done(cur); }
#undef PG8_SA
#undef PG8_SB
#undef PG8_STAGE
#undef PG8_LDA
#undef PG8_LDB
#undef PG8_MMA
#undef PG8_WAIT_V
#undef PG8_WAIT_L
#undef PG8_BAR
#undef PG8_SCHED
}
}
namespace attn_body {
using bf16=__hip_bfloat16;
using bf16x8=__attribute__((ext_vector_type(8)))short;
using s16x4=__attribute__((ext_vector_type(4)))short;
using f32x16=__attribute__((ext_vector_type(16)))float;
using u32x4=__attribute__((ext_vector_type(4)))unsigned;
constexpr int BATCH=2,NHEAD=16,SEQ=8192,D=64,DM=NHEAD*D;
constexpr int NW=8,QBLK=32,QB=QBLK*NW,KVBLK=64,NQB=SEQ/QB;
constexpr int ATTN_PITCH=DM, ATTN_UNIT_ROWS=QB;
__device__ __forceinline__ int crow(int r,int hi){return (r&3)+8*(r>>2)+4*hi;}
#define SBAR() __builtin_amdgcn_sched_barrier(0)
constexpr int NSLOT=3, SLOTB=8192;
constexpr int LDS_K=0, LDS_V=NSLOT*SLOTB, LDS_WS=2*NSLOT*SLOTB, LDS_OST=LDS_WS+NW*64*4, LDS_BYTES=LDS_OST+NW*4096;
constexpr float C2=0.125f*1.4426950408889634f;
__device__ __forceinline__ void glds16(const void*gsrc,unsigned lds_dst){unsigned keep;
  asm volatile("s_mov_b32 %0, m0\n\ts_mov_b32 m0, %2\n\ts_nop 0\n\tglobal_load_lds_dwordx4 %1, off\n\ts_mov_b32 m0, %0":"=&s"(keep):"v"(gsrc),"s"(lds_dst):"memory");}
__device__ __forceinline__ float max3f(float a,float b,float c){float r;asm("v_max3_f32 %0, %1, %2, %3":"=v"(r):"v"(a),"v"(b),"v"(c));return r;}
__device__ __forceinline__ float max2f(float a,float b){float r;asm("v_max_f32_e32 %0, %1, %2":"=v"(r):"v"(a),"v"(b));return r;}
__device__ __forceinline__ float fadd_s(float a,float b){float r;asm("v_add_f32_e32 %0, %1, %2":"=v"(r):"v"(a),"v"(b));return r;}
__device__ __forceinline__ float fsub_s(float a,float b){float r;asm("v_sub_f32_e32 %0, %1, %2":"=v"(r):"v"(a),"v"(b));return r;}
typedef float f32x2_t __attribute__((ext_vector_type(2))); typedef __bf16 bf16x2_t __attribute__((ext_vector_type(2)));
__device__ __forceinline__ unsigned cvtpk_s(float lo,float hi){f32x2_t v={lo,hi};bf16x2_t b=__builtin_convertvector(v,bf16x2_t);return __builtin_bit_cast(unsigned,b);}
#define WAIT_BAR(N) asm volatile("s_waitcnt vmcnt(" #N ") lgkmcnt(0)\n\ts_barrier":::"memory")

__device__ __forceinline__ void qkt(f32x16&p0,f32x16&p1,const char*Kslot,const bf16x8*qr,const f32x16&negm,int r32,int hi){
  const char*kb=Kslot+hi*1024+r32*16;
  #pragma unroll
  for(int d0=0;d0<4;++d0){
    const bf16x8 b0=*reinterpret_cast<const bf16x8*>(kb+d0*2048);
    const bf16x8 b1=*reinterpret_cast<const bf16x8*>(kb+d0*2048+512);
    if(d0==0){p0=__builtin_amdgcn_mfma_f32_32x32x16_bf16(b0,qr[0],negm,0,0,0);p1=__builtin_amdgcn_mfma_f32_32x32x16_bf16(b1,qr[0],negm,0,0,0);}
    else{p0=__builtin_amdgcn_mfma_f32_32x32x16_bf16(b0,qr[d0],p0,0,0,0);p1=__builtin_amdgcn_mfma_f32_32x32x16_bf16(b1,qr[d0],p1,0,0,0);}}
}
typedef __attribute__((address_space(3))) const char* lds_cptr;
typedef short v4i16_t __attribute__((ext_vector_type(4)));
__device__ __forceinline__ void kload8(bf16x8*kf,lds_cptr kp){
  kf[0]=*(const __attribute__((address_space(3))) bf16x8*)(kp);      kf[1]=*(const __attribute__((address_space(3))) bf16x8*)(kp+512);
  kf[2]=*(const __attribute__((address_space(3))) bf16x8*)(kp+2048); kf[3]=*(const __attribute__((address_space(3))) bf16x8*)(kp+2560);
  kf[4]=*(const __attribute__((address_space(3))) bf16x8*)(kp+4096); kf[5]=*(const __attribute__((address_space(3))) bf16x8*)(kp+4608);
  kf[6]=*(const __attribute__((address_space(3))) bf16x8*)(kp+6144); kf[7]=*(const __attribute__((address_space(3))) bf16x8*)(kp+6656);
}
__device__ __forceinline__ void kload2(bf16x8*kf,lds_cptr kp,int j){ kf[2*j]=*(const __attribute__((address_space(3))) bf16x8*)(kp+j*2048); kf[2*j+1]=*(const __attribute__((address_space(3))) bf16x8*)(kp+j*2048+512); }
__device__ __forceinline__ s16x4 vtr(lds_cptr p){ return __builtin_bit_cast(s16x4,__builtin_amdgcn_ds_read_tr16_b64_v4i16((__attribute__((address_space(3))) v4i16_t*)p)); }
__device__ __forceinline__ float rowmax(const f32x16&p0,const f32x16&p1){
  float a=max3f(p0[0],p0[1],p1[0]),b=max3f(p0[2],p0[3],p1[1]);a=max3f(a,p1[2],p1[3]);
  #pragma unroll
  for(int r=4;r<16;r+=4){a=max3f(a,p0[r],p0[r+1]);b=max3f(b,p0[r+2],p0[r+3]);a=max3f(a,p1[r],p1[r+1]);b=max3f(b,p1[r+2],p1[r+3]);}
  const float m=max2f(a,b);
  auto rr=__builtin_amdgcn_permlane32_swap(__float_as_uint(m),__float_as_uint(m),false,false);
  return max2f(__uint_as_float(rr[0]),__uint_as_float(rr[1]));
}
__device__ __forceinline__ void pv(f32x16*o,int vb,bf16x8 pa0,bf16x8 pa1,bf16x8 pa2,bf16x8 pa3){
  #pragma unroll
  for(int d0=0;d0<2;++d0){s16x4 lo[4],hi[4];
    #pragma unroll
    for(int ks=0;ks<4;++ks){
      asm volatile("ds_read_b64_tr_b16 %0,%1 offset:%c2":"=&v"(lo[ks]):"v"(vb),"i"(d0*4096+ks*1024):"memory");
      asm volatile("ds_read_b64_tr_b16 %0,%1 offset:%c2":"=&v"(hi[ks]):"v"(vb),"i"(d0*4096+ks*1024+512):"memory");}
    asm volatile("s_waitcnt lgkmcnt(0)":::"memory");SBAR();
    #define PK(k) (bf16x8){lo[k][0],lo[k][1],lo[k][2],lo[k][3],hi[k][0],hi[k][1],hi[k][2],hi[k][3]}
    o[d0]=__builtin_amdgcn_mfma_f32_32x32x16_bf16(pa0,PK(0),o[d0],0,0,0);
    o[d0]=__builtin_amdgcn_mfma_f32_32x32x16_bf16(pa1,PK(1),o[d0],0,0,0);
    o[d0]=__builtin_amdgcn_mfma_f32_32x32x16_bf16(pa2,PK(2),o[d0],0,0,0);
    o[d0]=__builtin_amdgcn_mfma_f32_32x32x16_bf16(pa3,PK(3),o[d0],0,0,0);
    #undef PK
  }
}
constexpr int NA_DR=656, NA_TAB=15*NA_DR;
constexpr int LDS_BIAS=LDS_BYTES+1024, ATTN_LDS_TOTAL=LDS_BIAS+NA_TAB*4+2048;
constexpr int OPITCH=1024;
typedef __attribute__((address_space(3))) float* lds_fptr;
template<int MODE> __device__ __forceinline__ void amask(f32x16&p0,f32x16&p1,const int kt,const int qpos,const int hi,lds_fptr bias,const int tb0,const int tb1,const int qrow){
  if(MODE==1){
    const int kb=kt*64+4*hi, lo=qpos-128, hq=qpos+128;
    #pragma unroll
    for(int r=0;r<16;++r){const int kv=kb+(r&3)+8*(r>>2); if(kv<lo||kv>hq)p0[r]=-INFINITY; if(kv+32<lo||kv+32>hq)p1[r]=-INFINITY;}
  }
  if(MODE==2){
    const int rs=min(max(qrow-4,0),248);
    if(kt<rs||kt>=rs+8){
      #pragma unroll
      for(int r=0;r<16;++r){p0[r]=-INFINITY;p1[r]=-INFINITY;}
    } else {
      const int dr=kt-qrow+7; lds_fptr b0=bias+dr*NA_DR+tb0, b1=bias+dr*NA_DR+tb1;
      #pragma unroll
      for(int r=0;r<16;++r){const int o=(r&3)+8*(r>>2); p0[r]+=b0[o]; p1[r]+=b1[o];}
    }
  }
}
#define ATTN_STORE16(base,byteoff,v) __builtin_amdgcn_raw_buffer_store_b128((v), __builtin_amdgcn_make_buffer_rsrc((void*)(base), 0, 0x7fffffff, 0x00020000), (int)(byteoff), 0, 16)
template<int MODE,int THRL> __device__ __forceinline__ void attn_unit(const bf16*Qh,const bf16*__restrict__ Kh,const bf16*__restrict__ Vh,bf16*Oh,const int DM,const int q0,const int tile0,const int NT,const float sink_l2,const float*biasg,const bool build,const bool pre,const bool preV,const bf16*nKh,const bf16*nVh,const int ntile0,char*shm){
  int tid=threadIdx.x; asm volatile("":"+v"(tid)); const int lane=tid&63,r32=lane&31,hi=lane>>5; const int wid=__builtin_amdgcn_readfirstlane(tid>>6);
  const bf16*Qw=Qh+(long)(q0+wid*QBLK)*DM;
  const unsigned lds0=(unsigned)(uintptr_t)shm;
  float*wsf=(float*)(shm+LDS_WS)+wid*64;
  const bf16*ksrc=Kh+(long)(tile0*KVBLK+lane)*DM+wid*8;
  const bf16*vsrc=Vh+(long)(tile0*KVBLK+16*(wid&3)+(lane>>2))*DM+(wid>>2)*32+(lane&3)*8;
  const unsigned kdst=lds0+LDS_K+wid*1024, vdst=lds0+LDS_V+wid*1024;
  #define DMA_K(t,slot) glds16(ksrc+(long)(t)*KVBLK*DM,(unsigned)__builtin_amdgcn_readfirstlane(kdst+(slot)))
  #define DMA_V(t,slot) glds16(vsrc+(long)(t)*KVBLK*DM,(unsigned)__builtin_amdgcn_readfirstlane(vdst+(slot)))
  const int vb0=(int)(lds0+LDS_V)+((lane>>4)&1)*32+(lane&3)*8+(4*hi+((lane&15)>>2))*64;
  const char*Kbase=shm+LDS_K; bf16x8 kf[8];
  const lds_cptr shm3=(lds_cptr)shm; const lds_cptr kp0=shm3+LDS_K+hi*1024+r32*16; const lds_cptr vp0=shm3+LDS_V+((lane>>4)&1)*32+(lane&3)*8+(4*hi+((lane&15)>>2))*64;
  lds_fptr biasl=(lds_fptr)((lds_cptr)shm+LDS_BIAS);
  if(MODE==2&&build){
    lds_fptr stg=biasl+NA_TAB; if(tid<465) stg[tid]=biasg[tid]*1.4426950408889634f;
    asm volatile("s_waitcnt vmcnt(0) lgkmcnt(0)\n\ts_barrier":::"memory");
    for(int e=tid;e<NA_TAB;e+=512){ const int dr=e/NA_DR, w=e-dr*NA_DR; int idx=-1;
      if(w<112){ if(w>=48&&w<64) idx=w-41; } else if(w<144){ } else if(w<400){ const int q=(w-144)>>5, kc=(w-144)&31; if(kc<16) idx=kc-q+15; } else { const int q=(w-400)>>5, j=(w-400)&31; if(j>=16) idx=j-q-9; }
      biasl[e]=(idx>=0)?stg[dr*31+idx]:-INFINITY; } }
  if(!pre){DMA_K(0,0);} if(!preV){DMA_V(0,0);} if(!pre){DMA_K(1,SLOTB);}
  bf16x8 qr[4];
  #pragma unroll
  for(int d0=0;d0<4;++d0)qr[d0]=*reinterpret_cast<const bf16x8*>(&Qw[(long)r32*DM+d0*16+hi*8]);
  float mhat=0.f,l_reg=0.f;f32x16 o[2];o[0]=f32x16{};o[1]=f32x16{};f32x16 negm=f32x16{};asm volatile("":"+v"(negm));
  const int qpos=q0+wid*QBLK+r32; const int qrow=(q0>>6)+(wid>>1);
  int tb0=0,tb1=0; if(MODE==2){ const int qc=qpos&63; if(qc<8){tb0=144+qc*32;tb1=112;} else if(qc>=56){tb0=112;tb1=400+(qc-56)*32;} else {tb0=56-qc;tb1=tb0+32;} tb0+=4*hi;tb1+=4*hi; }
  #define CMASK(P0,P1,t) amask<MODE>(P0,P1,tile0+(t),qpos,hi,biasl,tb0,tb1,qrow)
  bool resc=false;
  #define START(P0,P1) do{ const float rm=rowmax(P0,P1); resc=false; \
    { const float dl=(MODE==0)?rm:__builtin_fmaxf(rm,-64.f); mhat=fadd_s(mhat,dl); \
      _Pragma("unroll") for(int r=0;r<16;++r){P0[r]=fsub_s(P0[r],dl);P1[r]=fsub_s(P1[r],dl);} \
      _Pragma("unroll") for(int r=0;r<16;++r)negm[r]=-mhat; asm volatile("":"+v"(negm)); } \
    _Pragma("unroll") for(int r=0;r<16;++r)P0[r]=__builtin_amdgcn_exp2f(P0[r]); }while(0)
  #define RESC() do{ if(resc){ asm volatile("s_waitcnt lgkmcnt(0)":::"memory"); \
      _Pragma("unroll") for(int d_=0;d_<2;++d_) _Pragma("unroll") for(int r=0;r<16;++r)o[d_][r]*=wsf[crow(r,hi)]; } }while(0)
  f32x16 pA0,pA1,pB0,pB1;
  int sl_prev=0,sl_cur=0,sl_next=SLOTB;
  #define ROT() do{sl_prev=sl_cur;sl_cur=sl_next;sl_next=(sl_next==(NSLOT-1)*SLOTB)?0:sl_next+SLOTB;}while(0)
  DMA_K(2,2*SLOTB);
  WAIT_BAR(3);
  qkt(pA0,pA1,Kbase,qr,negm,r32,hi);asm volatile("s_nop 15\n\ts_nop 7":"+v"(pA0),"+v"(pA1));CMASK(pA0,pA1,0);
  START(pA0,pA1);
  _Pragma("unroll") for(int r=0;r<16;++r)pA1[r]=__builtin_amdgcn_exp2f(pA1[r]);
  WAIT_BAR(0);
  DMA_K(3,0);DMA_V(1,SLOTB);
  ROT();
  kload8(kf,kp0+sl_cur);
  WAIT_BAR(2);
  s16x4 vlo[8],vhi[8]; u32x4 pw0,pw1,pw2,pw3;
  #define PKW(P,B) cvtpk_s(P[B],P[B+1])
  #define PAF(k) __builtin_bit_cast(bf16x8,pw##k)
  #define VFR(i) (bf16x8){vlo[i][0],vlo[i][1],vlo[i][2],vlo[i][3],vhi[i][0],vhi[i][1],vhi[i][2],vhi[i][3]}
  #define PIN(x) asm volatile("":"+v"(x))
  #define MX3(a,b,c) __builtin_fmaxf(__builtin_fmaxf((a),(b)),(c))
  #define GAPA(MF,A0,A1,A2,A3,W0,W1,PW) do{ MF; sacc+=A0; sacc+=A1; sacc+=A2; sacc+=A3; PIN(sacc); W0; W1; PIN(PW); SBAR(); }while(0)
  #define EX(v) __builtin_amdgcn_exp2f(v)
  #define GAPB(MF,X,B) do{ MF; X[B]=EX(X[B]); X[B+1]=EX(X[B+1]); X[B+2]=EX(X[B+2]); X[B+3]=EX(X[B+3]); PIN(X); SBAR(); }while(0)
  #define VRD(i) do{ vlo[i]=vtr(vp_+(((i)>>2)*4096+((i)&3)*1024)); vhi[i]=vtr(vp_+(((i)>>2)*4096+((i)&3)*1024+512)); }while(0)
  #define KRD(G,j) do{ if(G){ kload2(kf,kp0+sl_next,j); SBAR(); } }while(0)
  #define STEP(C0,C1,P0,P1,t,GK,GV,GL) do{ SBAR(); \
    const lds_cptr vp_=vp0+sl_prev; \
    VRD(0); SBAR(); float sacc=(P0[0]+P0[1]); \
    GAPA(C0=__builtin_amdgcn_mfma_f32_32x32x16_bf16(kf[0],qr[0],negm,0,0,0), P0[2],P0[3],P0[4],P0[5],     pw0[0]=PKW(P0,0), pw0[1]=PKW(P0,2), pw0); \
    VRD(4); SBAR(); GAPA(C1=__builtin_amdgcn_mfma_f32_32x32x16_bf16(kf[1],qr[0],negm,0,0,0), P0[6],P0[7],P0[8],P0[9],     pw0[2]=PKW(P0,4), pw0[3]=PKW(P0,6), pw0); \
    VRD(1); SBAR(); GAPA(C0=__builtin_amdgcn_mfma_f32_32x32x16_bf16(kf[2],qr[1],C0,0,0,0),   P0[10],P0[11],P0[12],P0[13], pw1[0]=PKW(P0,8), pw1[1]=PKW(P0,10), pw1); \
    VRD(5); SBAR(); GAPA(C1=__builtin_amdgcn_mfma_f32_32x32x16_bf16(kf[3],qr[1],C1,0,0,0),   P0[14],P0[15],P1[0],P1[1],   pw1[2]=PKW(P0,12),pw1[3]=PKW(P0,14), pw1); \
    VRD(2); SBAR(); GAPA(C0=__builtin_amdgcn_mfma_f32_32x32x16_bf16(kf[4],qr[2],C0,0,0,0),   P1[2],P1[3],P1[4],P1[5],     pw2[0]=PKW(P1,0), pw2[1]=PKW(P1,2), pw2); \
    VRD(6); SBAR(); GAPA(C1=__builtin_amdgcn_mfma_f32_32x32x16_bf16(kf[5],qr[2],C1,0,0,0),   P1[6],P1[7],P1[8],P1[9],     pw2[2]=PKW(P1,4), pw2[3]=PKW(P1,6), pw2); \
    VRD(3); SBAR(); GAPA(C0=__builtin_amdgcn_mfma_f32_32x32x16_bf16(kf[6],qr[3],C0,0,0,0),   P1[10],P1[11],P1[12],P1[13], pw3[0]=PKW(P1,8), pw3[1]=PKW(P1,10), pw3); \
    VRD(7); SBAR(); GAPA(C1=__builtin_amdgcn_mfma_f32_32x32x16_bf16(kf[7],qr[3],C1,0,0,0),   P1[14],P1[15],0.f,0.f,       pw3[2]=PKW(P1,12),pw3[3]=PKW(P1,14), pw3); \
    l_reg+=sacc; \
    if(GK){DMA_K((t)+3,sl_cur);} if(GV){DMA_V((t)+1,sl_next);} \
    CMASK(C0,C1,t); \
    { float a=MX3(C0[0],C0[1],C1[0]),b=MX3(C0[2],C0[3],C1[1]); a=MX3(a,C1[2],C1[3]); \
      _Pragma("unroll") for(int r=4;r<16;r+=4){a=MX3(a,C0[r],C0[r+1]);b=MX3(b,C0[r+2],C0[r+3]);a=MX3(a,C1[r],C1[r+1]);b=MX3(b,C1[r+2],C1[r+3]);} \
      float rm=__builtin_fmaxf(a,b); { auto rr=__builtin_amdgcn_permlane32_swap(__float_as_uint(rm),__float_as_uint(rm),false,false); rm=__builtin_fmaxf(__uint_as_float(rr[0]),__uint_as_float(rr[1])); } \
      resc=false; \
      if(__builtin_expect(__any(rm>(float)THRL),0)){ const float dl=__builtin_fmaxf(rm,0.f); mhat+=dl; \
        _Pragma("unroll") for(int r=0;r<16;++r){C0[r]-=dl;C1[r]-=dl;} \
        _Pragma("unroll") for(int r=0;r<16;++r)negm[r]=-mhat; asm volatile("":"+v"(negm)); \
        const float f=__builtin_amdgcn_exp2f(-dl); l_reg*=f; if(hi==0)wsf[r32]=f; resc=true; } } \
    SBAR(); \
    GAPB(o[0]=__builtin_amdgcn_mfma_f32_32x32x16_bf16(PAF(0),VFR(0),o[0],0,0,0), C0,0); \
    GAPB(o[1]=__builtin_amdgcn_mfma_f32_32x32x16_bf16(PAF(0),VFR(4),o[1],0,0,0), C0,4); \
    KRD(GL,0); GAPB(o[0]=__builtin_amdgcn_mfma_f32_32x32x16_bf16(PAF(1),VFR(1),o[0],0,0,0), C0,8); \
    KRD(GL,1); GAPB(o[1]=__builtin_amdgcn_mfma_f32_32x32x16_bf16(PAF(1),VFR(5),o[1],0,0,0), C0,12); \
    KRD(GL,2); GAPB(o[0]=__builtin_amdgcn_mfma_f32_32x32x16_bf16(PAF(2),VFR(2),o[0],0,0,0), C1,0); \
    KRD(GL,3); GAPB(o[1]=__builtin_amdgcn_mfma_f32_32x32x16_bf16(PAF(2),VFR(6),o[1],0,0,0), C1,4); \
    GAPB(o[0]=__builtin_amdgcn_mfma_f32_32x32x16_bf16(PAF(3),VFR(3),o[0],0,0,0), C1,8); \
    GAPB(o[1]=__builtin_amdgcn_mfma_f32_32x32x16_bf16(PAF(3),VFR(7),o[1],0,0,0), C1,12); \
    }while(0)
  int t=1;
  for(;t+5<NT;t+=2){
    STEP(pB0,pB1,pA0,pA1,t,true,true,true);     WAIT_BAR(2); RESC(); ROT();
    STEP(pA0,pA1,pB0,pB1,t+1,true,true,true);   WAIT_BAR(2); RESC(); ROT();
  }
  #define ENDW(tt) do{ if((tt)+3<NT){WAIT_BAR(2);} else if((tt)+2<NT){WAIT_BAR(1);} else {WAIT_BAR(0);} }while(0)
  for(;t+1<NT;t+=2){
    STEP(pB0,pB1,pA0,pA1,t,(t+3<NT),(t+1<NT),(t+1<NT));       ENDW(t);   RESC(); ROT();
    STEP(pA0,pA1,pB0,pB1,t+1,(t+4<NT),(t+2<NT),(t+2<NT));     ENDW(t+1); RESC(); ROT();
  }
  if(nKh){
    const bf16*nks=nKh+(long)(ntile0*KVBLK+lane)*DM+wid*8;
    glds16(nks,(unsigned)__builtin_amdgcn_readfirstlane(kdst));
    if(NT%3==0){ const bf16*nvs=nVh+(long)(ntile0*KVBLK+16*(wid&3)+(lane>>2))*DM+(wid>>2)*32+(lane&3)*8; glds16(nvs,(unsigned)__builtin_amdgcn_readfirstlane(vdst)); }
    glds16(nks+(long)KVBLK*DM,(unsigned)__builtin_amdgcn_readfirstlane(kdst+SLOTB)); }
  STEP(pB0,pB1,pA0,pA1,NT-1,false,false,false); RESC();
  { float sacc=pB0[0]+pB0[1]; _Pragma("unroll") for(int r=2;r<16;++r)sacc+=pB0[r]; _Pragma("unroll") for(int r=0;r<16;++r)sacc+=pB1[r]; l_reg+=sacc;
    pw0=(u32x4){PKW(pB0,0),PKW(pB0,2),PKW(pB0,4),PKW(pB0,6)};pw1=(u32x4){PKW(pB0,8),PKW(pB0,10),PKW(pB0,12),PKW(pB0,14)};pw2=(u32x4){PKW(pB1,0),PKW(pB1,2),PKW(pB1,4),PKW(pB1,6)};pw3=(u32x4){PKW(pB1,8),PKW(pB1,10),PKW(pB1,12),PKW(pB1,14)};
    SBAR(); pv(o,vb0+sl_cur,PAF(0),PAF(1),PAF(2),PAF(3)); }
  #undef PKW
  #undef PAF
  #undef VFR
  #undef PIN
  #undef MX3
  #undef GAPA
  #undef GAPB
  #undef EX
  #undef VRD
  #undef KRD
  #undef STEP
  #undef ENDW
  {auto rr=__builtin_amdgcn_permlane32_swap(__float_as_uint(l_reg),__float_as_uint(l_reg),false,false);l_reg=__uint_as_float(rr[0])+__uint_as_float(rr[1]);}
  if(MODE==1) l_reg+=__builtin_amdgcn_exp2f(sink_l2-mhat);
  if(hi==0)wsf[32+r32]=l_reg;asm volatile("s_waitcnt lgkmcnt(0)":::"memory");
  float rli[16];
  #pragma unroll
  for(int r=0;r<16;++r)rli[r]=__builtin_amdgcn_rcpf(wsf[32+crow(r,hi)]);
  bf16*Ow=Oh+(long)(q0+wid*QBLK)*OPITCH;
  { bf16*stg=(bf16*)(shm+LDS_OST)+wid*2048;
    #pragma unroll
    for(int r=0;r<16;++r){const int orow=crow(r,hi);
      #pragma unroll
      for(int d0=0;d0<2;++d0)stg[orow*64+d0*32+r32]=__float2bfloat16(o[d0][r]*rli[r]);}
    asm volatile("s_waitcnt lgkmcnt(0)":::"memory");
    #pragma unroll
    for(int i=0;i<4;++i){const int row=i*8+(lane>>3),ch=lane&7; const u32x4 v=*(const u32x4*)(stg+row*64+ch*8); ATTN_STORE16(Oh,(unsigned)(((q0+wid*QBLK+row)*OPITCH+ch*8)*2),v);} }
  asm volatile("s_waitcnt lgkmcnt(0)\n\ts_barrier":::"memory");
  #undef DMA_K
  #undef DMA_V
  #undef CMASK
  #undef START
  #undef RESC
  #undef ROT
}
#undef SBAR
#undef WAIT_BAR
}
#define GAS __attribute__((address_space(1)))
#define LAS __attribute__((address_space(3)))
typedef unsigned short bf16;
typedef unsigned v4u __attribute__((ext_vector_type(4)));
typedef float f32x4 __attribute__((ext_vector_type(4)));
constexpr int NWAVES = 8;
#ifndef REP_P0
#define REP_P0 1
#endif
#ifndef REP_ATT_E
#define REP_ATT_E 1
#endif
#ifndef REP_ATT_O
#define REP_ATT_O 1
#endif
#ifndef REP_GU
#define REP_GU 1
#endif
#ifndef REP_PROJ
#define REP_PROJ 1
#endif
constexpr int LDS_BYTES = 135168;
static_assert(attn_body::ATTN_LDS_TOTAL <= 131072, "attention LDS inside the ring");

constexpr size_t SZ_WGU = (size_t)NGU * DMODEL * 2, SZ_WD = (size_t)DMODEL * DFF * 2;
constexpr size_t WS_WGU = 0;
constexpr size_t WS_WD = WS_WGU + 4 * SZ_WGU;
constexpr size_t WS_WIN = WS_WD + 4 * SZ_WD;
constexpr size_t WS_WOE = WS_WIN + (size_t)1536 * 1024 * 2;
constexpr size_t WS_WQKV = WS_WOE + (size_t)1024 * 1024 * 2;
constexpr size_t WS_WOO = WS_WQKV + (size_t)3072 * 1024 * 2;
constexpr size_t WS_XB = WS_WOO + (size_t)1024 * 1024 * 2;
constexpr size_t WS_PART = WS_XB + (size_t)SEQ * DMODEL * 2;
constexpr size_t WS_U = WS_PART + (size_t)SEQ * 16 * 4;
constexpr size_t WS_PROJ = WS_U, WS_O = WS_U + (size_t)SEQ * 3072 * 2, WS_END = WS_O + (size_t)SEQ * 1024 * 2;
static_assert(WS_END <= 268435456 && WS_U % 256 == 0, "d_ws map");

struct Args { const float* in[19]; float* out; unsigned char* ws; };
typedef unsigned long long u64;
__device__ __forceinline__ u64 ldptr(LAS u64* PT, int i) { const u64 v = PT[i]; const unsigned lo = __builtin_amdgcn_readfirstlane((unsigned)v), hi = __builtin_amdgcn_readfirstlane((unsigned)(v >> 32)); return ((u64)hi << 32) | lo; }

__device__ __forceinline__ unsigned f2bf(float f) { unsigned u = __builtin_bit_cast(unsigned, f); return (u + 0x7fffu + ((u >> 16) & 1u)) >> 16; }
__device__ __forceinline__ unsigned pk2(float lo, float hi) { return f2bf(lo) | (f2bf(hi) << 16); }
__device__ __forceinline__ float bf2f(unsigned short b) { return __builtin_bit_cast(float, (unsigned)b << 16); }
#define LDS_WAIT() asm volatile("s_waitcnt lgkmcnt(0)" ::: "memory")
__device__ __forceinline__ float wave_sum(float v) {
#pragma unroll
    for (int o = 1; o < 64; o <<= 1) v += __shfl_xor(v, o);
    return v;
}
__device__ __forceinline__ void transpose_item(const float* W, int K, int N, bf16* WT, const float* gain, int mode, LAS float* scr, int item, int lane) {
    const int nblk = N / 32, kb = item / nblk, nb = item % nblk, k0 = 64 * kb, n0 = 32 * nb;
    {
        const int kk8 = lane >> 3, seg = lane & 7;
        f32x4 w[8]; float gk[8];
#pragma unroll
        for (int i = 0; i < 8; ++i) { w[i] = __builtin_nontemporal_load((const GAS f32x4*)(W + (size_t)(k0 + 8 * i + kk8) * N + n0 + 4 * seg)); gk[i] = gain ? gain[k0 + 8 * i + kk8] : 1.f; }
#pragma unroll
        for (int i = 0; i < 8; ++i) { LAS float* d = scr + (8 * i + kk8) * 33 + 4 * seg; const f32x4 v = w[i] * gk[i]; d[0] = v.x; d[1] = v.y; d[2] = v.z; d[3] = v.w; }
    }
    LDS_WAIT(); asm volatile("" ::: "memory");
    const int d0 = (mode == 0) ? n0 : (mode == 3) ? ((n0 & ~255) + 128 * ((n0 >> 5) & 1) + 32 * ((n0 & 255) >> 6)) : ((n0 >> 7) * 256 + (n0 & 127) + (mode == 2 ? 128 : 0));
    const auto wrs = __builtin_amdgcn_make_buffer_rsrc((void*)WT, 0, 0x7fffffff, 0x00020000);
    const int c = lane & 7;
#pragma unroll
    for (int j = 0; j < 4; ++j) { const int n = (lane >> 3) + 8 * j; const LAS float* s = scr + (8 * c) * 33 + n;
        v4u o; o.x = pk2(s[0 * 33], s[1 * 33]); o.y = pk2(s[2 * 33], s[3 * 33]); o.z = pk2(s[4 * 33], s[5 * 33]); o.w = pk2(s[6 * 33], s[7 * 33]);
        __builtin_amdgcn_raw_buffer_store_b128(o, wrs, (int)((((unsigned)(d0 + n)) * (unsigned)K + k0 + 8 * c) * 2u), 0, 16); }
    LDS_WAIT(); asm volatile("" ::: "memory");
}

__device__ __forceinline__ void cs_of(float ang, float& c, float& s) {
    double t = (double)ang * 0.15915494309189535; t -= __builtin_rint(t); const float r = (float)t;
    c = __builtin_amdgcn_cosf(r); s = __builtin_amdgcn_sinf(r);
}

#define P_IN(i) ((const float*)(const GAS float*)ldptr(PT, (i)))
#define P_WSB(off) ((bf16*)(GAS bf16*)(ldptr(PT, 20) + (off)))
__device__ __forceinline__ void conv_weights(LAS u64* PT, LAS unsigned char* ldsl, const unsigned mask, const int worker, const int nworkers, const int wave, const int lane) {
    LAS float* scr = (LAS float*)(ldsl + wave * 16384);
    bf16* WGU = P_WSB(WS_WGU); bf16* WD = P_WSB(WS_WD);
    constexpr int I_G = 16 * 88, I_D = 44 * 32, I_IN = 16 * 48, I_O = 16 * 32, I_QKV = 16 * 96;
    for (int it = worker; ; it += nworkers) {
        int r = it;
#define CONV_ENTRY(bit, cnt, call) if (mask & (1u << (bit))) { if (r < (cnt)) { call; continue; } r -= (cnt); }
#define FFN_ITEMS(f_, L_, GI, WG, WU, WDN) { const size_t wo = (size_t)(L_) * DMODEL * DFF; \
            CONV_ENTRY(3 * (f_) + 0, I_G, transpose_item(P_IN(WG) + wo, DMODEL, DFF, WGU + (size_t)(f_) * NGU * DMODEL, P_IN(GI) + (L_) * DMODEL, 1, scr, r, lane)) \
            CONV_ENTRY(3 * (f_) + 1, I_G, transpose_item(P_IN(WU) + wo, DMODEL, DFF, WGU + (size_t)(f_) * NGU * DMODEL, P_IN(GI) + (L_) * DMODEL, 2, scr, r, lane)) \
            CONV_ENTRY(3 * (f_) + 2, I_D, transpose_item(P_IN(WDN) + wo, DFF, DMODEL, WD + (size_t)(f_) * DMODEL * DFF, nullptr, 0, scr, r, lane)) }
        FFN_ITEMS(0, 0, 1, 2, 3, 4)
        FFN_ITEMS(1, 0, 6, 7, 8, 9)
        FFN_ITEMS(2, 1, 1, 2, 3, 4)
        FFN_ITEMS(3, 1, 6, 7, 8, 9)
#undef FFN_ITEMS
        CONV_ENTRY(12, I_IN, transpose_item(P_IN(10), DMODEL, 1536, P_WSB(WS_WIN), P_IN(5), 3, scr, r, lane))
        CONV_ENTRY(13, I_O, transpose_item(P_IN(14), DMODEL, DMODEL, P_WSB(WS_WOE), nullptr, 0, scr, r, lane))
        CONV_ENTRY(14, I_QKV, transpose_item(P_IN(15), DMODEL, 3072, P_WSB(WS_WQKV), P_IN(5) + DMODEL, 0, scr, r, lane))
        CONV_ENTRY(15, I_O, transpose_item(P_IN(17), DMODEL, DMODEL, P_WSB(WS_WOO), nullptr, 0, scr, r, lane))
#undef CONV_ENTRY
        break;
    }
}
#undef P_IN
#undef P_WSB
__device__ __forceinline__ void conv_in_tail(LAS u64* PT, LAS unsigned char* ldsl, const unsigned mask, const int nwg, const int G, const int bx, const int wave, const int lane) {
    const int rem = nwg % G, first = rem;
    if (bx >= first) conv_weights(PT, ldsl, mask, (bx - first) * NWAVES + wave, (G - first) * NWAVES, wave, lane);
}
#define RLX_AGENT __ATOMIC_RELAXED, __HIP_MEMORY_SCOPE_AGENT
#define XB_TMO      128
#define XB_XCNT(j)  (256  + 64 * (j))
#define XB_XSUB(j)  (1280 + 64 * (j))
#define XB_XGEN(j)  (2304 + 64 * (j))
#define XB_TOP      3328
#define XB_TOPGEN   3392
#define XCD_BAR_WORDS 3456
#define XB_SPIN_CAP (1u << 18)

__device__ __forceinline__ unsigned xb_ld(unsigned* p)              { return __hip_atomic_load(p, __ATOMIC_RELAXED, __HIP_MEMORY_SCOPE_AGENT); }
__device__ __forceinline__ unsigned xb_add(unsigned* p, unsigned v) { return __hip_atomic_fetch_add(p, v, __ATOMIC_RELAXED, __HIP_MEMORY_SCOPE_AGENT); }
__device__ __forceinline__ unsigned xb_xcc_id() { return (unsigned)__builtin_amdgcn_s_getreg((3 << 11) | 20) & 0xFu; }
#define XB_SPIN(cond, bar) do { unsigned _sp = 0; while (cond) { __builtin_amdgcn_s_sleep(1); \
    if ((++_sp & 255u) == 0u) { if (xb_ld(&(bar)[XB_TMO])) break; if (_sp > XB_SPIN_CAP) { atomicAdd(&(bar)[XB_TMO], 1u); break; } } } } while (0)

struct XcdBarrier {
    unsigned* bar; unsigned x;
    volatile LAS unsigned* st;
};

__device__ __forceinline__ XcdBarrier xcd_barrier_post(unsigned* bar, volatile LAS unsigned* st) {
    XcdBarrier b; b.bar = bar; b.x = xb_xcc_id(); b.st = st;
    if (threadIdx.x == 0) (void)xb_add(&bar[XB_XCNT(b.x)], 1u);
    return b;
}
__device__ __forceinline__ void xcd_barrier_complete(unsigned* bar, unsigned x, unsigned& nloc, unsigned& nx) {
    const unsigned G = gridDim.x * gridDim.y * gridDim.z;
    unsigned sum, cnt, mine, sp = 0u;
    for (;;) {
        sum = 0u; cnt = 0u; mine = 0u;
#pragma unroll
        for (unsigned j = 0; j < 16; ++j) { const unsigned c = xb_ld(&bar[XB_XCNT(j)]); sum += c; cnt += (c > 0u) ? 1u : 0u; mine = (j == x) ? c : mine; }
        if (sum == G) break;
        __builtin_amdgcn_s_sleep(1);
        if ((++sp & 255u) == 0u) { if (xb_ld(&bar[XB_TMO])) break; if (sp > XB_SPIN_CAP) { atomicAdd(&bar[XB_TMO], 1u); break; } }
    }
    nloc = mine > 0u ? mine : 1u; nx = cnt > 0u ? cnt : 1u;
}

__device__ __forceinline__ void xcd_barrier(const XcdBarrier& b) {
    asm volatile("s_waitcnt vmcnt(0)" ::: "memory");
    __syncthreads();
    if (threadIdx.x == 0) {
        unsigned* bar = b.bar;
        __builtin_amdgcn_s_waitcnt(0);
        unsigned nloc = b.st[0], nx = b.st[1];
        if (nloc == 0u) { xcd_barrier_complete(bar, b.x, nloc, nx); b.st[0] = nloc; b.st[1] = nx; }
        const unsigned old = xb_add(&bar[XB_XSUB(b.x)], 1u);
        const unsigned gen = old / nloc;
        if (old + 1u == (gen + 1u) * nloc) {
            __builtin_amdgcn_fence(__ATOMIC_RELEASE, "agent");
            asm volatile("s_waitcnt vmcnt(0)" ::: "memory");
            const unsigned og = xb_add(&bar[XB_TOP], 1u);
            const unsigned tg = og / nx;
            if (og + 1u == (tg + 1u) * nx) xb_add(&bar[XB_TOPGEN], 1u);
            else XB_SPIN(xb_ld(&bar[XB_TOPGEN]) == tg, bar);
            __builtin_amdgcn_fence(__ATOMIC_ACQUIRE, "agent");
            xb_add(&bar[XB_XGEN(b.x)], 1u);
            asm volatile("s_waitcnt vmcnt(0)" ::: "memory");
        } else {
            XB_SPIN(xb_ld(&bar[XB_XGEN(b.x)]) == gen, bar);
            __builtin_amdgcn_fence(__ATOMIC_ACQUIRE, "agent");
            asm volatile("s_waitcnt vmcnt(0)" ::: "memory");
        }
    }
    __syncthreads();
}

constexpr size_t WS_ROPE = WS_PART + 768 * 1024;
constexpr size_t WS_BAR = WS_PART + 512 * 1024;
__global__ void __launch_bounds__(NWAVES * 64, 2) fwd_megakernel(Args args) {
    extern __shared__ __attribute__((aligned(16))) unsigned char lds[];
    cg::grid_group grid = cg::this_grid();
    LAS unsigned char* ldsl = (LAS unsigned char*)lds;
#define FRESH() int tid = threadIdx.x; asm volatile("" : "+v"(tid)); int G = gridDim.x, bx = blockIdx.x; asm volatile("" : "+s"(G), "+s"(bx)); \
    const int lane = tid & 63, wave = __builtin_amdgcn_readfirstlane(tid >> 6); const int gw = bx * NWAVES + wave, NGW = G * NWAVES; (void)lane; (void)gw; (void)NGW;
    LAS u64* PT = (LAS u64*)(ldsl + 131072);
    if (threadIdx.x == 0) {
#pragma unroll
        for (int i = 0; i < 19; ++i) PT[i] = (u64)args.in[i];
        PT[19] = (u64)args.out; PT[20] = (u64)args.ws;
        ((volatile LAS unsigned*)(ldsl + 131072 + 256))[0] = 0u; ((volatile LAS unsigned*)(ldsl + 131072 + 256))[1] = 0u;
    }
    __syncthreads();
    int par = 0;
#define P_IN(i) ((const float*)(const GAS float*)ldptr(PT, (i)))
#define P_OUT ((float*)(GAS float*)ldptr(PT, 19))
#define P_WSB(off) ((bf16*)(GAS bf16*)(ldptr(PT, 20) + (off)))
#define P_SUMQ ((u64*)(GAS u64*)(ldptr(PT, 20) + WS_PART))

#ifndef NO_P0
    {
        FRESH();
        bf16* XB = P_WSB(WS_XB); u64* SUMQ = P_SUMQ;
        for (int rep = 0; rep < REP_P0; ++rep) {
        conv_weights(PT, ldsl, 0x0003u, gw, NGW, wave, lane);
        if (bx == 0) { unsigned* bw = (unsigned*)(GAS unsigned*)(ldptr(PT, 20) + WS_BAR); for (int i = tid; i < XCD_BAR_WORDS + 64 * 64; i += NWAVES * 64) bw[i] = 0u; }
        if (bx == 0 && tid < 48) { float* rt = (float*)(GAS float*)(ldptr(PT, 20) + WS_ROPE);
            rt[tid] = (tid < 16) ? (float)::exp2(-(double)tid * (2.0 / 32.0) * 13.287712379549449) : (float)::exp2(-(double)(tid - 16) * (2.0 / 64.0) * 13.287712379549449); }
        const float* x = P_IN(0); const auto xrs = __builtin_amdgcn_make_buffer_rsrc((void*)XB, 0, 0x7fffffff, 0x00020000);
        for (int m0 = gw; m0 < SEQ; m0 += 2 * NGW) {
            f32x4 v[2][4]; float s[2];
#pragma unroll
            for (int q = 0; q < 2; ++q) { const int m = m0 + q * NGW; const GAS f32x4* xr = (const GAS f32x4*)(x + (size_t)(m < SEQ ? m : m0) * DMODEL) + lane;
#pragma unroll
                for (int j = 0; j < 4; ++j) v[q][j] = xr[64 * j]; }
#pragma unroll
            for (int q = 0; q < 2; ++q) { const int m = m0 + q * NGW; s[q] = 0.f;
#pragma unroll
                for (int j = 0; j < 4; ++j) s[q] += (v[q][j].x * v[q][j].x + v[q][j].y * v[q][j].y) + (v[q][j].z * v[q][j].z + v[q][j].w * v[q][j].w);
                s[q] = wave_sum(s[q]);
                if (m < SEQ) {
#pragma unroll
                    for (int j = 0; j < 4; ++j) { typedef unsigned v2u __attribute__((ext_vector_type(2))); const v2u w2 = {pk2(v[q][j].x, v[q][j].y), pk2(v[q][j].z, v[q][j].w)};
                        __builtin_amdgcn_raw_buffer_store_b64(w2, xrs, (int)(((unsigned)m * DMODEL + 256u * j + 4u * lane) * 2u), 0, 16); }
                    if (lane == 0) { SUMQ[m] = (unsigned long long)(s[q] * 1048576.f); SUMQ[SEQ + m] = 0ull; }
                } }
        }
        }
    }
    grid.sync();
    { XcdBarrier b0 = xcd_barrier_post((unsigned*)(GAS unsigned*)(ldptr(PT, 20) + WS_BAR), (volatile LAS unsigned*)(ldsl + 131072 + 256)); (void)b0; }
#define GRID_BAR() do { XcdBarrier b_; b_.bar = (unsigned*)(GAS unsigned*)(ldptr(PT, 20) + WS_BAR); b_.x = xb_xcc_id(); b_.st = (volatile LAS unsigned*)(ldsl + 131072 + 256); xcd_barrier(b_); } while (0)
#endif

#pragma unroll 1
    for (int L = 0; L < 2; ++L) {
#pragma unroll 1
        for (int h2 = 0; h2 < 2; ++h2) {
            const int f = 2 * L + h2;
#ifndef NO_GU
            {
                FRESH();
                u64* SUMQ = P_SUMQ; pg8::Gemm g{P_WSB(WS_XB), P_WSB(WS_WGU) + (size_t)f * NGU * DMODEL, SEQ, NGU, DMODEL}; pg8::StaticOrder S; S.init(SEQ, NGU, G, bx);
                pg8::EpiGU E{P_WSB(WS_U), SUMQ + par * SEQ, SUMQ + (par ^ 1) * SEQ};
                for (int rep = 0; rep < ((f == 0) ? REP_GU : 1); ++rep)
                pg8::gemm_phase<pg8::EpiGU, pg8::StaticOrder, true, true>(ldsl, g, S, E);
                { const unsigned cm = (f == 0) ? 0x301Cu : (f == 1) ? 0x02C0u : (f == 2) ? 0xCC00u : 0u; if (cm) conv_in_tail(PT, ldsl, cm, (SEQ / 256) * (NGU / 256), G, bx, wave, lane); }
            }
#endif
            GRID_BAR();
#ifndef NO_DOWN
            {
                FRESH();
                u64* SUMQ = P_SUMQ; pg8::Gemm g{P_WSB(WS_U), P_WSB(WS_WD) + (size_t)f * DMODEL * DFF, SEQ, DMODEL, DFF}; pg8::StaticOrder S; S.init(SEQ, DMODEL, G, bx);
                if (f == 0) { pg8::EpiRes<true> E{P_IN(0), P_WSB(WS_XB), SUMQ + (par ^ 1) * SEQ, 0.5f}; pg8::gemm_phase<pg8::EpiRes<true>, pg8::StaticOrder, true, true>(ldsl, g, S, E); }
                else if (f == 3) { pg8::EpiFinal E{P_WSB(WS_XB), P_OUT, SUMQ + (par ^ 1) * SEQ, (unsigned*)(GAS unsigned*)(ldptr(PT, 20) + WS_BAR) + XCD_BAR_WORDS, P_IN(18), 0.5f};
                    pg8::gemm_phase<pg8::EpiFinal, pg8::StaticOrder, true, true>(ldsl, g, S, E); }
                else { pg8::EpiRes<false> E{nullptr, P_WSB(WS_XB), SUMQ + (par ^ 1) * SEQ, 0.5f}; pg8::gemm_phase<pg8::EpiRes<false>, pg8::StaticOrder, true, true>(ldsl, g, S, E); }
                par ^= 1;
            }
#endif
            if (f == 3) break;
            GRID_BAR();
            if (h2 == 1) continue;
            const int NPROJ = (L == 0) ? 1536 : 3072;
#ifndef NO_PROJ
            {
                FRESH();
                u64* SUMQ = P_SUMQ; pg8::Gemm g{P_WSB(WS_XB), (L == 0) ? P_WSB(WS_WIN) : P_WSB(WS_WQKV), SEQ, NPROJ, DMODEL}; pg8::StaticOrder S; S.init(SEQ, NPROJ, G, bx);
                if (L == 0) {
                    pg8::EpiProjEven E{P_WSB(WS_PROJ), SUMQ + par * SEQ, SUMQ + (par ^ 1) * SEQ, P_IN(11), P_IN(12), (const float*)(const GAS float*)(ldptr(PT, 20) + WS_ROPE), QSCALE};
                    pg8::gemm_phase<pg8::EpiProjEven, pg8::StaticOrder, true, true>(ldsl, g, S, E);
                    conv_in_tail(PT, ldsl, 0x0120u, (SEQ / 256) * (1536 / 256), G, bx, wave, lane);
                } else {
                    pg8::EpiProj E{P_WSB(WS_PROJ), (unsigned)NPROJ, SUMQ + par * SEQ, SUMQ + (par ^ 1) * SEQ, 1024, QSCALE};
                    pg8::gemm_phase<pg8::EpiProj, pg8::StaticOrder, true, true>(ldsl, g, S, E);
                }
            }
#endif
            GRID_BAR();
            if (L == 0) {
                FRESH();
                {
                const attn_body::bf16* P = (const attn_body::bf16*)P_WSB(WS_PROJ); attn_body::bf16* O = (attn_body::bf16*)P_WSB(WS_O);
#define EVEN_KV(u_, kc_, vc_, t0_) { const int uu_ = (u_) & 511, h_ = uu_ & 7, qb_ = uu_ >> 3, kvh_ = h_ >> 2; \
                    if ((u_) < 512) { kc_ = 512 + kvh_ * 64; vc_ = 640 + kvh_ * 64; t0_ = 0; } else { kc_ = 1280 + kvh_ * 64; vc_ = 1408 + kvh_ * 64; t0_ = min(max(qb_ * 4 - 2, 0), 248); } }
                bool pre = false;
                for (int u = bx; u < 1024; u += G) {
                    const int uu = u & 511, h = uu & 7, qb = uu >> 3;
                    int kc, vc, t0; EVEN_KV(u, kc, vc, t0)
                    const int un = u + G; int nkc = 0, nvc = 0, nt0 = 0; const bool hn = un < 1024; if (hn) EVEN_KV(un, nkc, nvc, nt0)
                    const attn_body::bf16* nK = hn ? P + nkc : nullptr; const attn_body::bf16* nV = hn ? P + nvc : nullptr;
                    if (u < 512) attn_body::attn_unit<0, 8>(P + h * 64, P + kc, P + vc, O + h * 64, 1536, qb * 256, 0, 256, 0.f, nullptr, false, pre, false, nK, nV, nt0, (char*)lds);
                    else attn_body::attn_unit<1, 8>(P + 768 + h * 64, P + kc, P + vc, O + 512 + h * 64, 1536, qb * 256, t0, 8, P_IN(13)[h] * LOG2E, nullptr, false, pre, false, nK, nV, nt0, (char*)lds);
                    pre = hn;
                }
#ifdef PROBE_B2
                for (int u = bx + 512; u < 1024; u += G) {
                    const int uu = u & 511, h = uu & 7, qb = uu >> 3; int kc, vc, t0; EVEN_KV(u, kc, vc, t0)
                    attn_body::attn_unit<1, 8>(P + 768 + h * 64, P + kc, P + vc, O + 512 + h * 64, 1536, qb * 256, t0, 8, P_IN(13)[h] * LOG2E, nullptr, false, false, false, nullptr, nullptr, 0, (char*)lds);
                }
#endif
#undef EVEN_KV
                }
            } else {
                FRESH();
                int hb = -1;
#ifdef PROBE_NA24
                for (int u = bx; u < 1024; u += G) {
                    const int h = u & 15, qb = u >> 4; const int t0 = min(max(qb * 4 - 4, 0), 232);
                    const attn_body::bf16* P = (const attn_body::bf16*)P_WSB(WS_PROJ); attn_body::bf16* O = (attn_body::bf16*)P_WSB(WS_O);
                    attn_body::attn_unit<2, 8>(P + h * 64, P + 1024 + h * 64, P + 2048 + h * 64, O + h * 64, 3072, qb * 256, t0, 24, 0.f, P_IN(16) + h * 465, h != hb, false, false, nullptr, nullptr, 0, (char*)lds); hb = h;
                }
#endif
                {
                const attn_body::bf16* P = (const attn_body::bf16*)P_WSB(WS_PROJ); attn_body::bf16* O = (attn_body::bf16*)P_WSB(WS_O);
                bool pre = false;
                for (int u = bx; u < 1024; u += G) {
                    const int h = u & 15, qb = u >> 4; const int t0 = min(max(qb * 4 - 4, 0), 244);
                    const int un = u + G; const bool hn = un < 1024; const int nh = un & 15, nqb = un >> 4, nt0 = min(max(nqb * 4 - 4, 0), 244);
                    attn_body::attn_unit<2, 8>(P + h * 64, P + 1024 + h * 64, P + 2048 + h * 64, O + h * 64, 3072, qb * 256, t0, 12, 0.f, P_IN(16) + h * 465, h != hb, pre, pre,
                                               hn ? P + 1024 + nh * 64 : nullptr, hn ? P + 2048 + nh * 64 : nullptr, nt0, (char*)lds); hb = h;
                    pre = hn;
                }
                }
            }
            GRID_BAR();
#ifndef NO_OUT
            {
                FRESH();
                u64* SUMQ = P_SUMQ; float* OUT = P_OUT; pg8::Gemm g{P_WSB(WS_O), (L == 0) ? P_WSB(WS_WOE) : P_WSB(WS_WOO), SEQ, DMODEL, DMODEL}; pg8::StaticOrder S; S.init(SEQ, DMODEL, G, bx);
                pg8::EpiRes<false> E{nullptr, P_WSB(WS_XB), SUMQ + (par ^ 1) * SEQ, 1.0f}; par ^= 1;
                pg8::gemm_phase<pg8::EpiRes<false>, pg8::StaticOrder, true, true>(ldsl, g, S, E);
            }
#endif
            GRID_BAR();
        }
    }
}

extern "C" void kernel_launch(void* const* d_in, const int* in_sizes, int n_in, void* d_out, int out_size, void* d_ws, size_t ws_size, hipStream_t stream) {
    static int grid = 0;
    if (grid == 0) {
        if (n_in != 19 || out_size != SEQ * DMODEL || ws_size < WS_END) { fprintf(stderr, "kernel_launch: unexpected shapes (n_in %d, out %d, ws %zu < %zu)\n", n_in, out_size, ws_size, (size_t)WS_END); grid = -1; return; }
        int dev = 0, cus = 0, per_cu = 0;
        (void)hipGetDevice(&dev);
        (void)hipDeviceGetAttribute(&cus, hipDeviceAttributeMultiprocessorCount, dev);
        if (hipFuncSetAttribute((const void*)fwd_megakernel, hipFuncAttributeMaxDynamicSharedMemorySize, LDS_BYTES) != hipSuccess) { fprintf(stderr, "kernel_launch: hipFuncSetAttribute failed\n"); grid = -1; return; }
        if (hipOccupancyMaxActiveBlocksPerMultiprocessor(&per_cu, (const void*)fwd_megakernel, NWAVES * 64, LDS_BYTES) != hipSuccess || per_cu < 1) { fprintf(stderr, "kernel_launch: occupancy query failed (%d)\n", per_cu); (void)hipGetLastError(); per_cu = 1; }
        grid = cus * per_cu;
        fprintf(stderr, "kernel_launch: %d CUs x %d = grid %d\n", cus, per_cu, grid);
    }
    if (grid < 0) return;
    Args a{};
    for (int i = 0; i < 19; ++i) a.in[i] = (const float*)d_in[i];
    a.out = (float*)d_out; a.ws = (unsigned char*)d_ws;
    void* kargs[] = {&a};
    hipError_t e = hipLaunchCooperativeKernel((const void*)fwd_megakernel, dim3(grid), dim3(NWAVES * 64), kargs, LDS_BYTES, stream);
    if (e != hipSuccess) fprintf(stderr, "kernel_launch: cooperative launch failed: %s (grid %d)\n", hipGetErrorString(e), grid);
}
```

```cpp
#include <hip/hip_runtime.h>
#include <hip/hip_cooperative_groups.h>
#include <hip/hip_bf16.h>
#include <cstdio>
#include <cstdint>
#include <cmath>
namespace cg = cooperative_groups;

constexpr int SEQ = 16384, DMODEL = 1024, DFF = 2816, NGU = 2 * DFF;
constexpr float RMS_EPS = 1e-6f;
constexpr float LOG2E = 1.4426950408889634f;
constexpr float QSCALE = 0.125f * 1.4426950408889634f;

namespace pg8 {
#define PG8_LAS __attribute__((address_space(3)))
typedef unsigned short bf16_t;
typedef short bf16x8 __attribute__((ext_vector_type(8)));
typedef float f32x4 __attribute__((ext_vector_type(4)));
typedef unsigned u32x4 __attribute__((ext_vector_type(4)));
#define WT_RSRC(base) __builtin_amdgcn_make_buffer_rsrc((void*)(base), 0, 0x7fffffff, 0x00020000)
#define WT_STORE16(rsrc, byteoff, v) __builtin_amdgcn_raw_buffer_store_b128((v), (rsrc), (int)(byteoff), 0, 16)
constexpr int BM = 256, BK = 64, HALF = 128, HTB = HALF * BK * 2  , STAGE_BYTES = 8 * HTB, NXCD = 8, WGM = 8;

__host__ __device__ __forceinline__ int lds_byte(int r, int c) { const int st = (r >> 4) * 2 + (c >> 5), rr = r & 15, cc = c & 31, ob = rr * 64 + cc * 2; return st * 1024 + (ob ^ (((ob >> 9) & 1) << 5)); }
__host__ __device__ __forceinline__ void stage_rc(int b, int& R, int& C) { const int st = b / 1024, sb = b % 1024, swz = sb ^ (((sb >> 9) & 1) << 5); R = (st >> 1) * 16 + swz / 64; C = (st & 1) * 32 + (swz % 64) / 2; }
__host__ __device__ __forceinline__ int perm32(int rho) { const int n = rho >> 4, i = rho & 15; return 8 * (i >> 2) + 4 * n + (i & 3); }

struct Unit { int pm, pn; };
struct Gemm { const bf16_t* A; const bf16_t* Bt; int M, N, K; };

struct StaticOrder {
    int nM, nN, nwg, G, c;
    __host__ __device__ void init(int M, int N, int G_, int c_) { nM = M / BM; nN = N / BM; nwg = nM * nN; G = G_; c = c_; }
    __host__ __device__ bool next(int i, Unit& u) const {
        const long L = (long)i * G + c; if (L >= nwg) return false;
        int wgid = (int)L; { const int q = nwg / NXCD, r = nwg % NXCD, xcd = wgid % NXCD, off = wgid / NXCD; wgid = (xcd < r ? xcd * (q + 1) : r * (q + 1) + (xcd - r) * q) + off; }
        const int nig = WGM * nN, gid = wgid / nig, fm = gid * WGM, gsz = (nM - fm) < WGM ? (nM - fm) : WGM;
        u.pm = fm + ((wgid % nig) % gsz); u.pn = (wgid % nig) / gsz; return true;
    }
    __device__ __forceinline__ void a_ready(const Unit&) const {}
    __device__ __forceinline__ void done(const Unit&) const {}
};

__device__ __forceinline__ unsigned cvt_pk_bf16(float lo, float hi) { unsigned r; asm volatile("v_cvt_pk_bf16_f32 %0, %1, %2" : "=v"(r) : "v"(lo), "v"(hi)); return r; }
typedef unsigned long long u64;
__device__ __forceinline__ float row_scale(const u64* sq, unsigned row) {
    return __builtin_amdgcn_rsqf((float)sq[row] * (1.f / (1048576.f * 1024.f)) + 1e-6f);
}
constexpr int SCALE_LDS = 131072 + 1024;
__device__ __forceinline__ float silu_mul(float g, float u) { return g * u * __builtin_amdgcn_rcpf(1.f + __builtin_amdgcn_exp2f(-1.4426950408889634f * g)); }

struct EpiGU {
    static constexpr bool PERM = true, AFTER_DRAIN = false, HAS_PRE = true, IS_FINAL = false;
    bf16_t* ACT; const u64* sq; u64* sqz;
    __device__ __forceinline__ void pre_first(const Unit& u, PG8_LAS unsigned char* lds, int tid) const {
        if (tid < 256) ((PG8_LAS float*)(lds + SCALE_LDS))[tid] = row_scale(sq, u.pm * BM + tid);
    }
    __device__ __forceinline__ void operator()(const f32x4 (&acc)[2][2][4][2], const Unit& u, const Unit& nx, bool has_next, int par, PG8_LAS unsigned char* lds, int tid, int wr, int wc, int fr, int fq) const {
        u64 nsq = 0; const bool ld = has_next && tid < 256; if (ld) nsq = sq[nx.pm * BM + tid];
        const PG8_LAS float* sc = (const PG8_LAS float*)(lds + SCALE_LDS) + par * 256;
        const unsigned rl0 = wr * 64 + fr, row0 = u.pm * BM + rl0, col0 = u.pn * 128 + wc * 32 + 8 * fq; const auto rs_ = WT_RSRC(ACT);
        const bool zr = (u.pn == 0) && (wc == 0) && (fq == 0);
#pragma unroll
        for (int ai = 0; ai < 2; ++ai) {
#pragma unroll
            for (int m = 0; m < 4; ++m) { const unsigned row = row0 + ai * HALF + m * 16; const float s = sc[rl0 + ai * HALF + m * 16]; if (zr) sqz[row] = 0ull;
                const f32x4 g0 = acc[ai][0][m][0] * s, g1 = acc[ai][0][m][1] * s, u0 = acc[ai][1][m][0] * s, u1 = acc[ai][1][m][1] * s;
                u32x4 w; w.x = cvt_pk_bf16(silu_mul(g0[0], u0[0]), silu_mul(g0[1], u0[1])); w.y = cvt_pk_bf16(silu_mul(g0[2], u0[2]), silu_mul(g0[3], u0[3]));
                w.z = cvt_pk_bf16(silu_mul(g1[0], u1[0]), silu_mul(g1[1], u1[1])); w.w = cvt_pk_bf16(silu_mul(g1[2], u1[2]), silu_mul(g1[3], u1[3]));
                WT_STORE16(rs_, (row * 2816u + col0) * 2u, w); }
            __builtin_amdgcn_sched_barrier(0);
        }
        if (ld) ((PG8_LAS float*)(lds + SCALE_LDS))[(par ^ 1) * 256 + tid] = __builtin_amdgcn_rsqf((float)nsq * (1.f / (1048576.f * 1024.f)) + 1e-6f);
    }
};
template <bool F32IN> struct EpiRes {
    static constexpr bool PERM = true, AFTER_DRAIN = false, HAS_PRE = false, IS_FINAL = false;
    const float* in_f32; bf16_t* xb; u64* sqa; float alpha;
    __device__ __forceinline__ void finish(const f32x4& v0, const f32x4& v1, unsigned off, float& ss) const {
        u32x4 w; w.x = cvt_pk_bf16(v0[0], v0[1]); w.y = cvt_pk_bf16(v0[2], v0[3]); w.z = cvt_pk_bf16(v1[0], v1[1]); w.w = cvt_pk_bf16(v1[2], v1[3]);
        WT_STORE16(WT_RSRC(xb), off * 2u, w);
        ss += ((v0[0] * v0[0] + v0[1] * v0[1]) + (v0[2] * v0[2] + v0[3] * v0[3])) + ((v1[0] * v1[0] + v1[1] * v1[1]) + (v1[2] * v1[2] + v1[3] * v1[3]));
    }
    __device__ __forceinline__ void operator()(const f32x4 (&acc)[2][2][4][2], const Unit& u, int wr, int wc, int fr, int fq) const {
        const unsigned row0 = u.pm * BM + wr * 64 + fr, col0 = u.pn * BM + wc * 32 + 8 * fq;
        if constexpr (F32IN) {
#pragma unroll
            for (int ai = 0; ai < 2; ++ai)
#pragma unroll
                for (int mp = 0; mp < 2; ++mp) {
                    f32x4 o[2][2][2];
#pragma unroll
                    for (int mm = 0; mm < 2; ++mm)
#pragma unroll
                        for (int bj = 0; bj < 2; ++bj) { const unsigned off = (row0 + ai * HALF + (2 * mp + mm) * 16) * 1024u + col0 + bj * HALF;
                            o[mm][bj][0] = *(const f32x4*)(in_f32 + off); o[mm][bj][1] = *(const f32x4*)(in_f32 + (off + 4u)); }
#pragma unroll
                    for (int mm = 0; mm < 2; ++mm) { const int m = 2 * mp + mm; const unsigned row = row0 + ai * HALF + m * 16; float ss = 0.f;
#pragma unroll
                        for (int bj = 0; bj < 2; ++bj) finish(o[mm][bj][0] + acc[ai][bj][m][0] * alpha, o[mm][bj][1] + acc[ai][bj][m][1] * alpha, row * 1024u + col0 + bj * HALF, ss);
                        ss += __shfl_xor(ss, 16); ss += __shfl_xor(ss, 32);
                        if (fq == 0) atomicAdd(sqa + row, (u64)(ss * 1048576.f)); }
                    __builtin_amdgcn_sched_barrier(0);
                }
        } else {
            u32x4 t[2][4][2];
#pragma unroll
            for (int ai = 0; ai < 2; ++ai)
#pragma unroll
                for (int m = 0; m < 4; ++m)
#pragma unroll
                    for (int bj = 0; bj < 2; ++bj) t[ai][m][bj] = *(const u32x4*)(xb + ((row0 + ai * HALF + m * 16) * 1024u + col0 + bj * HALF));
            __builtin_amdgcn_sched_barrier(0);
#pragma unroll
            for (int ai = 0; ai < 2; ++ai) {
#pragma unroll
                for (int m = 0; m < 4; ++m) { const unsigned row = row0 + ai * HALF + m * 16; float ss = 0.f;
#pragma unroll
                    for (int bj = 0; bj < 2; ++bj) { const u32x4 w0 = t[ai][m][bj];
                        const f32x4 o0 = {__builtin_bit_cast(float, w0.x << 16), __builtin_bit_cast(float, w0.x & 0xffff0000u), __builtin_bit_cast(float, w0.y << 16), __builtin_bit_cast(float, w0.y & 0xffff0000u)};
                        const f32x4 o1 = {__builtin_bit_cast(float, w0.z << 16), __builtin_bit_cast(float, w0.z & 0xffff0000u), __builtin_bit_cast(float, w0.w << 16), __builtin_bit_cast(float, w0.w & 0xffff0000u)};
                        finish(o0 + acc[ai][bj][m][0] * alpha, o1 + acc[ai][bj][m][1] * alpha, row * 1024u + col0 + bj * HALF, ss); }
                    ss += __shfl_xor(ss, 16); ss += __shfl_xor(ss, 32);
                    if (fq == 0) atomicAdd(sqa + row, (u64)(ss * 1048576.f)); }
                __builtin_amdgcn_sched_barrier(0);
            }
        }
    }
};
__device__ __forceinline__ void cs_f64(float ang, float& c, float& s) {
    double t = (double)ang * 0.15915494309189535; t -= __builtin_rint(t); const float r = (float)t;
    c = __builtin_amdgcn_cosf(r); s = __builtin_amdgcn_sinf(r);
}
struct EpiProjEven {
    static constexpr bool PERM = true, AFTER_DRAIN = false, HAS_PRE = true, IS_FINAL = false;
    bf16_t* O; const u64* sq; u64* sqz; const float* gq; const float* gk; const float* rope; float qscale;
    __device__ __forceinline__ void pre_first(const Unit& u, PG8_LAS unsigned char* lds, int tid) const {
        if (tid < 256) ((PG8_LAS float*)(lds + SCALE_LDS))[tid] = row_scale(sq, u.pm * BM + tid);
    }
    __device__ __forceinline__ void operator()(const f32x4 (&acc)[2][2][4][2], const Unit& u, const Unit& nx, bool has_next, int par, PG8_LAS unsigned char* lds, int tid, int wr, int wc, int fr, int fq) const {
        u64 nsq = 0; const bool ld = has_next && tid < 256; if (ld) nsq = sq[nx.pm * BM + tid];
        const PG8_LAS float* sc = (const PG8_LAS float*)(lds + SCALE_LDS) + par * 256;
        const unsigned rl0 = wr * 64 + fr, row0 = u.pm * BM + rl0; const auto rs_ = WT_RSRC(O);
        const int hs = u.pn * 4 + wc;
        const unsigned ocol = 64u * hs + 8u * fq;
        const bool zr = (u.pn == 0) && (wc == 0) && (fq == 0);
        const bool isq = (hs < 8) || (hs >= 12 && hs < 20);
        const float qs = isq ? qscale : 1.f;
        const bool hi32 = (fq & 2) != 0;
        if (hs < 10) {
            const float* gp = (hs < 8) ? gq : gk;
            f32x4 g[2][2], iv[2];
#pragma unroll
            for (int bj = 0; bj < 2; ++bj)
#pragma unroll
                for (int n = 0; n < 2; ++n) g[bj][n] = *(const f32x4*)(gp + 32 * bj + 8 * fq + 4 * n);
#pragma unroll
            for (int n = 0; n < 2; ++n) iv[n] = *(const f32x4*)(rope + 8 * (fq & 1) + 4 * n) * 0.15915494309189535f;
#pragma unroll
            for (int ai = 0; ai < 2; ++ai) {
#pragma unroll
                for (int m = 0; m < 4; ++m) { const unsigned row = row0 + ai * HALF + m * 16; const float s = sc[rl0 + ai * HALF + m * 16]; if (zr) sqz[row] = 0ull;
                    f32x4 v[2][2]; float ss = 0.f;
#pragma unroll
                    for (int bj = 0; bj < 2; ++bj)
#pragma unroll
                        for (int n = 0; n < 2; ++n) { v[bj][n] = acc[ai][bj][m][n] * s; ss += (v[bj][n][0] * v[bj][n][0] + v[bj][n][1] * v[bj][n][1]) + (v[bj][n][2] * v[bj][n][2] + v[bj][n][3] * v[bj][n][3]); }
                    ss += __shfl_xor(ss, 16); ss += __shfl_xor(ss, 32);
                    const float rs = __builtin_amdgcn_rsqf(ss * (1.f / 64.f) + 1e-6f) * qs;
#pragma unroll
                    for (int bj = 0; bj < 2; ++bj) { const float pos = (float)(bj ? (row & 63u) : (row >> 6)); float o[8];
#pragma unroll
                        for (int n = 0; n < 2; ++n)
#pragma unroll
                            for (int j = 0; j < 4; ++j) { const float nv = v[bj][n][j] * rs * g[bj][n][j];
                                const auto rr = __builtin_amdgcn_permlane32_swap(__builtin_bit_cast(unsigned, nv), __builtin_bit_cast(unsigned, nv), false, false);
                                const float pr = __builtin_bit_cast(float, hi32 ? rr[0] : rr[1]);
                                const float rev = pos * iv[n][j]; const float c = __builtin_amdgcn_cosf(rev), sn = __builtin_amdgcn_sinf(rev);
                                o[4 * n + j] = hi32 ? (pr * sn + nv * c) : (nv * c - pr * sn); }
                        u32x4 w; w.x = cvt_pk_bf16(o[0], o[1]); w.y = cvt_pk_bf16(o[2], o[3]); w.z = cvt_pk_bf16(o[4], o[5]); w.w = cvt_pk_bf16(o[6], o[7]);
                        WT_STORE16(rs_, (row * 1536u + ocol + 32u * bj) * 2u, w); } }
                __builtin_amdgcn_sched_barrier(0);
            }
        } else if (hs >= 12 && hs < 22) {
            f32x4 iv[2];
#pragma unroll
            for (int n = 0; n < 2; ++n) iv[n] = *(const f32x4*)(rope + 16 + 8 * fq + 4 * n);
#pragma unroll
            for (int ai = 0; ai < 2; ++ai) {
#pragma unroll
                for (int m = 0; m < 4; ++m) { const unsigned row = row0 + ai * HALF + m * 16; const float s = sc[rl0 + ai * HALF + m * 16] * qs; if (zr) sqz[row] = 0ull;
                    float o1[8], o2[8]; const float pos = (float)row;
#pragma unroll
                    for (int n = 0; n < 2; ++n)
#pragma unroll
                        for (int j = 0; j < 4; ++j) { float c, sn; cs_f64(pos * iv[n][j], c, sn);
                            const float x1 = acc[ai][0][m][n][j] * s, x2 = acc[ai][1][m][n][j] * s;
                            o1[4 * n + j] = x1 * c - x2 * sn; o2[4 * n + j] = x1 * sn + x2 * c; }
                    u32x4 w; w.x = cvt_pk_bf16(o1[0], o1[1]); w.y = cvt_pk_bf16(o1[2], o1[3]); w.z = cvt_pk_bf16(o1[4], o1[5]); w.w = cvt_pk_bf16(o1[6], o1[7]);
                    WT_STORE16(rs_, (row * 1536u + ocol) * 2u, w);
                    w.x = cvt_pk_bf16(o2[0], o2[1]); w.y = cvt_pk_bf16(o2[2], o2[3]); w.z = cvt_pk_bf16(o2[4], o2[5]); w.w = cvt_pk_bf16(o2[6], o2[7]);
                    WT_STORE16(rs_, (row * 1536u + ocol + 32u) * 2u, w); }
                __builtin_amdgcn_sched_barrier(0);
            }
        } else {
#pragma unroll
            for (int ai = 0; ai < 2; ++ai) {
#pragma unroll
                for (int m = 0; m < 4; ++m) { const unsigned row = row0 + ai * HALF + m * 16; const float s = sc[rl0 + ai * HALF + m * 16]; if (zr) sqz[row] = 0ull;
#pragma unroll
                    for (int bj = 0; bj < 2; ++bj) { const f32x4 v0 = acc[ai][bj][m][0] * s, v1 = acc[ai][bj][m][1] * s;
                        u32x4 w; w.x = cvt_pk_bf16(v0[0], v0[1]); w.y = cvt_pk_bf16(v0[2], v0[3]); w.z = cvt_pk_bf16(v1[0], v1[1]); w.w = cvt_pk_bf16(v1[2], v1[3]);
                        WT_STORE16(rs_, (row * 1536u + ocol + 32u * bj) * 2u, w); } }
                __builtin_amdgcn_sched_barrier(0);
            }
        }
        if (ld) ((PG8_LAS float*)(lds + SCALE_LDS))[(par ^ 1) * 256 + tid] = __builtin_amdgcn_rsqf((float)nsq * (1.f / (1048576.f * 1024.f)) + 1e-6f);
    }
};
struct EpiFinal {
    static constexpr bool PERM = true, AFTER_DRAIN = false, HAS_PRE = false, IS_FINAL = true;
    const bf16_t* xb; float* out; u64* sqa; unsigned* cnt; const float* gain; float alpha;
    __device__ __forceinline__ void fin(f32x4 (&acc)[2][2][4][2], const Unit& u, int tid, int wr, int wc, int fr, int fq) const {
        const unsigned row0 = u.pm * BM + wr * 64 + fr, col0 = u.pn * BM + wc * 32 + 8 * fq;
        {
            u32x4 t[2][4][2];
#pragma unroll
            for (int ai = 0; ai < 2; ++ai)
#pragma unroll
                for (int m = 0; m < 4; ++m)
#pragma unroll
                    for (int bj = 0; bj < 2; ++bj) t[ai][m][bj] = *(const u32x4*)(xb + ((row0 + ai * HALF + m * 16) * 1024u + col0 + bj * HALF));
            __builtin_amdgcn_sched_barrier(0);
#pragma unroll
            for (int ai = 0; ai < 2; ++ai)
#pragma unroll
                for (int m = 0; m < 4; ++m) { const unsigned row = row0 + ai * HALF + m * 16; float ss = 0.f;
#pragma unroll
                    for (int bj = 0; bj < 2; ++bj) { const u32x4 w0 = t[ai][m][bj];
                        const f32x4 o0 = {__builtin_bit_cast(float, w0.x << 16), __builtin_bit_cast(float, w0.x & 0xffff0000u), __builtin_bit_cast(float, w0.y << 16), __builtin_bit_cast(float, w0.y & 0xffff0000u)};
                        const f32x4 o1 = {__builtin_bit_cast(float, w0.z << 16), __builtin_bit_cast(float, w0.z & 0xffff0000u), __builtin_bit_cast(float, w0.w << 16), __builtin_bit_cast(float, w0.w & 0xffff0000u)};
                        const f32x4 v0 = o0 + acc[ai][bj][m][0] * alpha, v1 = o1 + acc[ai][bj][m][1] * alpha;
                        acc[ai][bj][m][0] = v0; acc[ai][bj][m][1] = v1;
                        ss += ((v0[0] * v0[0] + v0[1] * v0[1]) + (v0[2] * v0[2] + v0[3] * v0[3])) + ((v1[0] * v1[0] + v1[1] * v1[1]) + (v1[2] * v1[2] + v1[3] * v1[3])); }
                    ss += __shfl_xor(ss, 16); ss += __shfl_xor(ss, 32);
                    if (fq == 0) atomicAdd(sqa + row, (u64)(ss * 1048576.f)); }
        }
        asm volatile("s_waitcnt vmcnt(0)" ::: "memory");
        __builtin_amdgcn_s_barrier();
        unsigned* cw = cnt + 64 * u.pm;
        if (tid == 0) (void)__hip_atomic_fetch_add(cw, 1u, __ATOMIC_RELAXED, __HIP_MEMORY_SCOPE_AGENT);
        if (tid < 64) {
            unsigned sp = 0;
            while ((unsigned)__builtin_amdgcn_readfirstlane(__hip_atomic_load(cw, __ATOMIC_RELAXED, __HIP_MEMORY_SCOPE_AGENT)) < 4u) { __builtin_amdgcn_s_sleep(1); if (++sp > (1u << 20)) break; }
            __builtin_amdgcn_fence(__ATOMIC_ACQUIRE, "agent");
            asm volatile("s_waitcnt vmcnt(0)" ::: "memory");
        }
        asm volatile("" ::: "memory"); __builtin_amdgcn_s_barrier(); asm volatile("" ::: "memory");
        f32x4 gv[2][2];
#pragma unroll
        for (int bj = 0; bj < 2; ++bj) { gv[bj][0] = *(const f32x4*)(gain + col0 + bj * HALF); gv[bj][1] = *(const f32x4*)(gain + col0 + bj * HALF + 4); }
#pragma unroll
        for (int ai = 0; ai < 2; ++ai)
#pragma unroll
            for (int m = 0; m < 4; ++m) { const unsigned row = row0 + ai * HALF + m * 16;
                const u64 tot = __hip_atomic_load(sqa + row, __ATOMIC_RELAXED, __HIP_MEMORY_SCOPE_AGENT);
                const float sc = __builtin_amdgcn_rsqf((float)tot * (1.f / (1048576.f * 1024.f)) + 1e-6f);
#pragma unroll
                for (int bj = 0; bj < 2; ++bj) { const unsigned off = row * 1024u + col0 + bj * HALF;
                    *(f32x4*)(out + off) = acc[ai][bj][m][0] * sc * gv[bj][0]; *(f32x4*)(out + (off + 4u)) = acc[ai][bj][m][1] * sc * gv[bj][1]; } }
    }
};
struct EpiNull {
    static constexpr bool PERM = true, AFTER_DRAIN = false, HAS_PRE = false, IS_FINAL = false;
    float* sink;
    __device__ __forceinline__ void operator()(const f32x4 (&acc)[2][2][4][2], const Unit& u, int wr, int wc, int fr, int fq) const {
        float s = 0.f;
#pragma unroll
        for (int a = 0; a < 2; ++a)
#pragma unroll
            for (int b = 0; b < 2; ++b)
#pragma unroll
                for (int m = 0; m < 4; ++m)
#pragma unroll
                    for (int n = 0; n < 2; ++n) s += acc[a][b][m][n][0] + acc[a][b][m][n][1] + acc[a][b][m][n][2] + acc[a][b][m][n][3];
        if (s == 123.456f) sink[0] = s;
    }
};
struct EpiProj {
    static constexpr bool PERM = true, AFTER_DRAIN = false, HAS_PRE = true, IS_FINAL = false;
    bf16_t* O; unsigned ldc; const u64* sq; u64* sqz; int qcols; float qscale;
    __device__ __forceinline__ void pre_first(const Unit& u, PG8_LAS unsigned char* lds, int tid) const {
        if (tid < 256) ((PG8_LAS float*)(lds + SCALE_LDS))[tid] = row_scale(sq, u.pm * BM + tid);
    }
    __device__ __forceinline__ void operator()(const f32x4 (&acc)[2][2][4][2], const Unit& u, const Unit& nx, bool has_next, int par, PG8_LAS unsigned char* lds, int tid, int wr, int wc, int fr, int fq) const {
        u64 nsq = 0; const bool ld = has_next && tid < 256; if (ld) nsq = sq[nx.pm * BM + tid];
        const PG8_LAS float* sc = (const PG8_LAS float*)(lds + SCALE_LDS) + par * 256;
        const unsigned rl0 = wr * 64 + fr, row0 = u.pm * BM + rl0, col0 = u.pn * BM + wc * 32 + 8 * fq; const auto rs_ = WT_RSRC(O);
        const float cs = (u.pn * BM < qcols) ? qscale : 1.f;
        const bool zr = (u.pn == 0) && (wc == 0) && (fq == 0);
#pragma unroll
        for (int ai = 0; ai < 2; ++ai) {
#pragma unroll
            for (int m = 0; m < 4; ++m) { const unsigned row = row0 + ai * HALF + m * 16; const float s = sc[rl0 + ai * HALF + m * 16] * cs; if (zr) sqz[row] = 0ull;
#pragma unroll
                for (int bj = 0; bj < 2; ++bj) { const f32x4 v0 = acc[ai][bj][m][0] * s, v1 = acc[ai][bj][m][1] * s;
                    u32x4 w; w.x = cvt_pk_bf16(v0[0], v0[1]); w.y = cvt_pk_bf16(v0[2], v0[3]); w.z = cvt_pk_bf16(v1[0], v1[1]); w.w = cvt_pk_bf16(v1[2], v1[3]);
                    WT_STORE16(rs_, (row * ldc + col0 + bj * HALF) * 2u, w); } }
            __builtin_amdgcn_sched_barrier(0);
        }
        if (ld) ((PG8_LAS float*)(lds + SCALE_LDS))[(par ^ 1) * 256 + tid] = __builtin_amdgcn_rsqf((float)nsq * (1.f / (1048576.f * 1024.f)) + 1e-6f);
    }
};
template <class Epi, class Sched, bool ALIGN_EPI = false, bool SP2 = false>
__device__ __forceinline__ void gemm_phase(PG8_LAS unsigned char* lds, Gemm g, const Sched& S, const Epi& E) {
    asm volatile("" : "+s"(g.A), "+s"(g.Bt));
    int tid = threadIdx.x; asm volatile("" : "+v"(tid));
    const int wid = __builtin_amdgcn_readfirstlane(tid >> 6), lane = tid & 63, wr = wid >> 2, wc = wid & 3, fr = lane & 15, fq = lane >> 4;
    const int K = g.K, nt = K / BK;
    unsigned voffA[2], voffB[2];
#pragma unroll
    for (int i = 0; i < 2; ++i) { int R, C; stage_rc(tid * 16 + i * 8192, R, C); const int Rb = Epi::PERM ? ((R & ~31) + perm32(R & 31)) : R;
        voffA[i] = (unsigned)(R * K + C) * 2u; voffB[i] = (unsigned)(Rb * K + C) * 2u; }
    const size_t kstep = (size_t)(BK * 2);
    const size_t hstep = (size_t)HALF * K * 2;
    const size_t tstep = 2 * hstep;
    const unsigned ldsw = (unsigned)wid * 1024u;
    const int aoff = lds_byte(wr * 64 + fr, fq * 8), boff = lds_byte(wc * 32 + fr, fq * 8);
#define PG8_SA(b, h) (((b) * 2 + (h)) * HTB)
#define PG8_SB(b, h) ((4 + (b) * 2 + (h)) * HTB)
#define PG8_STAGE(bufoff, gbase, voff) do { _Pragma("unroll") for (int _i = 0; _i < 2; ++_i) \
        __builtin_amdgcn_global_load_lds((const unsigned*)((const char*)(gbase) + (voff)[_i]), (PG8_LAS unsigned*)(lds + (bufoff) + ldsw + _i * 8192), 16, 0, 0); } while (0)
#define PG8_LDA(dst, b, h) do { _Pragma("unroll") for (int m = 0; m < 4; ++m) _Pragma("unroll") for (int k = 0; k < 2; ++k) dst[m][k] = *(const PG8_LAS bf16x8*)(lds + PG8_SA(b, h) + aoff + m * 2048 + k * 1024); } while (0)
#define PG8_LDB(dst, b, h) do { _Pragma("unroll") for (int n = 0; n < 2; ++n) _Pragma("unroll") for (int k = 0; k < 2; ++k) dst[n][k] = *(const PG8_LAS bf16x8*)(lds + PG8_SB(b, h) + boff + n * 2048 + k * 1024); } while (0)
#define PG8_MMA(ai, bj, At, Bt) do { __builtin_amdgcn_s_setprio(1); _Pragma("unroll") for (int m = 0; m < 4; ++m) _Pragma("unroll") for (int n = 0; n < 2; ++n) _Pragma("unroll") for (int k = 0; k < 2; ++k) \
        acc[ai][bj][m][n] = __builtin_amdgcn_mfma_f32_16x16x32_bf16(Bt[n][k], At[m][k], acc[ai][bj][m][n], 0, 0, 0); __builtin_amdgcn_s_setprio(0); } while (0)
#define PG8_WAIT_V(n) asm volatile("s_waitcnt vmcnt(" #n ")" ::: "memory")
#define PG8_WAIT_L(n) asm volatile("s_waitcnt lgkmcnt(" #n ")" ::: "memory")
#define PG8_BAR __builtin_amdgcn_s_barrier()
#define PG8_SCHED __builtin_amdgcn_sched_barrier(0)
    Unit cur, nxt; int ui = 0;
    if (!S.next(0, cur)) return;
    f32x4 acc[2][2][4][2];
#pragma unroll
    for (int a = 0; a < 2; ++a)
#pragma unroll
        for (int b = 0; b < 2; ++b)
#pragma unroll
            for (int m = 0; m < 4; ++m)
#pragma unroll
                for (int n = 0; n < 2; ++n) acc[a][b][m][n] = (f32x4){0.f, 0.f, 0.f, 0.f};
    bf16x8 At[4][2], B0[2][2], B1[2][2];
    const char* cA = (const char*)g.A + (size_t)cur.pm * tstep; const char* cB = (const char*)g.Bt + (size_t)cur.pn * tstep;
    S.a_ready(cur);
    if constexpr (Epi::HAS_PRE) E.pre_first(cur, lds, tid);
    if constexpr (SP2) {
        PG8_STAGE(PG8_SB(0, 0), cB, voffB); PG8_STAGE(PG8_SB(0, 1), cB + hstep, voffB); PG8_STAGE(PG8_SA(0, 0), cA, voffA); PG8_STAGE(PG8_SA(0, 1), cA + hstep, voffA);
        if (wr == 1) PG8_BAR;
        PG8_WAIT_V(2); PG8_BAR;
        PG8_STAGE(PG8_SB(1, 0), cB + kstep, voffB); PG8_STAGE(PG8_SA(1, 0), cA + kstep, voffA); PG8_STAGE(PG8_SB(1, 1), cB + hstep + kstep, voffB);
        PG8_WAIT_V(6); PG8_BAR;
    } else {
        PG8_STAGE(PG8_SB(0, 0), cB, voffB); PG8_STAGE(PG8_SA(0, 0), cA, voffA); PG8_STAGE(PG8_SB(0, 1), cB + hstep, voffB); PG8_STAGE(PG8_SA(0, 1), cA + hstep, voffA);
        if (wr == 1) PG8_BAR;
        PG8_WAIT_V(4); PG8_BAR;
        PG8_STAGE(PG8_SB(1, 0), cB + kstep, voffB); PG8_STAGE(PG8_SA(1, 0), cA + kstep, voffA); PG8_STAGE(PG8_SB(1, 1), cB + hstep + kstep, voffB);
        PG8_WAIT_V(6); PG8_BAR;
    }
    for (;;) {
        const bool has_next = S.next(ui + 1, nxt);
        const char* nA = has_next ? (const char*)g.A + (size_t)nxt.pm * tstep : cA; const char* nB = has_next ? (const char*)g.Bt + (size_t)nxt.pn * tstep : cB;
        for (int t = 0; t < nt; t += 2) {
            const bool last = (t == nt - 2);
            const char* a1 = cA + (size_t)(t + 1) * kstep;
            const char* a2 = last ? nA : cA + (size_t)(t + 2) * kstep; const char* b2 = last ? nB : cB + (size_t)(t + 2) * kstep;
            const char* a3 = a2 + kstep; const char* b3 = b2 + kstep;
            if (last && has_next) S.a_ready(nxt);
            if constexpr (SP2) {
            PG8_LDB(B0, 0, 0); PG8_LDB(B1, 0, 1); PG8_SCHED; PG8_LDA(At, 0, 0); PG8_STAGE(PG8_SA(1, 1), a1 + hstep, voffA);
            PG8_WAIT_V(8); PG8_WAIT_L(0); PG8_BAR; PG8_MMA(0, 0, At, B0); PG8_MMA(0, 1, At, B1); PG8_BAR; PG8_SCHED;
            PG8_LDA(At, 0, 1); PG8_STAGE(PG8_SB(0, 0), b2, voffB); PG8_STAGE(PG8_SB(0, 1), b2 + hstep, voffB); PG8_STAGE(PG8_SA(0, 0), a2, voffA);
            PG8_WAIT_V(8); PG8_WAIT_L(0); PG8_BAR; PG8_MMA(1, 0, At, B0); PG8_MMA(1, 1, At, B1); PG8_BAR; PG8_SCHED;
            PG8_LDB(B0, 1, 0); PG8_LDB(B1, 1, 1); PG8_SCHED; PG8_LDA(At, 1, 0); PG8_STAGE(PG8_SA(0, 1), a2 + hstep, voffA);
            PG8_WAIT_V(8); PG8_WAIT_L(0); PG8_BAR; PG8_MMA(0, 0, At, B0); PG8_MMA(0, 1, At, B1); PG8_BAR; PG8_SCHED;
            PG8_LDA(At, 1, 1); PG8_STAGE(PG8_SB(1, 0), b3, voffB); PG8_STAGE(PG8_SB(1, 1), b3 + hstep, voffB); PG8_STAGE(PG8_SA(1, 0), a3, voffA);
            PG8_WAIT_V(8); PG8_WAIT_L(0); PG8_BAR; PG8_MMA(1, 0, At, B0); PG8_MMA(1, 1, At, B1); PG8_BAR; PG8_SCHED;
            } else {
            PG8_LDB(B0, 0, 0); PG8_SCHED; PG8_LDA(At, 0, 0); PG8_STAGE(PG8_SA(1, 1), a1 + hstep, voffA);
            PG8_WAIT_L(8); PG8_BAR; PG8_WAIT_L(0); PG8_MMA(0, 0, At, B0); PG8_BAR; PG8_SCHED;
            PG8_LDB(B1, 0, 1); PG8_STAGE(PG8_SB(0, 0), b2, voffB);
            PG8_BAR; PG8_WAIT_L(0); PG8_MMA(0, 1, At, B1); PG8_BAR;
            PG8_LDA(At, 0, 1); PG8_STAGE(PG8_SA(0, 0), a2, voffA);
            PG8_BAR; PG8_WAIT_L(0); PG8_MMA(1, 0, At, B0); PG8_BAR; PG8_SCHED;
            PG8_STAGE(PG8_SB(0, 1), b2 + hstep, voffB);
            PG8_WAIT_V(6); PG8_BAR; PG8_MMA(1, 1, At, B1); PG8_BAR;
            PG8_LDB(B0, 1, 0); PG8_SCHED; PG8_LDA(At, 1, 0); PG8_STAGE(PG8_SA(0, 1), a2 + hstep, voffA);
            PG8_WAIT_L(8); PG8_BAR; PG8_WAIT_L(0); PG8_MMA(0, 0, At, B0); PG8_BAR; PG8_SCHED;
            PG8_LDB(B1, 1, 1); PG8_STAGE(PG8_SB(1, 0), b3, voffB);
            PG8_BAR; PG8_WAIT_L(0); PG8_MMA(0, 1, At, B1); PG8_BAR;
            PG8_LDA(At, 1, 1); PG8_STAGE(PG8_SA(1, 0), a3, voffA);
            PG8_BAR; PG8_WAIT_L(0); PG8_MMA(1, 0, At, B0); PG8_BAR; PG8_SCHED;
            PG8_STAGE(PG8_SB(1, 1), b3 + hstep, voffB);
            PG8_WAIT_V(6); PG8_BAR; PG8_MMA(1, 1, At, B1); PG8_BAR;
            }
        }
        if constexpr (ALIGN_EPI) { if (wr == 0) PG8_BAR; }
        if constexpr (Epi::HAS_PRE) { E(acc, cur, nxt, has_next, ui & 1, lds, tid, wr, wc, fr, fq); S.done(cur); }
        else if constexpr (Epi::IS_FINAL) { E.fin(acc, cur, tid, wr, wc, fr, fq); S.done(cur); }
        else if constexpr (!Epi::AFTER_DRAIN) { E(acc, cur, wr, wc, fr, fq); S.done(cur); }
        if (!has_next) break;
#pragma unroll
        for (int a = 0; a < 2; ++a)
#pragma unroll
            for (int b = 0; b < 2; ++b)
#pragma unroll
                for (int m = 0; m < 4; ++m)
#pragma unroll
                    for (int n = 0; n < 2; ++n) acc[a][b][m][n] = (f32x4){0.f, 0.f, 0.f, 0.f};
        cur = nxt; cA = nA; cB = nB; ++ui;
        if constexpr (ALIGN_EPI) { if (wr == 1) PG8_BAR; }
    }
    PG8_WAIT_V(0);
    if constexpr (!ALIGN_EPI) { if (wr == 0) PG8_BAR; }
    PG8_BAR;
    if constexpr (Epi::AFTER_DRAIN) { E.fused(acc, cur, wr, wc, fr, fq, lds, wid, lane); S.done(cur); }
#undef PG8_SA
#undef PG8_SB
#undef PG8_STAGE
#undef PG8_LDA
#undef PG8_LDB
#undef PG8_MMA
#undef PG8_WAIT_V
#undef PG8_WAIT_L
#undef PG8_BAR
#undef PG8_SCHED
}
}
namespace attn_body {
using bf16=__hip_bfloat16;
using bf16x8=__attribute__((ext_vector_type(8)))short;
using s16x4=__attribute__((ext_vector_type(4)))short;
using f32x16=__attribute__((ext_vector_type(16)))float;
using u32x4=__attribute__((ext_vector_type(4)))unsigned;
constexpr int BATCH=2,NHEAD=16,SEQ=8192,D=64,DM=NHEAD*D;
constexpr int NW=8,QBLK=32,QB=QBLK*NW,KVBLK=64,NQB=SEQ/QB;
constexpr int ATTN_PITCH=DM, ATTN_UNIT_ROWS=QB;
__device__ __forceinline__ int crow(int r,int hi){return (r&3)+8*(r>>2)+4*hi;}
#define SBAR() __builtin_amdgcn_sched_barrier(0)
constexpr int NSLOT=3, SLOTB=8192;
constexpr int LDS_K=0, LDS_V=NSLOT*SLOTB, LDS_WS=2*NSLOT*SLOTB, LDS_OST=LDS_WS+NW*64*4, LDS_BYTES=LDS_OST+NW*4096;
constexpr float C2=0.125f*1.4426950408889634f;
__device__ __forceinline__ void glds16(const void*gsrc,unsigned lds_dst){unsigned keep;
  asm volatile("s_mov_b32 %0, m0\n\ts_mov_b32 m0, %2\n\ts_nop 0\n\tglobal_load_lds_dwordx4 %1, off\n\ts_mov_b32 m0, %0":"=&s"(keep):"v"(gsrc),"s"(lds_dst):"memory");}
__device__ __forceinline__ float max3f(float a,float b,float c){float r;asm("v_max3_f32 %0, %1, %2, %3":"=v"(r):"v"(a),"v"(b),"v"(c));return r;}
__device__ __forceinline__ float max2f(float a,float b){float r;asm("v_max_f32_e32 %0, %1, %2":"=v"(r):"v"(a),"v"(b));return r;}
__device__ __forceinline__ float fadd_s(float a,float b){float r;asm("v_add_f32_e32 %0, %1, %2":"=v"(r):"v"(a),"v"(b));return r;}
__device__ __forceinline__ float fsub_s(float a,float b){float r;asm("v_sub_f32_e32 %0, %1, %2":"=v"(r):"v"(a),"v"(b));return r;}
typedef float f32x2_t __attribute__((ext_vector_type(2))); typedef __bf16 bf16x2_t __attribute__((ext_vector_type(2)));
__device__ __forceinline__ unsigned cvtpk_s(float lo,float hi){f32x2_t v={lo,hi};bf16x2_t b=__builtin_convertvector(v,bf16x2_t);return __builtin_bit_cast(unsigned,b);}
#define WAIT_BAR(N) asm volatile("s_waitcnt vmcnt(" #N ") lgkmcnt(0)\n\ts_barrier":::"memory")

__device__ __forceinline__ void qkt(f32x16&p0,f32x16&p1,const char*Kslot,const bf16x8*qr,const f32x16&negm,int r32,int hi){
  const char*kb=Kslot+hi*1024+r32*16;
  #pragma unroll
  for(int d0=0;d0<4;++d0){
    const bf16x8 b0=*reinterpret_cast<const bf16x8*>(kb+d0*2048);
    const bf16x8 b1=*reinterpret_cast<const bf16x8*>(kb+d0*2048+512);
    if(d0==0){p0=__builtin_amdgcn_mfma_f32_32x32x16_bf16(b0,qr[0],negm,0,0,0);p1=__builtin_amdgcn_mfma_f32_32x32x16_bf16(b1,qr[0],negm,0,0,0);}
    else{p0=__builtin_amdgcn_mfma_f32_32x32x16_bf16(b0,qr[d0],p0,0,0,0);p1=__builtin_amdgcn_mfma_f32_32x32x16_bf16(b1,qr[d0],p1,0,0,0);}}
}
typedef __attribute__((address_space(3))) const char* lds_cptr;
typedef short v4i16_t __attribute__((ext_vector_type(4)));
__device__ __forceinline__ void kload8(bf16x8*kf,lds_cptr kp){
  kf[0]=*(const __attribute__((address_space(3))) bf16x8*)(kp);      kf[1]=*(const __attribute__((address_space(3))) bf16x8*)(kp+512);
  kf[2]=*(const __attribute__((address_space(3))) bf16x8*)(kp+2048); kf[3]=*(const __attribute__((address_space(3))) bf16x8*)(kp+2560);
  kf[4]=*(const __attribute__((address_space(3))) bf16x8*)(kp+4096); kf[5]=*(const __attribute__((address_space(3))) bf16x8*)(kp+4608);
  kf[6]=*(const __attribute__((address_space(3))) bf16x8*)(kp+6144); kf[7]=*(const __attribute__((address_space(3))) bf16x8*)(kp+6656);
}
__device__ __forceinline__ void kload2(bf16x8*kf,lds_cptr kp,int j){ kf[2*j]=*(const __attribute__((address_space(3))) bf16x8*)(kp+j*2048); kf[2*j+1]=*(const __attribute__((address_space(3))) bf16x8*)(kp+j*2048+512); }
__device__ __forceinline__ s16x4 vtr(lds_cptr p){ return __builtin_bit_cast(s16x4,__builtin_amdgcn_ds_read_tr16_b64_v4i16((__attribute__((address_space(3))) v4i16_t*)p)); }
__device__ __forceinline__ float rowmax(const f32x16&p0,const f32x16&p1){
  float a=max3f(p0[0],p0[1],p1[0]),b=max3f(p0[2],p0[3],p1[1]);a=max3f(a,p1[2],p1[3]);
  #pragma unroll
  for(int r=4;r<16;r+=4){a=max3f(a,p0[r],p0[r+1]);b=max3f(b,p0[r+2],p0[r+3]);a=max3f(a,p1[r],p1[r+1]);b=max3f(b,p1[r+2],p1[r+3]);}
  const float m=max2f(a,b);
  auto rr=__builtin_amdgcn_permlane32_swap(__float_as_uint(m),__float_as_uint(m),false,false);
  return max2f(__uint_as_float(rr[0]),__uint_as_float(rr[1]));
}
__device__ __forceinline__ void pv(f32x16*o,int vb,bf16x8 pa0,bf16x8 pa1,bf16x8 pa2,bf16x8 pa3){
  #pragma unroll
  for(int d0=0;d0<2;++d0){s16x4 lo[4],hi[4];
    #pragma unroll
    for(int ks=0;ks<4;++ks){
      asm volatile("ds_read_b64_tr_b16 %0,%1 offset:%c2":"=&v"(lo[ks]):"v"(vb),"i"(d0*4096+ks*1024):"memory");
      asm volatile("ds_read_b64_tr_b16 %0,%1 offset:%c2":"=&v"(hi[ks]):"v"(vb),"i"(d0*4096+ks*1024+512):"memory");}
    asm volatile("s_waitcnt lgkmcnt(0)":::"memory");SBAR();
    #define PK(k) (bf16x8){lo[k][0],lo[k][1],lo[k][2],lo[k][3],hi[k][0],hi[k][1],hi[k][2],hi[k][3]}
    o[d0]=__builtin_amdgcn_mfma_f32_32x32x16_bf16(pa0,PK(0),o[d0],0,0,0);
    o[d0]=__builtin_amdgcn_mfma_f32_32x32x16_bf16(pa1,PK(1),o[d0],0,0,0);
    o[d0]=__builtin_amdgcn_mfma_f32_32x32x16_bf16(pa2,PK(2),o[d0],0,0,0);
    o[d0]=__builtin_amdgcn_mfma_f32_32x32x16_bf16(pa3,PK(3),o[d0],0,0,0);
    #undef PK
  }
}
constexpr int NA_DR=656, NA_TAB=15*NA_DR;
constexpr int LDS_BIAS=LDS_BYTES+1024, ATTN_LDS_TOTAL=LDS_BIAS+NA_TAB*4+2048;
constexpr int OPITCH=1024;
typedef __attribute__((address_space(3))) float* lds_fptr;
template<int MODE> __device__ __forceinline__ void amask(f32x16&p0,f32x16&p1,const int kt,const int qpos,const int hi,lds_fptr bias,const int tb0,const int tb1,const int qrow){
  if(MODE==1){
    const int kb=kt*64+4*hi, lo=qpos-128, hq=qpos+128;
    #pragma unroll
    for(int r=0;r<16;++r){const int kv=kb+(r&3)+8*(r>>2); if(kv<lo||kv>hq)p0[r]=-INFINITY; if(kv+32<lo||kv+32>hq)p1[r]=-INFINITY;}
  }
  if(MODE==2){
    const int rs=min(max(qrow-4,0),248);
    if(kt<rs||kt>=rs+8){
      #pragma unroll
      for(int r=0;r<16;++r){p0[r]=-INFINITY;p1[r]=-INFINITY;}
    } else {
      const int dr=kt-qrow+7; lds_fptr b0=bias+dr*NA_DR+tb0, b1=bias+dr*NA_DR+tb1;
      #pragma unroll
      for(int r=0;r<16;++r){const int o=(r&3)+8*(r>>2); p0[r]+=b0[o]; p1[r]+=b1[o];}
    }
  }
}
#define ATTN_STORE16(base,byteoff,v) __builtin_amdgcn_raw_buffer_store_b128((v), __builtin_amdgcn_make_buffer_rsrc((void*)(base), 0, 0x7fffffff, 0x00020000), (int)(byteoff), 0, 16)
template<int MODE,int THRL> __device__ __forceinline__ void attn_unit(const bf16*Qh,const bf16*__restrict__ Kh,const bf16*__restrict__ Vh,bf16*Oh,const int DM,const int q0,const int tile0,const int NT,const float sink_l2,const float*biasg,const bool build,const bool pre,const bool preV,const bf16*nKh,const bf16*nVh,const int ntile0,char*shm){
  int tid=threadIdx.x; asm volatile("":"+v"(tid)); const int lane=tid&63,r32=lane&31,hi=lane>>5; const int wid=__builtin_amdgcn_readfirstlane(tid>>6);
  const bf16*Qw=Qh+(long)(q0+wid*QBLK)*DM;
  const unsigned lds0=(unsigned)(uintptr_t)shm;
  float*wsf=(float*)(shm+LDS_WS)+wid*64;
  const bf16*ksrc=Kh+(long)(tile0*KVBLK+lane)*DM+wid*8;
  const bf16*vsrc=Vh+(long)(tile0*KVBLK+16*(wid&3)+(lane>>2))*DM+(wid>>2)*32+(lane&3)*8;
  const unsigned kdst=lds0+LDS_K+wid*1024, vdst=lds0+LDS_V+wid*1024;
  #define DMA_K(t,slot) glds16(ksrc+(long)(t)*KVBLK*DM,(unsigned)__builtin_amdgcn_readfirstlane(kdst+(slot)))
  #define DMA_V(t,slot) glds16(vsrc+(long)(t)*KVBLK*DM,(unsigned)__builtin_amdgcn_readfirstlane(vdst+(slot)))
  const int vb0=(int)(lds0+LDS_V)+((lane>>4)&1)*32+(lane&3)*8+(4*hi+((lane&15)>>2))*64;
  const char*Kbase=shm+LDS_K; bf16x8 kf[8];
  const lds_cptr shm3=(lds_cptr)shm; const lds_cptr kp0=shm3+LDS_K+hi*1024+r32*16; const lds_cptr vp0=shm3+LDS_V+((lane>>4)&1)*32+(lane&3)*8+(4*hi+((lane&15)>>2))*64;
  lds_fptr biasl=(lds_fptr)((lds_cptr)shm+LDS_BIAS);
  if(MODE==2&&build){
    lds_fptr stg=biasl+NA_TAB; if(tid<465) stg[tid]=biasg[tid]*1.4426950408889634f;
    asm volatile("s_waitcnt vmcnt(0) lgkmcnt(0)\n\ts_barrier":::"memory");
    for(int e=tid;e<NA_TAB;e+=512){ const int dr=e/NA_DR, w=e-dr*NA_DR; int idx=-1;
      if(w<112){ if(w>=48&&w<64) idx=w-41; } else if(w<144){ } else if(w<400){ const int q=(w-144)>>5, kc=(w-144)&31; if(kc<16) idx=kc-q+15; } else { const int q=(w-400)>>5, j=(w-400)&31; if(j>=16) idx=j-q-9; }
      biasl[e]=(idx>=0)?stg[dr*31+idx]:-INFINITY; } }
  if(!pre){DMA_K(0,0);} if(!preV){DMA_V(0,0);} if(!pre){DMA_K(1,SLOTB);}
  bf16x8 qr[4];
  #pragma unroll
  for(int d0=0;d0<4;++d0)qr[d0]=*reinterpret_cast<const bf16x8*>(&Qw[(long)r32*DM+d0*16+hi*8]);
  float mhat=0.f,l_reg=0.f;f32x16 o[2];o[0]=f32x16{};o[1]=f32x16{};f32x16 negm=f32x16{};asm volatile("":"+v"(negm));
  const int qpos=q0+wid*QBLK+r32; const int qrow=(q0>>6)+(wid>>1);
  int tb0=0,tb1=0; if(MODE==2){ const int qc=qpos&63; if(qc<8){tb0=144+qc*32;tb1=112;} else if(qc>=56){tb0=112;tb1=400+(qc-56)*32;} else {tb0=56-qc;tb1=tb0+32;} tb0+=4*hi;tb1+=4*hi; }
  #define CMASK(P0,P1,t) amask<MODE>(P0,P1,tile0+(t),qpos,hi,biasl,tb0,tb1,qrow)
  bool resc=false;
  #define START(P0,P1) do{ const float rm=rowmax(P0,P1); resc=false; \
    { const float dl=(MODE==0)?rm:__builtin_fmaxf(rm,-64.f); mhat=fadd_s(mhat,dl); \
      _Pragma("unroll") for(int r=0;r<16;++r){P0[r]=fsub_s(P0[r],dl);P1[r]=fsub_s(P1[r],dl);} \
      _Pragma("unroll") for(int r=0;r<16;++r)negm[r]=-mhat; asm volatile("":"+v"(negm)); } \
    _Pragma("unroll") for(int r=0;r<16;++r)P0[r]=__builtin_amdgcn_exp2f(P0[r]); }while(0)
  #define RESC() do{ if(resc){ asm volatile("s_waitcnt lgkmcnt(0)":::"memory"); \
      _Pragma("unroll") for(int d_=0;d_<2;++d_) _Pragma("unroll") for(int r=0;r<16;++r)o[d_][r]*=wsf[crow(r,hi)]; } }while(0)
  f32x16 pA0,pA1,pB0,pB1;
  int sl_prev=0,sl_cur=0,sl_next=SLOTB;
  #define ROT() do{sl_prev=sl_cur;sl_cur=sl_next;sl_next=(sl_next==(NSLOT-1)*SLOTB)?0:sl_next+SLOTB;}while(0)
  DMA_K(2,2*SLOTB);
  WAIT_BAR(3);
  qkt(pA0,pA1,Kbase,qr,negm,r32,hi);asm volatile("s_nop 15\n\ts_nop 7":"+v"(pA0),"+v"(pA1));CMASK(pA0,pA1,0);
  START(pA0,pA1);
  _Pragma("unroll") for(int r=0;r<16;++r)pA1[r]=__builtin_amdgcn_exp2f(pA1[r]);
  WAIT_BAR(0);
  DMA_K(3,0);DMA_V(1,SLOTB);
  ROT();
  kload8(kf,kp0+sl_cur);
  WAIT_BAR(2);
  s16x4 vlo[8],vhi[8]; u32x4 pw0,pw1,pw2,pw3;
  #define PKW(P,B) cvtpk_s(P[B],P[B+1])
  #define PAF(k) __builtin_bit_cast(bf16x8,pw##k)
  #define VFR(i) (bf16x8){vlo[i][0],vlo[i][1],vlo[i][2],vlo[i][3],vhi[i][0],vhi[i][1],vhi[i][2],vhi[i][3]}
  #define PIN(x) asm volatile("":"+v"(x))
  #define MX3(a,b,c) __builtin_fmaxf(__builtin_fmaxf((a),(b)),(c))
  #define GAPA(MF,A0,A1,A2,A3,W0,W1,PW) do{ MF; sacc+=A0; sacc+=A1; sacc+=A2; sacc+=A3; PIN(sacc); W0; W1; PIN(PW); SBAR(); }while(0)
  #define EX(v) __builtin_amdgcn_exp2f(v)
  #define GAPB(MF,X,B) do{ MF; X[B]=EX(X[B]); X[B+1]=EX(X[B+1]); X[B+2]=EX(X[B+2]); X[B+3]=EX(X[B+3]); PIN(X); SBAR(); }while(0)
  #define VRD(i) do{ vlo[i]=vtr(vp_+(((i)>>2)*4096+((i)&3)*1024)); vhi[i]=vtr(vp_+(((i)>>2)*4096+((i)&3)*1024+512)); }while(0)
  #define KRD(G,j) do{ if(G){ kload2(kf,kp0+sl_next,j); SBAR(); } }while(0)
  #define STEP(C0,C1,P0,P1,t,GK,GV,GL) do{ SBAR(); \
    const lds_cptr vp_=vp0+sl_prev; \
    VRD(0); SBAR(); float sacc=(P0[0]+P0[1]); \
    GAPA(C0=__builtin_amdgcn_mfma_f32_32x32x16_bf16(kf[0],qr[0],negm,0,0,0), P0[2],P0[3],P0[4],P0[5],     pw0[0]=PKW(P0,0), pw0[1]=PKW(P0,2), pw0); \
    VRD(4); SBAR(); GAPA(C1=__builtin_amdgcn_mfma_f32_32x32x16_bf16(kf[1],qr[0],negm,0,0,0), P0[6],P0[7],P0[8],P0[9],     pw0[2]=PKW(P0,4), pw0[3]=PKW(P0,6), pw0); \
    VRD(1); SBAR(); GAPA(C0=__builtin_amdgcn_mfma_f32_32x32x16_bf16(kf[2],qr[1],C0,0,0,0),   P0[10],P0[11],P0[12],P0[13], pw1[0]=PKW(P0,8), pw1[1]=PKW(P0,10), pw1); \
    VRD(5); SBAR(); GAPA(C1=__builtin_amdgcn_mfma_f32_32x32x16_bf16(kf[3],qr[1],C1,0,0,0),   P0[14],P0[15],P1[0],P1[1],   pw1[2]=PKW(P0,12),pw1[3]=PKW(P0,14), pw1); \
    VRD(2); SBAR(); GAPA(C0=__builtin_amdgcn_mfma_f32_32x32x16_bf16(kf[4],qr[2],C0,0,0,0),   P1[2],P1[3],P1[4],P1[5],     pw2[0]=PKW(P1,0), pw2[1]=PKW(P1,2), pw2); \
    VRD(6); SBAR(); GAPA(C1=__builtin_amdgcn_mfma_f32_32x32x16_bf16(kf[5],qr[2],C1,0,0,0),   P1[6],P1[7],P1[8],P1[9],     pw2[2]=PKW(P1,4), pw2[3]=PKW(P1,6), pw2); \
    VRD(3); SBAR(); GAPA(C0=__builtin_amdgcn_mfma_f32_32x32x16_bf16(kf[6],qr[3],C0,0,0,0),   P1[10],P1[11],P1[12],P1[13], pw3[0]=PKW(P1,8), pw3[1]=PKW(P1,10), pw3); \
    VRD(7); SBAR(); GAPA(C1=__builtin_amdgcn_mfma_f32_32x32x16_bf16(kf[7],qr[3],C1,0,0,0),   P1[14],P1[15],0.f,0.f,       pw3[2]=PKW(P1,12),pw3[3]=PKW(P1,14), pw3); \
    l_reg+=sacc; \
    if(GK){DMA_K((t)+3,sl_cur);} if(GV){DMA_V((t)+1,sl_next);} \
    CMASK(C0,C1,t); \
    { float a=MX3(C0[0],C0[1],C1[0]),b=MX3(C0[2],C0[3],C1[1]); a=MX3(a,C1[2],C1[3]); \
      _Pragma("unroll") for(int r=4;r<16;r+=4){a=MX3(a,C0[r],C0[r+1]);b=MX3(b,C0[r+2],C0[r+3]);a=MX3(a,C1[r],C1[r+1]);b=MX3(b,C1[r+2],C1[r+3]);} \
      float rm=__builtin_fmaxf(a,b); { auto rr=__builtin_amdgcn_permlane32_swap(__float_as_uint(rm),__float_as_uint(rm),false,false); rm=__builtin_fmaxf(__uint_as_float(rr[0]),__uint_as_float(rr[1])); } \
      resc=false; \
      if(__builtin_expect(__any(rm>(float)THRL),0)){ const float dl=__builtin_fmaxf(rm,0.f); mhat+=dl; \
        _Pragma("unroll") for(int r=0;r<16;++r){C0[r]-=dl;C1[r]-=dl;} \
        _Pragma("unroll") for(int r=0;r<16;++r)negm[r]=-mhat; asm volatile("":"+v"(negm)); \
        const float f=__builtin_amdgcn_exp2f(-dl); l_reg*=f; if(hi==0)wsf[r32]=f; resc=true; } } \
    SBAR(); \
    GAPB(o[0]=__builtin_amdgcn_mfma_f32_32x32x16_bf16(PAF(0),VFR(0),o[0],0,0,0), C0,0); \
    GAPB(o[1]=__builtin_amdgcn_mfma_f32_32x32x16_bf16(PAF(0),VFR(4),o[1],0,0,0), C0,4); \
    KRD(GL,0); GAPB(o[0]=__builtin_amdgcn_mfma_f32_32x32x16_bf16(PAF(1),VFR(1),o[0],0,0,0), C0,8); \
    KRD(GL,1); GAPB(o[1]=__builtin_amdgcn_mfma_f32_32x32x16_bf16(PAF(1),VFR(5),o[1],0,0,0), C0,12); \
    KRD(GL,2); GAPB(o[0]=__builtin_amdgcn_mfma_f32_32x32x16_bf16(PAF(2),VFR(2),o[0],0,0,0), C1,0); \
    KRD(GL,3); GAPB(o[1]=__builtin_amdgcn_mfma_f32_32x32x16_bf16(PAF(2),VFR(6),o[1],0,0,0), C1,4); \
    GAPB(o[0]=__builtin_amdgcn_mfma_f32_32x32x16_bf16(PAF(3),VFR(3),o[0],0,0,0), C1,8); \
    GAPB(o[1]=__builtin_amdgcn_mfma_f32_32x32x16_bf16(PAF(3),VFR(7),o[1],0,0,0), C1,12); \
    }while(0)
  int t=1;
  for(;t+5<NT;t+=2){
    STEP(pB0,pB1,pA0,pA1,t,true,true,true);     WAIT_BAR(2); RESC(); ROT();
    STEP(pA0,pA1,pB0,pB1,t+1,true,true,true);   WAIT_BAR(2); RESC(); ROT();
  }
  #define ENDW(tt) do{ if((tt)+3<NT){WAIT_BAR(2);} else if((tt)+2<NT){WAIT_BAR(1);} else {WAIT_BAR(0);} }while(0)
  for(;t+1<NT;t+=2){
    STEP(pB0,pB1,pA0,pA1,t,(t+3<NT),(t+1<NT),(t+1<NT));       ENDW(t);   RESC(); ROT();
    STEP(pA0,pA1,pB0,pB1,t+1,(t+4<NT),(t+2<NT),(t+2<NT));     ENDW(t+1); RESC(); ROT();
  }
  if(nKh){
    const bf16*nks=nKh+(long)(ntile0*KVBLK+lane)*DM+wid*8;
    glds16(nks,(unsigned)__builtin_amdgcn_readfirstlane(kdst));
    if(NT%3==0){ const bf16*nvs=nVh+(long)(ntile0*KVBLK+16*(wid&3)+(lane>>2))*DM+(wid>>2)*32+(lane&3)*8; glds16(nvs,(unsigned)__builtin_amdgcn_readfirstlane(vdst)); }
    glds16(nks+(long)KVBLK*DM,(unsigned)__builtin_amdgcn_readfirstlane(kdst+SLOTB)); }
  STEP(pB0,pB1,pA0,pA1,NT-1,false,false,false); RESC();
  { float sacc=pB0[0]+pB0[1]; _Pragma("unroll") for(int r=2;r<16;++r)sacc+=pB0[r]; _Pragma("unroll") for(int r=0;r<16;++r)sacc+=pB1[r]; l_reg+=sacc;
    pw0=(u32x4){PKW(pB0,0),PKW(pB0,2),PKW(pB0,4),PKW(pB0,6)};pw1=(u32x4){PKW(pB0,8),PKW(pB0,10),PKW(pB0,12),PKW(pB0,14)};pw2=(u32x4){PKW(pB1,0),PKW(pB1,2),PKW(pB1,4),PKW(pB1,6)};pw3=(u32x4){PKW(pB1,8),PKW(pB1,10),PKW(pB1,12),PKW(pB1,14)};
    SBAR(); pv(o,vb0+sl_cur,PAF(0),PAF(1),PAF(2),PAF(3)); }
  #undef PKW
  #undef PAF
  #undef VFR
  #undef PIN
  #undef MX3
  #undef GAPA
  #undef GAPB
  #undef EX
  #undef VRD
  #undef KRD
  #undef STEP
  #undef ENDW
  {auto rr=__builtin_amdgcn_permlane32_swap(__float_as_uint(l_reg),__float_as_uint(l_reg),false,false);l_reg=__uint_as_float(rr[0])+__uint_as_float(rr[1]);}
  if(MODE==1) l_reg+=__builtin_amdgcn_exp2f(sink_l2-mhat);
  if(hi==0)wsf[32+r32]=l_reg;asm volatile("s_waitcnt lgkmcnt(0)":::"memory");
  float rli[16];
  #pragma unroll
  for(int r=0;r<16;++r)rli[r]=__builtin_amdgcn_rcpf(wsf[32+crow(r,hi)]);
  bf16*Ow=Oh+(long)(q0+wid*QBLK)*OPITCH;
  { bf16*stg=(bf16*)(shm+LDS_OST)+wid*2048;
    #pragma unroll
    for(int r=0;r<16;++r){const int orow=crow(r,hi);
      #pragma unroll
      for(int d0=0;d0<2;++d0)stg[orow*64+d0*32+r32]=__float2bfloat16(o[d0][r]*rli[r]);}
    asm volatile("s_waitcnt lgkmcnt(0)":::"memory");
    #pragma unroll
    for(int i=0;i<4;++i){const int row=i*8+(lane>>3),ch=lane&7; const u32x4 v=*(const u32x4*)(stg+row*64+ch*8); ATTN_STORE16(Oh,(unsigned)(((q0+wid*QBLK+row)*OPITCH+ch*8)*2),v);} }
  asm volatile("s_waitcnt lgkmcnt(0)\n\ts_barrier":::"memory");
  #undef DMA_K
  #undef DMA_V
  #undef CMASK
  #undef START
  #undef RESC
  #undef ROT
}
#undef SBAR
#undef WAIT_BAR
}
#define GAS __attribute__((address_space(1)))
#define LAS __attribute__((address_space(3)))
typedef unsigned short bf16;
typedef unsigned v4u __attribute__((ext_vector_type(4)));
typedef float f32x4 __attribute__((ext_vector_type(4)));
constexpr int NWAVES = 8;
#ifndef REP_P0
#define REP_P0 1
#endif
#ifndef REP_ATT_E
#define REP_ATT_E 1
#endif
#ifndef REP_ATT_O
#define REP_ATT_O 1
#endif
#ifndef REP_GU
#define REP_GU 1
#endif
#ifndef REP_PROJ
#define REP_PROJ 1
#endif
constexpr int LDS_BYTES = 135168;
static_assert(attn_body::ATTN_LDS_TOTAL <= 131072, "attention LDS inside the ring");

constexpr size_t SZ_WGU = (size_t)NGU * DMODEL * 2, SZ_WD = (size_t)DMODEL * DFF * 2;
constexpr size_t WS_WGU = 0;
constexpr size_t WS_WD = WS_WGU + 4 * SZ_WGU;
constexpr size_t WS_WIN = WS_WD + 4 * SZ_WD;
constexpr size_t WS_WOE = WS_WIN + (size_t)1536 * 1024 * 2;
constexpr size_t WS_WQKV = WS_WOE + (size_t)1024 * 1024 * 2;
constexpr size_t WS_WOO = WS_WQKV + (size_t)3072 * 1024 * 2;
constexpr size_t WS_XB = WS_WOO + (size_t)1024 * 1024 * 2;
constexpr size_t WS_PART = WS_XB + (size_t)SEQ * DMODEL * 2;
constexpr size_t WS_U = WS_PART + (size_t)SEQ * 16 * 4;
constexpr size_t WS_PROJ = WS_U, WS_O = WS_U + (size_t)SEQ * 3072 * 2, WS_END = WS_O + (size_t)SEQ * 1024 * 2;
static_assert(WS_END <= 268435456 && WS_U % 256 == 0, "d_ws map");

struct Args { const float* in[19]; float* out; unsigned char* ws; };
typedef unsigned long long u64;
__device__ __forceinline__ u64 ldptr(LAS u64* PT, int i) { const u64 v = PT[i]; const unsigned lo = __builtin_amdgcn_readfirstlane((unsigned)v), hi = __builtin_amdgcn_readfirstlane((unsigned)(v >> 32)); return ((u64)hi << 32) | lo; }

__device__ __forceinline__ unsigned f2bf(float f) { unsigned u = __builtin_bit_cast(unsigned, f); return (u + 0x7fffu + ((u >> 16) & 1u)) >> 16; }
__device__ __forceinline__ unsigned pk2(float lo, float hi) { return f2bf(lo) | (f2bf(hi) << 16); }
__device__ __forceinline__ float bf2f(unsigned short b) { return __builtin_bit_cast(float, (unsigned)b << 16); }
#define LDS_WAIT() asm volatile("s_waitcnt lgkmcnt(0)" ::: "memory")
__device__ __forceinline__ float wave_sum(float v) {
#pragma unroll
    for (int o = 1; o < 64; o <<= 1) v += __shfl_xor(v, o);
    return v;
}
__device__ __forceinline__ void transpose_item(const float* W, int K, int N, bf16* WT, const float* gain, int mode, LAS float* scr, int item, int lane) {
    const int nblk = N / 32, kb = item / nblk, nb = item % nblk, k0 = 64 * kb, n0 = 32 * nb;
    {
        const int kk8 = lane >> 3, seg = lane & 7;
        f32x4 w[8]; float gk[8];
#pragma unroll
        for (int i = 0; i < 8; ++i) { w[i] = __builtin_nontemporal_load((const GAS f32x4*)(W + (size_t)(k0 + 8 * i + kk8) * N + n0 + 4 * seg)); gk[i] = gain ? gain[k0 + 8 * i + kk8] : 1.f; }
#pragma unroll
        for (int i = 0; i < 8; ++i) { LAS float* d = scr + (8 * i + kk8) * 33 + 4 * seg; const f32x4 v = w[i] * gk[i]; d[0] = v.x; d[1] = v.y; d[2] = v.z; d[3] = v.w; }
    }
    LDS_WAIT(); asm volatile("" ::: "memory");
    const int d0 = (mode == 0) ? n0 : (mode == 3) ? ((n0 & ~255) + 128 * ((n0 >> 5) & 1) + 32 * ((n0 & 255) >> 6)) : ((n0 >> 7) * 256 + (n0 & 127) + (mode == 2 ? 128 : 0));
    const auto wrs = __builtin_amdgcn_make_buffer_rsrc((void*)WT, 0, 0x7fffffff, 0x00020000);
    const int c = lane & 7;
#pragma unroll
    for (int j = 0; j < 4; ++j) { const int n = (lane >> 3) + 8 * j; const LAS float* s = scr + (8 * c) * 33 + n;
        v4u o; o.x = pk2(s[0 * 33], s[1 * 33]); o.y = pk2(s[2 * 33], s[3 * 33]); o.z = pk2(s[4 * 33], s[5 * 33]); o.w = pk2(s[6 * 33], s[7 * 33]);
        __builtin_amdgcn_raw_buffer_store_b128(o, wrs, (int)((((unsigned)(d0 + n)) * (unsigned)K + k0 + 8 * c) * 2u), 0, 16); }
    LDS_WAIT(); asm volatile("" ::: "memory");
}

__device__ __forceinline__ void cs_of(float ang, float& c, float& s) {
    double t = (double)ang * 0.15915494309189535; t -= __builtin_rint(t); const float r = (float)t;
    c = __builtin_amdgcn_cosf(r); s = __builtin_amdgcn_sinf(r);
}

#define P_IN(i) ((const float*)(const GAS float*)ldptr(PT, (i)))
#define P_WSB(off) ((bf16*)(GAS bf16*)(ldptr(PT, 20) + (off)))
__device__ __forceinline__ void conv_weights(LAS u64* PT, LAS unsigned char* ldsl, const unsigned mask, const int worker, const int nworkers, const int wave, const int lane) {
    LAS float* scr = (LAS float*)(ldsl + wave * 16384);
    bf16* WGU = P_WSB(WS_WGU); bf16* WD = P_WSB(WS_WD);
    constexpr int I_G = 16 * 88, I_D = 44 * 32, I_IN = 16 * 48, I_O = 16 * 32, I_QKV = 16 * 96;
    for (int it = worker; ; it += nworkers) {
        int r = it;
#define CONV_ENTRY(bit, cnt, call) if (mask & (1u << (bit))) { if (r < (cnt)) { call; continue; } r -= (cnt); }
#define FFN_ITEMS(f_, L_, GI, WG, WU, WDN) { const size_t wo = (size_t)(L_) * DMODEL * DFF; \
            CONV_ENTRY(3 * (f_) + 0, I_G, transpose_item(P_IN(WG) + wo, DMODEL, DFF, WGU + (size_t)(f_) * NGU * DMODEL, P_IN(GI) + (L_) * DMODEL, 1, scr, r, lane)) \
            CONV_ENTRY(3 * (f_) + 1, I_G, transpose_item(P_IN(WU) + wo, DMODEL, DFF, WGU + (size_t)(f_) * NGU * DMODEL, P_IN(GI) + (L_) * DMODEL, 2, scr, r, lane)) \
            CONV_ENTRY(3 * (f_) + 2, I_D, transpose_item(P_IN(WDN) + wo, DFF, DMODEL, WD + (size_t)(f_) * DMODEL * DFF, nullptr, 0, scr, r, lane)) }
        FFN_ITEMS(0, 0, 1, 2, 3, 4)
        FFN_ITEMS(1, 0, 6, 7, 8, 9)
        FFN_ITEMS(2, 1, 1, 2, 3, 4)
        FFN_ITEMS(3, 1, 6, 7, 8, 9)
#undef FFN_ITEMS
        CONV_ENTRY(12, I_IN, transpose_item(P_IN(10), DMODEL, 1536, P_WSB(WS_WIN), P_IN(5), 3, scr, r, lane))
        CONV_ENTRY(13, I_O, transpose_item(P_IN(14), DMODEL, DMODEL, P_WSB(WS_WOE), nullptr, 0, scr, r, lane))
        CONV_ENTRY(14, I_QKV, transpose_item(P_IN(15), DMODEL, 3072, P_WSB(WS_WQKV), P_IN(5) + DMODEL, 0, scr, r, lane))
        CONV_ENTRY(15, I_O, transpose_item(P_IN(17), DMODEL, DMODEL, P_WSB(WS_WOO), nullptr, 0, scr, r, lane))
#undef CONV_ENTRY
        break;
    }
}
#undef P_IN
#undef P_WSB
__device__ __forceinline__ void conv_in_tail(LAS u64* PT, LAS unsigned char* ldsl, const unsigned mask, const int nwg, const int G, const int bx, const int wave, const int lane) {
    const int rem = nwg % G, first = rem;
    if (bx >= first) conv_weights(PT, ldsl, mask, (bx - first) * NWAVES + wave, (G - first) * NWAVES, wave, lane);
}
#define RLX_AGENT __ATOMIC_RELAXED, __HIP_MEMORY_SCOPE_AGENT
#define XB_TMO      128
#define XB_XCNT(j)  (256  + 64 * (j))
#define XB_XSUB(j)  (1280 + 64 * (j))
#define XB_XGEN(j)  (2304 + 64 * (j))
#define XB_TOP      3328
#define XB_TOPGEN   3392
#define XCD_BAR_WORDS 3456
#define XB_SPIN_CAP (1u << 18)

__device__ __forceinline__ unsigned xb_ld(unsigned* p)              { return __hip_atomic_load(p, __ATOMIC_RELAXED, __HIP_MEMORY_SCOPE_AGENT); }
__device__ __forceinline__ unsigned xb_add(unsigned* p, unsigned v) { return __hip_atomic_fetch_add(p, v, __ATOMIC_RELAXED, __HIP_MEMORY_SCOPE_AGENT); }
__device__ __forceinline__ unsigned xb_xcc_id() { return (unsigned)__builtin_amdgcn_s_getreg((3 << 11) | 20) & 0xFu; }
#define XB_SPIN(cond, bar) do { unsigned _sp = 0; while (cond) { __builtin_amdgcn_s_sleep(1); \
    if ((++_sp & 255u) == 0u) { if (xb_ld(&(bar)[XB_TMO])) break; if (_sp > XB_SPIN_CAP) { atomicAdd(&(bar)[XB_TMO], 1u); break; } } } } while (0)

struct XcdBarrier {
    unsigned* bar; unsigned x;
    volatile LAS unsigned* st;
};

__device__ __forceinline__ XcdBarrier xcd_barrier_post(unsigned* bar, volatile LAS unsigned* st) {
    XcdBarrier b; b.bar = bar; b.x = xb_xcc_id(); b.st = st;
    if (threadIdx.x == 0) (void)xb_add(&bar[XB_XCNT(b.x)], 1u);
    return b;
}
__device__ __forceinline__ void xcd_barrier_complete(unsigned* bar, unsigned x, unsigned& nloc, unsigned& nx) {
    const unsigned G = gridDim.x * gridDim.y * gridDim.z;
    unsigned sum, cnt, mine, sp = 0u;
    for (;;) {
        sum = 0u; cnt = 0u; mine = 0u;
#pragma unroll
        for (unsigned j = 0; j < 16; ++j) { const unsigned c = xb_ld(&bar[XB_XCNT(j)]); sum += c; cnt += (c > 0u) ? 1u : 0u; mine = (j == x) ? c : mine; }
        if (sum == G) break;
        __builtin_amdgcn_s_sleep(1);
        if ((++sp & 255u) == 0u) { if (xb_ld(&bar[XB_TMO])) break; if (sp > XB_SPIN_CAP) { atomicAdd(&bar[XB_TMO], 1u); break; } }
    }
    nloc = mine > 0u ? mine : 1u; nx = cnt > 0u ? cnt : 1u;
}

__device__ __forceinline__ void xcd_barrier(const XcdBarrier& b) {
    asm volatile("s_waitcnt vmcnt(0)" ::: "memory");
    __syncthreads();
    if (threadIdx.x == 0) {
        unsigned* bar = b.bar;
        __builtin_amdgcn_s_waitcnt(0);
        unsigned nloc = b.st[0], nx = b.st[1];
        if (nloc == 0u) { xcd_barrier_complete(bar, b.x, nloc, nx); b.st[0] = nloc; b.st[1] = nx; }
        const unsigned old = xb_add(&bar[XB_XSUB(b.x)], 1u);
        const unsigned gen = old / nloc;
        if (old + 1u == (gen + 1u) * nloc) {
            __builtin_amdgcn_fence(__ATOMIC_RELEASE, "agent");
            asm volatile("s_waitcnt vmcnt(0)" ::: "memory");
            const unsigned og = xb_add(&bar[XB_TOP], 1u);
            const unsigned tg = og / nx;
            if (og + 1u == (tg + 1u) * nx) xb_add(&bar[XB_TOPGEN], 1u);
            else XB_SPIN(xb_ld(&bar[XB_TOPGEN]) == tg, bar);
            __builtin_amdgcn_fence(__ATOMIC_ACQUIRE, "agent");
            xb_add(&bar[XB_XGEN(b.x)], 1u);
            asm volatile("s_waitcnt vmcnt(0)" ::: "memory");
        } else {
            XB_SPIN(xb_ld(&bar[XB_XGEN(b.x)]) == gen, bar);
            __builtin_amdgcn_fence(__ATOMIC_ACQUIRE, "agent");
            asm volatile("s_waitcnt vmcnt(0)" ::: "memory");
        }
    }
    __syncthreads();
}

constexpr size_t WS_ROPE = WS_PART + 768 * 1024;
constexpr size_t WS_BAR = WS_PART + 512 * 1024;
__global__ void __launch_bounds__(NWAVES * 64, 2) fwd_megakernel(Args args) {
    extern __shared__ __attribute__((aligned(16))) unsigned char lds[];
    LAS unsigned char* ldsl = (LAS unsigned char*)lds;
#define FRESH() int tid = threadIdx.x; asm volatile("" : "+v"(tid)); int G = gridDim.x, bx = blockIdx.x; asm volatile("" : "+s"(G), "+s"(bx)); \
    const int lane = tid & 63, wave = __builtin_amdgcn_readfirstlane(tid >> 6); const int gw = bx * NWAVES + wave, NGW = G * NWAVES; (void)lane; (void)gw; (void)NGW;
    LAS u64* PT = (LAS u64*)(ldsl + 131072);
    if (threadIdx.x == 0) {
#pragma unroll
        for (int i = 0; i < 19; ++i) PT[i] = (u64)args.in[i];
        PT[19] = (u64)args.out; PT[20] = (u64)args.ws;
        ((volatile LAS unsigned*)(ldsl + 131072 + 256))[0] = 0u; ((volatile LAS unsigned*)(ldsl + 131072 + 256))[1] = 0u;
    }
    __syncthreads();
    { XcdBarrier b0 = xcd_barrier_post((unsigned*)(GAS unsigned*)((u64)args.ws + WS_BAR), (volatile LAS unsigned*)(ldsl + 131072 + 256)); (void)b0; }
#define GRID_BAR() do { XcdBarrier b_; b_.bar = (unsigned*)(GAS unsigned*)(ldptr(PT, 20) + WS_BAR); b_.x = xb_xcc_id(); b_.st = (volatile LAS unsigned*)(ldsl + 131072 + 256); xcd_barrier(b_); } while (0)
    int par = 0;
#define P_IN(i) ((const float*)(const GAS float*)ldptr(PT, (i)))
#define P_OUT ((float*)(GAS float*)ldptr(PT, 19))
#define P_WSB(off) ((bf16*)(GAS bf16*)(ldptr(PT, 20) + (off)))
#define P_SUMQ ((u64*)(GAS u64*)(ldptr(PT, 20) + WS_PART))

#ifndef NO_P0
    {
        FRESH();
        bf16* XB = P_WSB(WS_XB); u64* SUMQ = P_SUMQ;
        for (int rep = 0; rep < REP_P0; ++rep) {
        conv_weights(PT, ldsl, 0x0003u, gw, NGW, wave, lane);
        if (bx == 0 && tid < 48) { float* rt = (float*)(GAS float*)(ldptr(PT, 20) + WS_ROPE);
            rt[tid] = (tid < 16) ? (float)::exp2(-(double)tid * (2.0 / 32.0) * 13.287712379549449) : (float)::exp2(-(double)(tid - 16) * (2.0 / 64.0) * 13.287712379549449); }
        const float* x = P_IN(0); const auto xrs = __builtin_amdgcn_make_buffer_rsrc((void*)XB, 0, 0x7fffffff, 0x00020000);
        for (int m0 = gw; m0 < SEQ; m0 += 2 * NGW) {
            f32x4 v[2][4]; float s[2];
#pragma unroll
            for (int q = 0; q < 2; ++q) { const int m = m0 + q * NGW; const GAS f32x4* xr = (const GAS f32x4*)(x + (size_t)(m < SEQ ? m : m0) * DMODEL) + lane;
#pragma unroll
                for (int j = 0; j < 4; ++j) v[q][j] = xr[64 * j]; }
#pragma unroll
            for (int q = 0; q < 2; ++q) { const int m = m0 + q * NGW; s[q] = 0.f;
#pragma unroll
                for (int j = 0; j < 4; ++j) s[q] += (v[q][j].x * v[q][j].x + v[q][j].y * v[q][j].y) + (v[q][j].z * v[q][j].z + v[q][j].w * v[q][j].w);
                s[q] = wave_sum(s[q]);
                if (m < SEQ) {
#pragma unroll
                    for (int j = 0; j < 4; ++j) { typedef unsigned v2u __attribute__((ext_vector_type(2))); const v2u w2 = {pk2(v[q][j].x, v[q][j].y), pk2(v[q][j].z, v[q][j].w)};
                        __builtin_amdgcn_raw_buffer_store_b64(w2, xrs, (int)(((unsigned)m * DMODEL + 256u * j + 4u * lane) * 2u), 0, 16); }
                    if (lane == 0) { SUMQ[m] = (unsigned long long)(s[q] * 1048576.f); SUMQ[SEQ + m] = 0ull; }
                } }
        }
        }
    }
    GRID_BAR();
#endif

#pragma unroll 1
    for (int L = 0; L < 2; ++L) {
#pragma unroll 1
        for (int h2 = 0; h2 < 2; ++h2) {
            const int f = 2 * L + h2;
#ifndef NO_GU
            {
                FRESH();
                u64* SUMQ = P_SUMQ; pg8::Gemm g{P_WSB(WS_XB), P_WSB(WS_WGU) + (size_t)f * NGU * DMODEL, SEQ, NGU, DMODEL}; pg8::StaticOrder S; S.init(SEQ, NGU, G, bx);
                pg8::EpiGU E{P_WSB(WS_U), SUMQ + par * SEQ, SUMQ + (par ^ 1) * SEQ};
                for (int rep = 0; rep < ((f == 0) ? REP_GU : 1); ++rep)
                pg8::gemm_phase<pg8::EpiGU, pg8::StaticOrder, true, true>(ldsl, g, S, E);
                { const unsigned cm = (f == 0) ? 0x301Cu : (f == 1) ? 0x02C0u : (f == 2) ? 0xCC00u : 0u; if (cm) conv_in_tail(PT, ldsl, cm, (SEQ / 256) * (NGU / 256), G, bx, wave, lane); }
            }
#endif
            GRID_BAR();
#ifndef NO_DOWN
            {
                FRESH();
                u64* SUMQ = P_SUMQ; pg8::Gemm g{P_WSB(WS_U), P_WSB(WS_WD) + (size_t)f * DMODEL * DFF, SEQ, DMODEL, DFF}; pg8::StaticOrder S; S.init(SEQ, DMODEL, G, bx);
                if (f == 0) { pg8::EpiRes<true> E{P_IN(0), P_WSB(WS_XB), SUMQ + (par ^ 1) * SEQ, 0.5f}; pg8::gemm_phase<pg8::EpiRes<true>, pg8::StaticOrder, true, true>(ldsl, g, S, E); }
                else if (f == 3) { pg8::EpiFinal E{P_WSB(WS_XB), P_OUT, SUMQ + (par ^ 1) * SEQ, (unsigned*)(GAS unsigned*)(ldptr(PT, 20) + WS_BAR) + XCD_BAR_WORDS, P_IN(18), 0.5f};
                    pg8::gemm_phase<pg8::EpiFinal, pg8::StaticOrder, true, true>(ldsl, g, S, E); }
                else { pg8::EpiRes<false> E{nullptr, P_WSB(WS_XB), SUMQ + (par ^ 1) * SEQ, 0.5f}; pg8::gemm_phase<pg8::EpiRes<false>, pg8::StaticOrder, true, true>(ldsl, g, S, E); }
                par ^= 1;
            }
#endif
            if (f == 3) break;
            GRID_BAR();
            if (h2 == 1) continue;
            const int NPROJ = (L == 0) ? 1536 : 3072;
#ifndef NO_PROJ
            {
                FRESH();
                u64* SUMQ = P_SUMQ; pg8::Gemm g{P_WSB(WS_XB), (L == 0) ? P_WSB(WS_WIN) : P_WSB(WS_WQKV), SEQ, NPROJ, DMODEL}; pg8::StaticOrder S; S.init(SEQ, NPROJ, G, bx);
                if (L == 0) {
                    pg8::EpiProjEven E{P_WSB(WS_PROJ), SUMQ + par * SEQ, SUMQ + (par ^ 1) * SEQ, P_IN(11), P_IN(12), (const float*)(const GAS float*)(ldptr(PT, 20) + WS_ROPE), QSCALE};
                    pg8::gemm_phase<pg8::EpiProjEven, pg8::StaticOrder, true, true>(ldsl, g, S, E);
                    conv_in_tail(PT, ldsl, 0x0120u, (SEQ / 256) * (1536 / 256), G, bx, wave, lane);
                } else {
                    pg8::EpiProj E{P_WSB(WS_PROJ), (unsigned)NPROJ, SUMQ + par * SEQ, SUMQ + (par ^ 1) * SEQ, 1024, QSCALE};
                    pg8::gemm_phase<pg8::EpiProj, pg8::StaticOrder, true, true>(ldsl, g, S, E);
                }
            }
#endif
            GRID_BAR();
            if (L == 0) {
                FRESH();
                {
                const attn_body::bf16* P = (const attn_body::bf16*)P_WSB(WS_PROJ); attn_body::bf16* O = (attn_body::bf16*)P_WSB(WS_O);
#define EVEN_KV(u_, kc_, vc_, t0_) { const int uu_ = (u_) & 511, h_ = uu_ & 7, qb_ = uu_ >> 3, kvh_ = h_ >> 2; \
                    if ((u_) < 512) { kc_ = 512 + kvh_ * 64; vc_ = 640 + kvh_ * 64; t0_ = 0; } else { kc_ = 1280 + kvh_ * 64; vc_ = 1408 + kvh_ * 64; t0_ = min(max(qb_ * 4 - 2, 0), 248); } }
                bool pre = false;
                for (int u = bx; u < 1024; u += G) {
                    const int uu = u & 511, h = uu & 7, qb = uu >> 3;
                    int kc, vc, t0; EVEN_KV(u, kc, vc, t0)
                    const int un = u + G; int nkc = 0, nvc = 0, nt0 = 0; const bool hn = un < 1024; if (hn) EVEN_KV(un, nkc, nvc, nt0)
                    const attn_body::bf16* nK = hn ? P + nkc : nullptr; const attn_body::bf16* nV = hn ? P + nvc : nullptr;
                    if (u < 512) attn_body::attn_unit<0, 8>(P + h * 64, P + kc, P + vc, O + h * 64, 1536, qb * 256, 0, 256, 0.f, nullptr, false, pre, false, nK, nV, nt0, (char*)lds);
                    else attn_body::attn_unit<1, 8>(P + 768 + h * 64, P + kc, P + vc, O + 512 + h * 64, 1536, qb * 256, t0, 8, P_IN(13)[h] * LOG2E, nullptr, false, pre, false, nK, nV, nt0, (char*)lds);
                    pre = hn;
                }
#ifdef PROBE_B2
                for (int u = bx + 512; u < 1024; u += G) {
                    const int uu = u & 511, h = uu & 7, qb = uu >> 3; int kc, vc, t0; EVEN_KV(u, kc, vc, t0)
                    attn_body::attn_unit<1, 8>(P + 768 + h * 64, P + kc, P + vc, O + 512 + h * 64, 1536, qb * 256, t0, 8, P_IN(13)[h] * LOG2E, nullptr, false, false, false, nullptr, nullptr, 0, (char*)lds);
                }
#endif
#undef EVEN_KV
                }
            } else {
                FRESH();
                int hb = -1;
#ifdef PROBE_NA24
                for (int u = bx; u < 1024; u += G) {
                    const int h = u & 15, qb = u >> 4; const int t0 = min(max(qb * 4 - 4, 0), 232);
                    const attn_body::bf16* P = (const attn_body::bf16*)P_WSB(WS_PROJ); attn_body::bf16* O = (attn_body::bf16*)P_WSB(WS_O);
                    attn_body::attn_unit<2, 8>(P + h * 64, P + 1024 + h * 64, P + 2048 + h * 64, O + h * 64, 3072, qb * 256, t0, 24, 0.f, P_IN(16) + h * 465, h != hb, false, false, nullptr, nullptr, 0, (char*)lds); hb = h;
                }
#endif
                {
                const attn_body::bf16* P = (const attn_body::bf16*)P_WSB(WS_PROJ); attn_body::bf16* O = (attn_body::bf16*)P_WSB(WS_O);
                bool pre = false;
                for (int u = bx; u < 1024; u += G) {
                    const int h = u & 15, qb = u >> 4; const int t0 = min(max(qb * 4 - 4, 0), 244);
                    const int un = u + G; const bool hn = un < 1024; const int nh = un & 15, nqb = un >> 4, nt0 = min(max(nqb * 4 - 4, 0), 244);
                    attn_body::attn_unit<2, 8>(P + h * 64, P + 1024 + h * 64, P + 2048 + h * 64, O + h * 64, 3072, qb * 256, t0, 12, 0.f, P_IN(16) + h * 465, h != hb, pre, pre,
                                               hn ? P + 1024 + nh * 64 : nullptr, hn ? P + 2048 + nh * 64 : nullptr, nt0, (char*)lds); hb = h;
                    pre = hn;
                }
                }
            }
            GRID_BAR();
#ifndef NO_OUT
            {
                FRESH();
                u64* SUMQ = P_SUMQ; float* OUT = P_OUT; pg8::Gemm g{P_WSB(WS_O), (L == 0) ? P_WSB(WS_WOE) : P_WSB(WS_WOO), SEQ, DMODEL, DMODEL}; pg8::StaticOrder S; S.init(SEQ, DMODEL, G, bx);
                pg8::EpiRes<false> E{nullptr, P_WSB(WS_XB), SUMQ + (par ^ 1) * SEQ, 1.0f}; par ^= 1;
                pg8::gemm_phase<pg8::EpiRes<false>, pg8::StaticOrder, true, true>(ldsl, g, S, E);
            }
#endif
            GRID_BAR();
        }
    }
}

extern "C" void kernel_launch(void* const* d_in, const int* in_sizes, int n_in, void* d_out, int out_size, void* d_ws, size_t ws_size, hipStream_t stream) {
    static int grid = 0;
    if (grid == 0) {
        if (n_in != 19 || out_size != SEQ * DMODEL || ws_size < WS_END) { fprintf(stderr, "kernel_launch: unexpected shapes (n_in %d, out %d, ws %zu < %zu)\n", n_in, out_size, ws_size, (size_t)WS_END); grid = -1; return; }
        int dev = 0, cus = 0, per_cu = 0;
        (void)hipGetDevice(&dev);
        (void)hipDeviceGetAttribute(&cus, hipDeviceAttributeMultiprocessorCount, dev);
        if (hipFuncSetAttribute((const void*)fwd_megakernel, hipFuncAttributeMaxDynamicSharedMemorySize, LDS_BYTES) != hipSuccess) { fprintf(stderr, "kernel_launch: hipFuncSetAttribute failed\n"); grid = -1; return; }
        if (hipOccupancyMaxActiveBlocksPerMultiprocessor(&per_cu, (const void*)fwd_megakernel, NWAVES * 64, LDS_BYTES) != hipSuccess || per_cu < 1) { fprintf(stderr, "kernel_launch: occupancy query failed (%d)\n", per_cu); (void)hipGetLastError(); per_cu = 1; }
        grid = cus * per_cu;
        fprintf(stderr, "kernel_launch: %d CUs x %d = grid %d\n", cus, per_cu, grid);
    }
    if (grid < 0) return;
    Args a{};
    for (int i = 0; i < 19; ++i) a.in[i] = (const float*)d_in[i];
    a.out = (float*)d_out; a.ws = (unsigned char*)d_ws;
    (void)hipMemsetAsync((unsigned char*)d_ws + WS_BAR, 0, (XCD_BAR_WORDS + 64 * 64) * 4, stream);
    void* kargs[] = {&a};
    hipError_t e = hipLaunchCooperativeKernel((const void*)fwd_megakernel, dim3(grid), dim3(NWAVES * 64), kargs, LDS_BYTES, stream);
    if (e != hipSuccess) fprintf(stderr, "kernel_launch: cooperative launch failed: %s (grid %d)\n", hipGetErrorString(e), grid);
}
```

```cpp
#include <hip/hip_runtime.h>
#include <hip/hip_bf16.h>
#include <cstdio>
#include <cstdint>
#include <cmath>

constexpr int SEQ = 16384, DMODEL = 1024, DFF = 2816, NGU = 2 * DFF;
constexpr float RMS_EPS = 1e-6f;
constexpr float LOG2E = 1.4426950408889634f;
constexpr float QSCALE = 0.125f * 1.4426950408889634f;

namespace pg8 {
#define PG8_LAS __attribute__((address_space(3)))
typedef unsigned short bf16_t;
typedef short bf16x8 __attribute__((ext_vector_type(8)));
typedef float f32x4 __attribute__((ext_vector_type(4)));
typedef unsigned u32x4 __attribute__((ext_vector_type(4)));
#define WT_RSRC(base) __builtin_amdgcn_make_buffer_rsrc((void*)(base), 0, 0x7fffffff, 0x00020000)
#define WT_STORE16(rsrc, byteoff, v) __builtin_amdgcn_raw_buffer_store_b128((v), (rsrc), (int)(byteoff), 0, 16)
constexpr int BM = 256, BK = 64, HALF = 128, HTB = HALF * BK * 2  , STAGE_BYTES = 8 * HTB, NXCD = 8, WGM = 8;

__host__ __device__ __forceinline__ int lds_byte(int r, int c) { const int st = (r >> 4) * 2 + (c >> 5), rr = r & 15, cc = c & 31, ob = rr * 64 + cc * 2; return st * 1024 + (ob ^ (((ob >> 9) & 1) << 5)); }
__host__ __device__ __forceinline__ void stage_rc(int b, int& R, int& C) { const int st = b / 1024, sb = b % 1024, swz = sb ^ (((sb >> 9) & 1) << 5); R = (st >> 1) * 16 + swz / 64; C = (st & 1) * 32 + (swz % 64) / 2; }
__host__ __device__ __forceinline__ int perm32(int rho) { const int n = rho >> 4, i = rho & 15; return 8 * (i >> 2) + 4 * n + (i & 3); }

struct Unit { int pm, pn; };
struct Gemm { const bf16_t* A; const bf16_t* Bt; int M, N, K; };

struct StaticOrder {
    int nM, nN, nwg, G, c;
    __host__ __device__ void init(int M, int N, int G_, int c_) { nM = M / BM; nN = N / BM; nwg = nM * nN; G = G_; c = c_; }
    __host__ __device__ bool next(int i, Unit& u) const {
        const long L = (long)i * G + c; if (L >= nwg) return false;
        int wgid = (int)L; { const int q = nwg / NXCD, r = nwg % NXCD, xcd = wgid % NXCD, off = wgid / NXCD; wgid = (xcd < r ? xcd * (q + 1) : r * (q + 1) + (xcd - r) * q) + off; }
        const int nig = WGM * nN, gid = wgid / nig, fm = gid * WGM, gsz = (nM - fm) < WGM ? (nM - fm) : WGM;
        u.pm = fm + ((wgid % nig) % gsz); u.pn = (wgid % nig) / gsz; return true;
    }
    __device__ __forceinline__ void a_ready(const Unit&) const {}
    __device__ __forceinline__ void done(const Unit&) const {}
};

__device__ __forceinline__ unsigned cvt_pk_bf16(float lo, float hi) { unsigned r; asm volatile("v_cvt_pk_bf16_f32 %0, %1, %2" : "=v"(r) : "v"(lo), "v"(hi)); return r; }
typedef unsigned long long u64;
__device__ __forceinline__ float row_scale(const u64* sq, unsigned row) {
    return __builtin_amdgcn_rsqf((float)sq[row] * (1.f / (1048576.f * 1024.f)) + 1e-6f);
}
constexpr int SCALE_LDS = 131072 + 1024;
__device__ __forceinline__ float silu_mul(float g, float u) { return g * u * __builtin_amdgcn_rcpf(1.f + __builtin_amdgcn_exp2f(-1.4426950408889634f * g)); }

struct EpiGU {
    static constexpr bool PERM = true, AFTER_DRAIN = false, HAS_PRE = true, IS_FINAL = false;
    bf16_t* ACT; const u64* sq; u64* sqz;
    __device__ __forceinline__ void pre_first(const Unit& u, PG8_LAS unsigned char* lds, int tid) const {
        if (tid < 256) ((PG8_LAS float*)(lds + SCALE_LDS))[tid] = row_scale(sq, u.pm * BM + tid);
    }
    __device__ __forceinline__ void operator()(const f32x4 (&acc)[2][2][4][2], const Unit& u, const Unit& nx, bool has_next, int par, PG8_LAS unsigned char* lds, int tid, int wr, int wc, int fr, int fq) const {
        u64 nsq = 0; const bool ld = has_next && tid < 256; if (ld) nsq = sq[nx.pm * BM + tid];
        const PG8_LAS float* sc = (const PG8_LAS float*)(lds + SCALE_LDS) + par * 256;
        const unsigned rl0 = wr * 64 + fr, row0 = u.pm * BM + rl0, col0 = u.pn * 128 + wc * 32 + 8 * fq; const auto rs_ = WT_RSRC(ACT);
        const bool zr = (u.pn == 0) && (wc == 0) && (fq == 0);
#pragma unroll
        for (int ai = 0; ai < 2; ++ai) {
#pragma unroll
            for (int m = 0; m < 4; ++m) { const unsigned row = row0 + ai * HALF + m * 16; const float s = sc[rl0 + ai * HALF + m * 16]; if (zr) sqz[row] = 0ull;
                const f32x4 g0 = acc[ai][0][m][0] * s, g1 = acc[ai][0][m][1] * s, u0 = acc[ai][1][m][0] * s, u1 = acc[ai][1][m][1] * s;
                u32x4 w; w.x = cvt_pk_bf16(silu_mul(g0[0], u0[0]), silu_mul(g0[1], u0[1])); w.y = cvt_pk_bf16(silu_mul(g0[2], u0[2]), silu_mul(g0[3], u0[3]));
                w.z = cvt_pk_bf16(silu_mul(g1[0], u1[0]), silu_mul(g1[1], u1[1])); w.w = cvt_pk_bf16(silu_mul(g1[2], u1[2]), silu_mul(g1[3], u1[3]));
                WT_STORE16(rs_, (row * 2816u + col0) * 2u, w); }
            __builtin_amdgcn_sched_barrier(0);
        }
        if (ld) ((PG8_LAS float*)(lds + SCALE_LDS))[(par ^ 1) * 256 + tid] = __builtin_amdgcn_rsqf((float)nsq * (1.f / (1048576.f * 1024.f)) + 1e-6f);
    }
};
template <bool F32IN> struct EpiRes {
    static constexpr bool PERM = true, AFTER_DRAIN = false, HAS_PRE = false, IS_FINAL = false;
    const float* in_f32; bf16_t* xb; u64* sqa; float alpha;
    __device__ __forceinline__ void finish(const f32x4& v0, const f32x4& v1, unsigned off, float& ss) const {
        u32x4 w; w.x = cvt_pk_bf16(v0[0], v0[1]); w.y = cvt_pk_bf16(v0[2], v0[3]); w.z = cvt_pk_bf16(v1[0], v1[1]); w.w = cvt_pk_bf16(v1[2], v1[3]);
        WT_STORE16(WT_RSRC(xb), off * 2u, w);
        ss += ((v0[0] * v0[0] + v0[1] * v0[1]) + (v0[2] * v0[2] + v0[3] * v0[3])) + ((v1[0] * v1[0] + v1[1] * v1[1]) + (v1[2] * v1[2] + v1[3] * v1[3]));
    }
    __device__ __forceinline__ void operator()(const f32x4 (&acc)[2][2][4][2], const Unit& u, int wr, int wc, int fr, int fq) const {
        const unsigned row0 = u.pm * BM + wr * 64 + fr, col0 = u.pn * BM + wc * 32 + 8 * fq;
        if constexpr (F32IN) {
#pragma unroll
            for (int ai = 0; ai < 2; ++ai)
#pragma unroll
                for (int mp = 0; mp < 2; ++mp) {
                    f32x4 o[2][2][2];
#pragma unroll
                    for (int mm = 0; mm < 2; ++mm)
#pragma unroll
                        for (int bj = 0; bj < 2; ++bj) { const unsigned off = (row0 + ai * HALF + (2 * mp + mm) * 16) * 1024u + col0 + bj * HALF;
                            o[mm][bj][0] = *(const f32x4*)(in_f32 + off); o[mm][bj][1] = *(const f32x4*)(in_f32 + (off + 4u)); }
#pragma unroll
                    for (int mm = 0; mm < 2; ++mm) { const int m = 2 * mp + mm; const unsigned row = row0 + ai * HALF + m * 16; float ss = 0.f;
#pragma unroll
                        for (int bj = 0; bj < 2; ++bj) finish(o[mm][bj][0] + acc[ai][bj][m][0] * alpha, o[mm][bj][1] + acc[ai][bj][m][1] * alpha, row * 1024u + col0 + bj * HALF, ss);
                        ss += __shfl_xor(ss, 16); ss += __shfl_xor(ss, 32);
                        if (fq == 0) atomicAdd(sqa + row, (u64)(ss * 1048576.f)); }
                    __builtin_amdgcn_sched_barrier(0);
                }
        } else {
            u32x4 t[2][4][2];
#pragma unroll
            for (int ai = 0; ai < 2; ++ai)
#pragma unroll
                for (int m = 0; m < 4; ++m)
#pragma unroll
                    for (int bj = 0; bj < 2; ++bj) t[ai][m][bj] = *(const u32x4*)(xb + ((row0 + ai * HALF + m * 16) * 1024u + col0 + bj * HALF));
            __builtin_amdgcn_sched_barrier(0);
#pragma unroll
            for (int ai = 0; ai < 2; ++ai) {
#pragma unroll
                for (int m = 0; m < 4; ++m) { const unsigned row = row0 + ai * HALF + m * 16; float ss = 0.f;
#pragma unroll
                    for (int bj = 0; bj < 2; ++bj) { const u32x4 w0 = t[ai][m][bj];
                        const f32x4 o0 = {__builtin_bit_cast(float, w0.x << 16), __builtin_bit_cast(float, w0.x & 0xffff0000u), __builtin_bit_cast(float, w0.y << 16), __builtin_bit_cast(float, w0.y & 0xffff0000u)};
                        const f32x4 o1 = {__builtin_bit_cast(float, w0.z << 16), __builtin_bit_cast(float, w0.z & 0xffff0000u), __builtin_bit_cast(float, w0.w << 16), __builtin_bit_cast(float, w0.w & 0xffff0000u)};
                        finish(o0 + acc[ai][bj][m][0] * alpha, o1 + acc[ai][bj][m][1] * alpha, row * 1024u + col0 + bj * HALF, ss); }
                    ss += __shfl_xor(ss, 16); ss += __shfl_xor(ss, 32);
                    if (fq == 0) atomicAdd(sqa + row, (u64)(ss * 1048576.f)); }
                __builtin_amdgcn_sched_barrier(0);
            }
        }
    }
};
__device__ __forceinline__ void cs_f64(float ang, float& c, float& s) {
    double t = (double)ang * 0.15915494309189535; t -= __builtin_rint(t); const float r = (float)t;
    c = __builtin_amdgcn_cosf(r); s = __builtin_amdgcn_sinf(r);
}
struct EpiProjEven {
    static constexpr bool PERM = true, AFTER_DRAIN = false, HAS_PRE = true, IS_FINAL = false;
    bf16_t* O; const u64* sq; u64* sqz; const float* gq; const float* gk; const float* rope; float qscale;
    __device__ __forceinline__ void pre_first(const Unit& u, PG8_LAS unsigned char* lds, int tid) const {
        if (tid < 256) ((PG8_LAS float*)(lds + SCALE_LDS))[tid] = row_scale(sq, u.pm * BM + tid);
    }
    __device__ __forceinline__ void operator()(const f32x4 (&acc)[2][2][4][2], const Unit& u, const Unit& nx, bool has_next, int par, PG8_LAS unsigned char* lds, int tid, int wr, int wc, int fr, int fq) const {
        u64 nsq = 0; const bool ld = has_next && tid < 256; if (ld) nsq = sq[nx.pm * BM + tid];
        const PG8_LAS float* sc = (const PG8_LAS float*)(lds + SCALE_LDS) + par * 256;
        const unsigned rl0 = wr * 64 + fr, row0 = u.pm * BM + rl0; const auto rs_ = WT_RSRC(O);
        const int hs = u.pn * 4 + wc;
        const unsigned ocol = 64u * hs + 8u * fq;
        const bool zr = (u.pn == 0) && (wc == 0) && (fq == 0);
        const bool isq = (hs < 8) || (hs >= 12 && hs < 20);
        const float qs = isq ? qscale : 1.f;
        const bool hi32 = (fq & 2) != 0;
        if (hs < 10) {
            const float* gp = (hs < 8) ? gq : gk;
            f32x4 g[2][2], iv[2];
#pragma unroll
            for (int bj = 0; bj < 2; ++bj)
#pragma unroll
                for (int n = 0; n < 2; ++n) g[bj][n] = *(const f32x4*)(gp + 32 * bj + 8 * fq + 4 * n);
#pragma unroll
            for (int n = 0; n < 2; ++n) iv[n] = *(const f32x4*)(rope + 8 * (fq & 1) + 4 * n) * 0.15915494309189535f;
#pragma unroll
            for (int ai = 0; ai < 2; ++ai) {
#pragma unroll
                for (int m = 0; m < 4; ++m) { const unsigned row = row0 + ai * HALF + m * 16; const float s = sc[rl0 + ai * HALF + m * 16]; if (zr) sqz[row] = 0ull;
                    f32x4 v[2][2]; float ss = 0.f;
#pragma unroll
                    for (int bj = 0; bj < 2; ++bj)
#pragma unroll
                        for (int n = 0; n < 2; ++n) { v[bj][n] = acc[ai][bj][m][n] * s; ss += (v[bj][n][0] * v[bj][n][0] + v[bj][n][1] * v[bj][n][1]) + (v[bj][n][2] * v[bj][n][2] + v[bj][n][3] * v[bj][n][3]); }
                    ss += __shfl_xor(ss, 16); ss += __shfl_xor(ss, 32);
                    const float rs = __builtin_amdgcn_rsqf(ss * (1.f / 64.f) + 1e-6f) * qs;
#pragma unroll
                    for (int bj = 0; bj < 2; ++bj) { const float pos = (float)(bj ? (row & 63u) : (row >> 6)); float o[8];
#pragma unroll
                        for (int n = 0; n < 2; ++n)
#pragma unroll
                            for (int j = 0; j < 4; ++j) { const float nv = v[bj][n][j] * rs * g[bj][n][j];
                                const auto rr = __builtin_amdgcn_permlane32_swap(__builtin_bit_cast(unsigned, nv), __builtin_bit_cast(unsigned, nv), false, false);
                                const float pr = __builtin_bit_cast(float, hi32 ? rr[0] : rr[1]);
                                const float rev = pos * iv[n][j]; const float c = __builtin_amdgcn_cosf(rev), sn = __builtin_amdgcn_sinf(rev);
                                o[4 * n + j] = hi32 ? (pr * sn + nv * c) : (nv * c - pr * sn); }
                        u32x4 w; w.x = cvt_pk_bf16(o[0], o[1]); w.y = cvt_pk_bf16(o[2], o[3]); w.z = cvt_pk_bf16(o[4], o[5]); w.w = cvt_pk_bf16(o[6], o[7]);
                        WT_STORE16(rs_, (row * 1536u + ocol + 32u * bj) * 2u, w); } }
                __builtin_amdgcn_sched_barrier(0);
            }
        } else if (hs >= 12 && hs < 22) {
            f32x4 iv[2];
#pragma unroll
            for (int n = 0; n < 2; ++n) iv[n] = *(const f32x4*)(rope + 16 + 8 * fq + 4 * n);
#pragma unroll
            for (int ai = 0; ai < 2; ++ai) {
#pragma unroll
                for (int m = 0; m < 4; ++m) { const unsigned row = row0 + ai * HALF + m * 16; const float s = sc[rl0 + ai * HALF + m * 16] * qs; if (zr) sqz[row] = 0ull;
                    float o1[8], o2[8]; const float pos = (float)row;
#pragma unroll
                    for (int n = 0; n < 2; ++n)
#pragma unroll
                        for (int j = 0; j < 4; ++j) { float c, sn; cs_f64(pos * iv[n][j], c, sn);
                            const float x1 = acc[ai][0][m][n][j] * s, x2 = acc[ai][1][m][n][j] * s;
                            o1[4 * n + j] = x1 * c - x2 * sn; o2[4 * n + j] = x1 * sn + x2 * c; }
                    u32x4 w; w.x = cvt_pk_bf16(o1[0], o1[1]); w.y = cvt_pk_bf16(o1[2], o1[3]); w.z = cvt_pk_bf16(o1[4], o1[5]); w.w = cvt_pk_bf16(o1[6], o1[7]);
                    WT_STORE16(rs_, (row * 1536u + ocol) * 2u, w);
                    w.x = cvt_pk_bf16(o2[0], o2[1]); w.y = cvt_pk_bf16(o2[2], o2[3]); w.z = cvt_pk_bf16(o2[4], o2[5]); w.w = cvt_pk_bf16(o2[6], o2[7]);
                    WT_STORE16(rs_, (row * 1536u + ocol + 32u) * 2u, w); }
                __builtin_amdgcn_sched_barrier(0);
            }
        } else {
#pragma unroll
            for (int ai = 0; ai < 2; ++ai) {
#pragma unroll
                for (int m = 0; m < 4; ++m) { const unsigned row = row0 + ai * HALF + m * 16; const float s = sc[rl0 + ai * HALF + m * 16]; if (zr) sqz[row] = 0ull;
#pragma unroll
                    for (int bj = 0; bj < 2; ++bj) { const f32x4 v0 = acc[ai][bj][m][0] * s, v1 = acc[ai][bj][m][1] * s;
                        u32x4 w; w.x = cvt_pk_bf16(v0[0], v0[1]); w.y = cvt_pk_bf16(v0[2], v0[3]); w.z = cvt_pk_bf16(v1[0], v1[1]); w.w = cvt_pk_bf16(v1[2], v1[3]);
                        WT_STORE16(rs_, (row * 1536u + ocol + 32u * bj) * 2u, w); } }
                __builtin_amdgcn_sched_barrier(0);
            }
        }
        if (ld) ((PG8_LAS float*)(lds + SCALE_LDS))[(par ^ 1) * 256 + tid] = __builtin_amdgcn_rsqf((float)nsq * (1.f / (1048576.f * 1024.f)) + 1e-6f);
    }
};
struct EpiFinal {
    static constexpr bool PERM = true, AFTER_DRAIN = false, HAS_PRE = false, IS_FINAL = true;
    const bf16_t* xb; float* out; u64* sqa; unsigned* cnt; const float* gain; float alpha;
    __device__ __forceinline__ void fin(f32x4 (&acc)[2][2][4][2], const Unit& u, int tid, int wr, int wc, int fr, int fq) const {
        const unsigned row0 = u.pm * BM + wr * 64 + fr, col0 = u.pn * BM + wc * 32 + 8 * fq;
        {
            u32x4 t[2][4][2];
#pragma unroll
            for (int ai = 0; ai < 2; ++ai)
#pragma unroll
                for (int m = 0; m < 4; ++m)
#pragma unroll
                    for (int bj = 0; bj < 2; ++bj) t[ai][m][bj] = *(const u32x4*)(xb + ((row0 + ai * HALF + m * 16) * 1024u + col0 + bj * HALF));
            __builtin_amdgcn_sched_barrier(0);
#pragma unroll
            for (int ai = 0; ai < 2; ++ai)
#pragma unroll
                for (int m = 0; m < 4; ++m) { const unsigned row = row0 + ai * HALF + m * 16; float ss = 0.f;
#pragma unroll
                    for (int bj = 0; bj < 2; ++bj) { const u32x4 w0 = t[ai][m][bj];
                        const f32x4 o0 = {__builtin_bit_cast(float, w0.x << 16), __builtin_bit_cast(float, w0.x & 0xffff0000u), __builtin_bit_cast(float, w0.y << 16), __builtin_bit_cast(float, w0.y & 0xffff0000u)};
                        const f32x4 o1 = {__builtin_bit_cast(float, w0.z << 16), __builtin_bit_cast(float, w0.z & 0xffff0000u), __builtin_bit_cast(float, w0.w << 16), __builtin_bit_cast(float, w0.w & 0xffff0000u)};
                        const f32x4 v0 = o0 + acc[ai][bj][m][0] * alpha, v1 = o1 + acc[ai][bj][m][1] * alpha;
                        acc[ai][bj][m][0] = v0; acc[ai][bj][m][1] = v1;
                        ss += ((v0[0] * v0[0] + v0[1] * v0[1]) + (v0[2] * v0[2] + v0[3] * v0[3])) + ((v1[0] * v1[0] + v1[1] * v1[1]) + (v1[2] * v1[2] + v1[3] * v1[3])); }
                    ss += __shfl_xor(ss, 16); ss += __shfl_xor(ss, 32);
                    if (fq == 0) atomicAdd(sqa + row, (u64)(ss * 1048576.f)); }
        }
        asm volatile("s_waitcnt vmcnt(0)" ::: "memory");
        __builtin_amdgcn_s_barrier();
        unsigned* cw = cnt + 64 * u.pm;
        if (tid == 0) (void)__hip_atomic_fetch_add(cw, 1u, __ATOMIC_RELAXED, __HIP_MEMORY_SCOPE_AGENT);
        if (tid < 64) {
            unsigned sp = 0;
            while ((unsigned)__builtin_amdgcn_readfirstlane(__hip_atomic_load(cw, __ATOMIC_RELAXED, __HIP_MEMORY_SCOPE_AGENT)) < 4u) { __builtin_amdgcn_s_sleep(1); if (++sp > (1u << 20)) break; }
            __builtin_amdgcn_fence(__ATOMIC_ACQUIRE, "agent");
            asm volatile("s_waitcnt vmcnt(0)" ::: "memory");
        }
        asm volatile("" ::: "memory"); __builtin_amdgcn_s_barrier(); asm volatile("" ::: "memory");
        f32x4 gv[2][2];
#pragma unroll
        for (int bj = 0; bj < 2; ++bj) { gv[bj][0] = *(const f32x4*)(gain + col0 + bj * HALF); gv[bj][1] = *(const f32x4*)(gain + col0 + bj * HALF + 4); }
#pragma unroll
        for (int ai = 0; ai < 2; ++ai)
#pragma unroll
            for (int m = 0; m < 4; ++m) { const unsigned row = row0 + ai * HALF + m * 16;
                const u64 tot = __hip_atomic_load(sqa + row, __ATOMIC_RELAXED, __HIP_MEMORY_SCOPE_AGENT);
                const float sc = __builtin_amdgcn_rsqf((float)tot * (1.f / (1048576.f * 1024.f)) + 1e-6f);
#pragma unroll
                for (int bj = 0; bj < 2; ++bj) { const unsigned off = row * 1024u + col0 + bj * HALF;
                    *(f32x4*)(out + off) = acc[ai][bj][m][0] * sc * gv[bj][0]; *(f32x4*)(out + (off + 4u)) = acc[ai][bj][m][1] * sc * gv[bj][1]; } }
    }
};
struct EpiNull {
    static constexpr bool PERM = true, AFTER_DRAIN = false, HAS_PRE = false, IS_FINAL = false;
    float* sink;
    __device__ __forceinline__ void operator()(const f32x4 (&acc)[2][2][4][2], const Unit& u, int wr, int wc, int fr, int fq) const {
        float s = 0.f;
#pragma unroll
        for (int a = 0; a < 2; ++a)
#pragma unroll
            for (int b = 0; b < 2; ++b)
#pragma unroll
                for (int m = 0; m < 4; ++m)
#pragma unroll
                    for (int n = 0; n < 2; ++n) s += acc[a][b][m][n][0] + acc[a][b][m][n][1] + acc[a][b][m][n][2] + acc[a][b][m][n][3];
        if (s == 123.456f) sink[0] = s;
    }
};
struct EpiProj {
    static constexpr bool PERM = true, AFTER_DRAIN = false, HAS_PRE = true, IS_FINAL = false;
    bf16_t* O; unsigned ldc; const u64* sq; u64* sqz; int qcols; float qscale;
    __device__ __forceinline__ void pre_first(const Unit& u, PG8_LAS unsigned char* lds, int tid) const {
        if (tid < 256) ((PG8_LAS float*)(lds + SCALE_LDS))[tid] = row_scale(sq, u.pm * BM + tid);
    }
    __device__ __forceinline__ void operator()(const f32x4 (&acc)[2][2][4][2], const Unit& u, const Unit& nx, bool has_next, int par, PG8_LAS unsigned char* lds, int tid, int wr, int wc, int fr, int fq) const {
        u64 nsq = 0; const bool ld = has_next && tid < 256; if (ld) nsq = sq[nx.pm * BM + tid];
        const PG8_LAS float* sc = (const PG8_LAS float*)(lds + SCALE_LDS) + par * 256;
        const unsigned rl0 = wr * 64 + fr, row0 = u.pm * BM + rl0, col0 = u.pn * BM + wc * 32 + 8 * fq; const auto rs_ = WT_RSRC(O);
        const float cs = (u.pn * BM < qcols) ? qscale : 1.f;
        const bool zr = (u.pn == 0) && (wc == 0) && (fq == 0);
#pragma unroll
        for (int ai = 0; ai < 2; ++ai) {
#pragma unroll
            for (int m = 0; m < 4; ++m) { const unsigned row = row0 + ai * HALF + m * 16; const float s = sc[rl0 + ai * HALF + m * 16] * cs; if (zr) sqz[row] = 0ull;
#pragma unroll
                for (int bj = 0; bj < 2; ++bj) { const f32x4 v0 = acc[ai][bj][m][0] * s, v1 = acc[ai][bj][m][1] * s;
                    u32x4 w; w.x = cvt_pk_bf16(v0[0], v0[1]); w.y = cvt_pk_bf16(v0[2], v0[3]); w.z = cvt_pk_bf16(v1[0], v1[1]); w.w = cvt_pk_bf16(v1[2], v1[3]);
                    WT_STORE16(rs_, (row * ldc + col0 + bj * HALF) * 2u, w); } }
            __builtin_amdgcn_sched_barrier(0);
        }
        if (ld) ((PG8_LAS float*)(lds + SCALE_LDS))[(par ^ 1) * 256 + tid] = __builtin_amdgcn_rsqf((float)nsq * (1.f / (1048576.f * 1024.f)) + 1e-6f);
    }
};
template <class Epi, class Sched, bool ALIGN_EPI = false, bool SP2 = false>
__device__ __forceinline__ void gemm_phase(PG8_LAS unsigned char* lds, Gemm g, const Sched& S, const Epi& E) {
    asm volatile("" : "+s"(g.A), "+s"(g.Bt));
    int tid = threadIdx.x; asm volatile("" : "+v"(tid));
    const int wid = __builtin_amdgcn_readfirstlane(tid >> 6), lane = tid & 63, wr = wid >> 2, wc = wid & 3, fr = lane & 15, fq = lane >> 4;
    const int K = g.K, nt = K / BK;
    unsigned voffA[2], voffB[2];
#pragma unroll
    for (int i = 0; i < 2; ++i) { int R, C; stage_rc(tid * 16 + i * 8192, R, C); const int Rb = Epi::PERM ? ((R & ~31) + perm32(R & 31)) : R;
        voffA[i] = (unsigned)(R * K + C) * 2u; voffB[i] = (unsigned)(Rb * K + C) * 2u; }
    const size_t kstep = (size_t)(BK * 2);
    const size_t hstep = (size_t)HALF * K * 2;
    const size_t tstep = 2 * hstep;
    const unsigned ldsw = (unsigned)wid * 1024u;
    const int aoff = lds_byte(wr * 64 + fr, fq * 8), boff = lds_byte(wc * 32 + fr, fq * 8);
#define PG8_SA(b, h) (((b) * 2 + (h)) * HTB)
#define PG8_SB(b, h) ((4 + (b) * 2 + (h)) * HTB)
#define PG8_STAGE(bufoff, gbase, voff) do { _Pragma("unroll") for (int _i = 0; _i < 2; ++_i) \
        __builtin_amdgcn_global_load_lds((const unsigned*)((const char*)(gbase) + (voff)[_i]), (PG8_LAS unsigned*)(lds + (bufoff) + ldsw + _i * 8192), 16, 0, 0); } while (0)
#define PG8_LDA(dst, b, h) do { _Pragma("unroll") for (int m = 0; m < 4; ++m) _Pragma("unroll") for (int k = 0; k < 2; ++k) dst[m][k] = *(const PG8_LAS bf16x8*)(lds + PG8_SA(b, h) + aoff + m * 2048 + k * 1024); } while (0)
#define PG8_LDB(dst, b, h) do { _Pragma("unroll") for (int n = 0; n < 2; ++n) _Pragma("unroll") for (int k = 0; k < 2; ++k) dst[n][k] = *(const PG8_LAS bf16x8*)(lds + PG8_SB(b, h) + boff + n * 2048 + k * 1024); } while (0)
#define PG8_MMA(ai, bj, At, Bt) do { __builtin_amdgcn_s_setprio(1); _Pragma("unroll") for (int m = 0; m < 4; ++m) _Pragma("unroll") for (int n = 0; n < 2; ++n) _Pragma("unroll") for (int k = 0; k < 2; ++k) \
        acc[ai][bj][m][n] = __builtin_amdgcn_mfma_f32_16x16x32_bf16(Bt[n][k], At[m][k], acc[ai][bj][m][n], 0, 0, 0); __builtin_amdgcn_s_setprio(0); } while (0)
#define PG8_WAIT_V(n) asm volatile("s_waitcnt vmcnt(" #n ")" ::: "memory")
#define PG8_WAIT_L(n) asm volatile("s_waitcnt lgkmcnt(" #n ")" ::: "memory")
#define PG8_BAR __builtin_amdgcn_s_barrier()
#define PG8_SCHED __builtin_amdgcn_sched_barrier(0)
    Unit cur, nxt; int ui = 0;
    if (!S.next(0, cur)) return;
    f32x4 acc[2][2][4][2];
#pragma unroll
    for (int a = 0; a < 2; ++a)
#pragma unroll
        for (int b = 0; b < 2; ++b)
#pragma unroll
            for (int m = 0; m < 4; ++m)
#pragma unroll
                for (int n = 0; n < 2; ++n) acc[a][b][m][n] = (f32x4){0.f, 0.f, 0.f, 0.f};
    bf16x8 At[4][2], B0[2][2], B1[2][2];
    const char* cA = (const char*)g.A + (size_t)cur.pm * tstep; const char* cB = (const char*)g.Bt + (size_t)cur.pn * tstep;
    S.a_ready(cur);
    if constexpr (Epi::HAS_PRE) E.pre_first(cur, lds, tid);
    if constexpr (SP2) {
        PG8_STAGE(PG8_SB(0, 0), cB, voffB); PG8_STAGE(PG8_SB(0, 1), cB + hstep, voffB); PG8_STAGE(PG8_SA(0, 0), cA, voffA); PG8_STAGE(PG8_SA(0, 1), cA + hstep, voffA);
        if (wr == 1) PG8_BAR;
        PG8_WAIT_V(2); PG8_BAR;
        PG8_STAGE(PG8_SB(1, 0), cB + kstep, voffB); PG8_STAGE(PG8_SA(1, 0), cA + kstep, voffA); PG8_STAGE(PG8_SB(1, 1), cB + hstep + kstep, voffB);
        PG8_WAIT_V(6); PG8_BAR;
    } else {
        PG8_STAGE(PG8_SB(0, 0), cB, voffB); PG8_STAGE(PG8_SA(0, 0), cA, voffA); PG8_STAGE(PG8_SB(0, 1), cB + hstep, voffB); PG8_STAGE(PG8_SA(0, 1), cA + hstep, voffA);
        if (wr == 1) PG8_BAR;
        PG8_WAIT_V(4); PG8_BAR;
        PG8_STAGE(PG8_SB(1, 0), cB + kstep, voffB); PG8_STAGE(PG8_SA(1, 0), cA + kstep, voffA); PG8_STAGE(PG8_SB(1, 1), cB + hstep + kstep, voffB);
        PG8_WAIT_V(6); PG8_BAR;
    }
    for (;;) {
        const bool has_next = S.next(ui + 1, nxt);
        const char* nA = has_next ? (const char*)g.A + (size_t)nxt.pm * tstep : cA; const char* nB = has_next ? (const char*)g.Bt + (size_t)nxt.pn * tstep : cB;
        for (int t = 0; t < nt; t += 2) {
            const bool last = (t == nt - 2);
            const char* a1 = cA + (size_t)(t + 1) * kstep;
            const char* a2 = last ? nA : cA + (size_t)(t + 2) * kstep; const char* b2 = last ? nB : cB + (size_t)(t + 2) * kstep;
            const char* a3 = a2 + kstep; const char* b3 = b2 + kstep;
            if (last && has_next) S.a_ready(nxt);
            if constexpr (SP2) {
            PG8_LDB(B0, 0, 0); PG8_LDB(B1, 0, 1); PG8_SCHED; PG8_LDA(At, 0, 0); PG8_STAGE(PG8_SA(1, 1), a1 + hstep, voffA);
            PG8_WAIT_V(8); PG8_WAIT_L(0); PG8_BAR; PG8_MMA(0, 0, At, B0); PG8_MMA(0, 1, At, B1); PG8_BAR; PG8_SCHED;
            PG8_LDA(At, 0, 1); PG8_STAGE(PG8_SB(0, 0), b2, voffB); PG8_STAGE(PG8_SB(0, 1), b2 + hstep, voffB); PG8_STAGE(PG8_SA(0, 0), a2, voffA);
            PG8_WAIT_V(8); PG8_WAIT_L(0); PG8_BAR; PG8_MMA(1, 0, At, B0); PG8_MMA(1, 1, At, B1); PG8_BAR; PG8_SCHED;
            PG8_LDB(B0, 1, 0); PG8_LDB(B1, 1, 1); PG8_SCHED; PG8_LDA(At, 1, 0); PG8_STAGE(PG8_SA(0, 1), a2 + hstep, voffA);
            PG8_WAIT_V(8); PG8_WAIT_L(0); PG8_BAR; PG8_MMA(0, 0, At, B0); PG8_MMA(0, 1, At, B1); PG8_BAR; PG8_SCHED;
            PG8_LDA(At, 1, 1); PG8_STAGE(PG8_SB(1, 0), b3, voffB); PG8_STAGE(PG8_SB(1, 1), b3 + hstep, voffB); PG8_STAGE(PG8_SA(1, 0), a3, voffA);
            PG8_WAIT_V(8); PG8_WAIT_L(0); PG8_BAR; PG8_MMA(1, 0, At, B0); PG8_MMA(1, 1, At, B1); PG8_BAR; PG8_SCHED;
            } else {
            PG8_LDB(B0, 0, 0); PG8_SCHED; PG8_LDA(At, 0, 0); PG8_STAGE(PG8_SA(1, 1), a1 + hstep, voffA);
            PG8_WAIT_L(8); PG8_BAR; PG8_WAIT_L(0); PG8_MMA(0, 0, At, B0); PG8_BAR; PG8_SCHED;
            PG8_LDB(B1, 0, 1); PG8_STAGE(PG8_SB(0, 0), b2, voffB);
            PG8_BAR; PG8_WAIT_L(0); PG8_MMA(0, 1, At, B1); PG8_BAR;
            PG8_LDA(At, 0, 1); PG8_STAGE(PG8_SA(0, 0), a2, voffA);
            PG8_BAR; PG8_WAIT_L(0); PG8_MMA(1, 0, At, B0); PG8_BAR; PG8_SCHED;
            PG8_STAGE(PG8_SB(0, 1), b2 + hstep, voffB);
            PG8_WAIT_V(6); PG8_BAR; PG8_MMA(1, 1, At, B1); PG8_BAR;
            PG8_LDB(B0, 1, 0); PG8_SCHED; PG8_LDA(At, 1, 0); PG8_STAGE(PG8_SA(0, 1), a2 + hstep, voffA);
            PG8_WAIT_L(8); PG8_BAR; PG8_WAIT_L(0); PG8_MMA(0, 0, At, B0); PG8_BAR; PG8_SCHED;
            PG8_LDB(B1, 1, 1); PG8_STAGE(PG8_SB(1, 0), b3, voffB);
            PG8_BAR; PG8_WAIT_L(0); PG8_MMA(0, 1, At, B1); PG8_BAR;
            PG8_LDA(At, 1, 1); PG8_STAGE(PG8_SA(1, 0), a3, voffA);
            PG8_BAR; PG8_WAIT_L(0); PG8_MMA(1, 0, At, B0); PG8_BAR; PG8_SCHED;
            PG8_STAGE(PG8_SB(1, 1), b3 + hstep, voffB);
            PG8_WAIT_V(6); PG8_BAR; PG8_MMA(1, 1, At, B1); PG8_BAR;
            }
        }
        if constexpr (ALIGN_EPI) { if (wr == 0) PG8_BAR; }
        if constexpr (Epi::HAS_PRE) { E(acc, cur, nxt, has_next, ui & 1, lds, tid, wr, wc, fr, fq); S.done(cur); }
        else if constexpr (Epi::IS_FINAL) { E.fin(acc, cur, tid, wr, wc, fr, fq); S.done(cur); }
        else if constexpr (!Epi::AFTER_DRAIN) { E(acc, cur, wr, wc, fr, fq); S.done(cur); }
        if (!has_next) break;
#pragma unroll
        for (int a = 0; a < 2; ++a)
#pragma unroll
            for (int b = 0; b < 2; ++b)
#pragma unroll
                for (int m = 0; m < 4; ++m)
#pragma unroll
                    for (int n = 0; n < 2; ++n) acc[a][b][m][n] = (f32x4){0.f, 0.f, 0.f, 0.f};
        cur = nxt; cA = nA; cB = nB; ++ui;
        if constexpr (ALIGN_EPI) { if (wr == 1) PG8_BAR; }
    }
    PG8_WAIT_V(0);
    if constexpr (!ALIGN_EPI) { if (wr == 0) PG8_BAR; }
    PG8_BAR;
    if constexpr (Epi::AFTER_DRAIN) { E.fused(acc, cur, wr, wc, fr, fq, lds, wid, lane); S.done(cur); }
#undef PG8_SA
#undef PG8_SB
#undef PG8_STAGE
#undef PG8_LDA
#undef PG8_LDB
#undef PG8_MMA
#undef PG8_WAIT_V
#undef PG8_WAIT_L
#undef PG8_BAR
#undef PG8_SCHED
}
}
namespace attn_body {
using bf16=__hip_bfloat16;
using bf16x8=__attribute__((ext_vector_type(8)))short;
using s16x4=__attribute__((ext_vector_type(4)))short;
using f32x16=__attribute__((ext_vector_type(16)))float;
using u32x4=__attribute__((ext_vector_type(4)))unsigned;
constexpr int BATCH=2,NHEAD=16,SEQ=8192,D=64,DM=NHEAD*D;
constexpr int NW=8,QBLK=32,QB=QBLK*NW,KVBLK=64,NQB=SEQ/QB;
constexpr int ATTN_PITCH=DM, ATTN_UNIT_ROWS=QB;
__device__ __forceinline__ int crow(int r,int hi){return (r&3)+8*(r>>2)+4*hi;}
#define SBAR() __builtin_amdgcn_sched_barrier(0)
constexpr int NSLOT=3, SLOTB=8192;
constexpr int LDS_K=0, LDS_V=NSLOT*SLOTB, LDS_WS=2*NSLOT*SLOTB, LDS_OST=LDS_WS+NW*64*4, LDS_BYTES=LDS_OST+NW*4096;
constexpr float C2=0.125f*1.4426950408889634f;
__device__ __forceinline__ void glds16(const void*gsrc,unsigned lds_dst){unsigned keep;
  asm volatile("s_mov_b32 %0, m0\n\ts_mov_b32 m0, %2\n\ts_nop 0\n\tglobal_load_lds_dwordx4 %1, off\n\ts_mov_b32 m0, %0":"=&s"(keep):"v"(gsrc),"s"(lds_dst):"memory");}
__device__ __forceinline__ float max3f(float a,float b,float c){float r;asm("v_max3_f32 %0, %1, %2, %3":"=v"(r):"v"(a),"v"(b),"v"(c));return r;}
__device__ __forceinline__ float max2f(float a,float b){float r;asm("v_max_f32_e32 %0, %1, %2":"=v"(r):"v"(a),"v"(b));return r;}
__device__ __forceinline__ float fadd_s(float a,float b){float r;asm("v_add_f32_e32 %0, %1, %2":"=v"(r):"v"(a),"v"(b));return r;}
__device__ __forceinline__ float fsub_s(float a,float b){float r;asm("v_sub_f32_e32 %0, %1, %2":"=v"(r):"v"(a),"v"(b));return r;}
typedef float f32x2_t __attribute__((ext_vector_type(2))); typedef __bf16 bf16x2_t __attribute__((ext_vector_type(2)));
__device__ __forceinline__ unsigned cvtpk_s(float lo,float hi){f32x2_t v={lo,hi};bf16x2_t b=__builtin_convertvector(v,bf16x2_t);return __builtin_bit_cast(unsigned,b);}
#define WAIT_BAR(N) asm volatile("s_waitcnt vmcnt(" #N ") lgkmcnt(0)\n\ts_barrier":::"memory")

__device__ __forceinline__ void qkt(f32x16&p0,f32x16&p1,const char*Kslot,const bf16x8*qr,const f32x16&negm,int r32,int hi){
  const char*kb=Kslot+hi*1024+r32*16;
  #pragma unroll
  for(int d0=0;d0<4;++d0){
    const bf16x8 b0=*reinterpret_cast<const bf16x8*>(kb+d0*2048);
    const bf16x8 b1=*reinterpret_cast<const bf16x8*>(kb+d0*2048+512);
    if(d0==0){p0=__builtin_amdgcn_mfma_f32_32x32x16_bf16(b0,qr[0],negm,0,0,0);p1=__builtin_amdgcn_mfma_f32_32x32x16_bf16(b1,qr[0],negm,0,0,0);}
    else{p0=__builtin_amdgcn_mfma_f32_32x32x16_bf16(b0,qr[d0],p0,0,0,0);p1=__builtin_amdgcn_mfma_f32_32x32x16_bf16(b1,qr[d0],p1,0,0,0);}}
}
typedef __attribute__((address_space(3))) const char* lds_cptr;
typedef short v4i16_t __attribute__((ext_vector_type(4)));
__device__ __forceinline__ void kload8(bf16x8*kf,lds_cptr kp){
  kf[0]=*(const __attribute__((address_space(3))) bf16x8*)(kp);      kf[1]=*(const __attribute__((address_space(3))) bf16x8*)(kp+512);
  kf[2]=*(const __attribute__((address_space(3))) bf16x8*)(kp+2048); kf[3]=*(const __attribute__((address_space(3))) bf16x8*)(kp+2560);
  kf[4]=*(const __attribute__((address_space(3))) bf16x8*)(kp+4096); kf[5]=*(const __attribute__((address_space(3))) bf16x8*)(kp+4608);
  kf[6]=*(const __attribute__((address_space(3))) bf16x8*)(kp+6144); kf[7]=*(const __attribute__((address_space(3))) bf16x8*)(kp+6656);
}
__device__ __forceinline__ void kload2(bf16x8*kf,lds_cptr kp,int j){ kf[2*j]=*(const __attribute__((address_space(3))) bf16x8*)(kp+j*2048); kf[2*j+1]=*(const __attribute__((address_space(3))) bf16x8*)(kp+j*2048+512); }
__device__ __forceinline__ s16x4 vtr(lds_cptr p){ return __builtin_bit_cast(s16x4,__builtin_amdgcn_ds_read_tr16_b64_v4i16((__attribute__((address_space(3))) v4i16_t*)p)); }
__device__ __forceinline__ float rowmax(const f32x16&p0,const f32x16&p1){
  float a=max3f(p0[0],p0[1],p1[0]),b=max3f(p0[2],p0[3],p1[1]);a=max3f(a,p1[2],p1[3]);
  #pragma unroll
  for(int r=4;r<16;r+=4){a=max3f(a,p0[r],p0[r+1]);b=max3f(b,p0[r+2],p0[r+3]);a=max3f(a,p1[r],p1[r+1]);b=max3f(b,p1[r+2],p1[r+3]);}
  const float m=max2f(a,b);
  auto rr=__builtin_amdgcn_permlane32_swap(__float_as_uint(m),__float_as_uint(m),false,false);
  return max2f(__uint_as_float(rr[0]),__uint_as_float(rr[1]));
}
__device__ __forceinline__ void pv(f32x16*o,int vb,bf16x8 pa0,bf16x8 pa1,bf16x8 pa2,bf16x8 pa3){
  #pragma unroll
  for(int d0=0;d0<2;++d0){s16x4 lo[4],hi[4];
    #pragma unroll
    for(int ks=0;ks<4;++ks){
      asm volatile("ds_read_b64_tr_b16 %0,%1 offset:%c2":"=&v"(lo[ks]):"v"(vb),"i"(d0*4096+ks*1024):"memory");
      asm volatile("ds_read_b64_tr_b16 %0,%1 offset:%c2":"=&v"(hi[ks]):"v"(vb),"i"(d0*4096+ks*1024+512):"memory");}
    asm volatile("s_waitcnt lgkmcnt(0)":::"memory");SBAR();
    #define PK(k) (bf16x8){lo[k][0],lo[k][1],lo[k][2],lo[k][3],hi[k][0],hi[k][1],hi[k][2],hi[k][3]}
    o[d0]=__builtin_amdgcn_mfma_f32_32x32x16_bf16(pa0,PK(0),o[d0],0,0,0);
    o[d0]=__builtin_amdgcn_mfma_f32_32x32x16_bf16(pa1,PK(1),o[d0],0,0,0);
    o[d0]=__builtin_amdgcn_mfma_f32_32x32x16_bf16(pa2,PK(2),o[d0],0,0,0);
    o[d0]=__builtin_amdgcn_mfma_f32_32x32x16_bf16(pa3,PK(3),o[d0],0,0,0);
    #undef PK
  }
}
constexpr int NA_DR=656, NA_TAB=15*NA_DR;
constexpr int LDS_BIAS=LDS_BYTES+1024, ATTN_LDS_TOTAL=LDS_BIAS+NA_TAB*4+2048;
constexpr int OPITCH=1024;
typedef __attribute__((address_space(3))) float* lds_fptr;
template<int MODE> __device__ __forceinline__ void amask(f32x16&p0,f32x16&p1,const int kt,const int qpos,const int hi,lds_fptr bias,const int tb0,const int tb1,const int qrow){
  if(MODE==1){
    const int kb=kt*64+4*hi, lo=qpos-128, hq=qpos+128;
    #pragma unroll
    for(int r=0;r<16;++r){const int kv=kb+(r&3)+8*(r>>2); if(kv<lo||kv>hq)p0[r]=-INFINITY; if(kv+32<lo||kv+32>hq)p1[r]=-INFINITY;}
  }
  if(MODE==2){
    const int rs=min(max(qrow-4,0),248);
    if(kt<rs||kt>=rs+8){
      #pragma unroll
      for(int r=0;r<16;++r){p0[r]=-INFINITY;p1[r]=-INFINITY;}
    } else {
      const int dr=kt-qrow+7; lds_fptr b0=bias+dr*NA_DR+tb0, b1=bias+dr*NA_DR+tb1;
      #pragma unroll
      for(int r=0;r<16;++r){const int o=(r&3)+8*(r>>2); p0[r]+=b0[o]; p1[r]+=b1[o];}
    }
  }
}
#define ATTN_STORE16(base,byteoff,v) __builtin_amdgcn_raw_buffer_store_b128((v), __builtin_amdgcn_make_buffer_rsrc((void*)(base), 0, 0x7fffffff, 0x00020000), (int)(byteoff), 0, 16)
template<int MODE,int THRL> __device__ __forceinline__ void attn_unit(const bf16*Qh,const bf16*__restrict__ Kh,const bf16*__restrict__ Vh,bf16*Oh,const int DM,const int q0,const int tile0,const int NT,const float sink_l2,const float*biasg,const bool build,const bool pre,const bool preV,const bf16*nKh,const bf16*nVh,const int ntile0,char*shm){
  int tid=threadIdx.x; asm volatile("":"+v"(tid)); const int lane=tid&63,r32=lane&31,hi=lane>>5; const int wid=__builtin_amdgcn_readfirstlane(tid>>6);
  const bf16*Qw=Qh+(long)(q0+wid*QBLK)*DM;
  const unsigned lds0=(unsigned)(uintptr_t)shm;
  float*wsf=(float*)(shm+LDS_WS)+wid*64;
  const bf16*ksrc=Kh+(long)(tile0*KVBLK+lane)*DM+wid*8;
  const bf16*vsrc=Vh+(long)(tile0*KVBLK+16*(wid&3)+(lane>>2))*DM+(wid>>2)*32+(lane&3)*8;
  const unsigned kdst=lds0+LDS_K+wid*1024, vdst=lds0+LDS_V+wid*1024;
  #define DMA_K(t,slot) glds16(ksrc+(long)(t)*KVBLK*DM,(unsigned)__builtin_amdgcn_readfirstlane(kdst+(slot)))
  #define DMA_V(t,slot) glds16(vsrc+(long)(t)*KVBLK*DM,(unsigned)__builtin_amdgcn_readfirstlane(vdst+(slot)))
  const int vb0=(int)(lds0+LDS_V)+((lane>>4)&1)*32+(lane&3)*8+(4*hi+((lane&15)>>2))*64;
  const char*Kbase=shm+LDS_K; bf16x8 kf[8];
  const lds_cptr shm3=(lds_cptr)shm; const lds_cptr kp0=shm3+LDS_K+hi*1024+r32*16; const lds_cptr vp0=shm3+LDS_V+((lane>>4)&1)*32+(lane&3)*8+(4*hi+((lane&15)>>2))*64;
  lds_fptr biasl=(lds_fptr)((lds_cptr)shm+LDS_BIAS);
  if(MODE==2&&build){
    lds_fptr stg=biasl+NA_TAB; if(tid<465) stg[tid]=biasg[tid]*1.4426950408889634f;
    asm volatile("s_waitcnt vmcnt(0) lgkmcnt(0)\n\ts_barrier":::"memory");
    for(int e=tid;e<NA_TAB;e+=512){ const int dr=e/NA_DR, w=e-dr*NA_DR; int idx=-1;
      if(w<112){ if(w>=48&&w<64) idx=w-41; } else if(w<144){ } else if(w<400){ const int q=(w-144)>>5, kc=(w-144)&31; if(kc<16) idx=kc-q+15; } else { const int q=(w-400)>>5, j=(w-400)&31; if(j>=16) idx=j-q-9; }
      biasl[e]=(idx>=0)?stg[dr*31+idx]:-INFINITY; } }
  if(!pre){DMA_K(0,0);} if(!preV){DMA_V(0,0);} if(!pre){DMA_K(1,SLOTB);}
  bf16x8 qr[4];
  #pragma unroll
  for(int d0=0;d0<4;++d0)qr[d0]=*reinterpret_cast<const bf16x8*>(&Qw[(long)r32*DM+d0*16+hi*8]);
  float mhat=0.f,l_reg=0.f;f32x16 o[2];o[0]=f32x16{};o[1]=f32x16{};f32x16 negm=f32x16{};asm volatile("":"+v"(negm));
  const int qpos=q0+wid*QBLK+r32; const int qrow=(q0>>6)+(wid>>1);
  int tb0=0,tb1=0; if(MODE==2){ const int qc=qpos&63; if(qc<8){tb0=144+qc*32;tb1=112;} else if(qc>=56){tb0=112;tb1=400+(qc-56)*32;} else {tb0=56-qc;tb1=tb0+32;} tb0+=4*hi;tb1+=4*hi; }
  #define CMASK(P0,P1,t) amask<MODE>(P0,P1,tile0+(t),qpos,hi,biasl,tb0,tb1,qrow)
  bool resc=false;
  #define START(P0,P1) do{ const float rm=rowmax(P0,P1); resc=false; \
    { const float dl=(MODE==0)?rm:__builtin_fmaxf(rm,-64.f); mhat=fadd_s(mhat,dl); \
      _Pragma("unroll") for(int r=0;r<16;++r){P0[r]=fsub_s(P0[r],dl);P1[r]=fsub_s(P1[r],dl);} \
      _Pragma("unroll") for(int r=0;r<16;++r)negm[r]=-mhat; asm volatile("":"+v"(negm)); } \
    _Pragma("unroll") for(int r=0;r<16;++r)P0[r]=__builtin_amdgcn_exp2f(P0[r]); }while(0)
  #define RESC() do{ if(resc){ asm volatile("s_waitcnt lgkmcnt(0)":::"memory"); \
      _Pragma("unroll") for(int d_=0;d_<2;++d_) _Pragma("unroll") for(int r=0;r<16;++r)o[d_][r]*=wsf[crow(r,hi)]; } }while(0)
  f32x16 pA0,pA1,pB0,pB1;
  int sl_prev=0,sl_cur=0,sl_next=SLOTB;
  #define ROT() do{sl_prev=sl_cur;sl_cur=sl_next;sl_next=(sl_next==(NSLOT-1)*SLOTB)?0:sl_next+SLOTB;}while(0)
  DMA_K(2,2*SLOTB);
  WAIT_BAR(3);
  qkt(pA0,pA1,Kbase,qr,negm,r32,hi);asm volatile("s_nop 15\n\ts_nop 7":"+v"(pA0),"+v"(pA1));CMASK(pA0,pA1,0);
  START(pA0,pA1);
  _Pragma("unroll") for(int r=0;r<16;++r)pA1[r]=__builtin_amdgcn_exp2f(pA1[r]);
  WAIT_BAR(0);
  DMA_K(3,0);DMA_V(1,SLOTB);
  ROT();
  kload8(kf,kp0+sl_cur);
  WAIT_BAR(2);
  s16x4 vlo[8],vhi[8]; u32x4 pw0,pw1,pw2,pw3;
  #define PKW(P,B) cvtpk_s(P[B],P[B+1])
  #define PAF(k) __builtin_bit_cast(bf16x8,pw##k)
  #define VFR(i) (bf16x8){vlo[i][0],vlo[i][1],vlo[i][2],vlo[i][3],vhi[i][0],vhi[i][1],vhi[i][2],vhi[i][3]}
  #define PIN(x) asm volatile("":"+v"(x))
  #define MX3(a,b,c) __builtin_fmaxf(__builtin_fmaxf((a),(b)),(c))
  #define GAPA(MF,A0,A1,A2,A3,W0,W1,PW) do{ MF; sacc+=A0; sacc+=A1; sacc+=A2; sacc+=A3; PIN(sacc); W0; W1; PIN(PW); SBAR(); }while(0)
  #define EX(v) __builtin_amdgcn_exp2f(v)
  #define GAPB(MF,X,B) do{ MF; X[B]=EX(X[B]); X[B+1]=EX(X[B+1]); X[B+2]=EX(X[B+2]); X[B+3]=EX(X[B+3]); PIN(X); SBAR(); }while(0)
  #define VRD(i) do{ vlo[i]=vtr(vp_+(((i)>>2)*4096+((i)&3)*1024)); vhi[i]=vtr(vp_+(((i)>>2)*4096+((i)&3)*1024+512)); }while(0)
  #define KRD(G,j) do{ if(G){ kload2(kf,kp0+sl_next,j); SBAR(); } }while(0)
  #define STEP(C0,C1,P0,P1,t,GK,GV,GL) do{ SBAR(); \
    const lds_cptr vp_=vp0+sl_prev; \
    VRD(0); SBAR(); float sacc=(P0[0]+P0[1]); \
    GAPA(C0=__builtin_amdgcn_mfma_f32_32x32x16_bf16(kf[0],qr[0],negm,0,0,0), P0[2],P0[3],P0[4],P0[5],     pw0[0]=PKW(P0,0), pw0[1]=PKW(P0,2), pw0); \
    VRD(4); SBAR(); GAPA(C1=__builtin_amdgcn_mfma_f32_32x32x16_bf16(kf[1],qr[0],negm,0,0,0), P0[6],P0[7],P0[8],P0[9],     pw0[2]=PKW(P0,4), pw0[3]=PKW(P0,6), pw0); \
    VRD(1); SBAR(); GAPA(C0=__builtin_amdgcn_mfma_f32_32x32x16_bf16(kf[2],qr[1],C0,0,0,0),   P0[10],P0[11],P0[12],P0[13], pw1[0]=PKW(P0,8), pw1[1]=PKW(P0,10), pw1); \
    VRD(5); SBAR(); GAPA(C1=__builtin_amdgcn_mfma_f32_32x32x16_bf16(kf[3],qr[1],C1,0,0,0),   P0[14],P0[15],P1[0],P1[1],   pw1[2]=PKW(P0,12),pw1[3]=PKW(P0,14), pw1); \
    VRD(2); SBAR(); GAPA(C0=__builtin_amdgcn_mfma_f32_32x32x16_bf16(kf[4],qr[2],C0,0,0,0),   P1[2],P1[3],P1[4],P1[5],     pw2[0]=PKW(P1,0), pw2[1]=PKW(P1,2), pw2); \
    VRD(6); SBAR(); GAPA(C1=__builtin_amdgcn_mfma_f32_32x32x16_bf16(kf[5],qr[2],C1,0,0,0),   P1[6],P1[7],P1[8],P1[9],     pw2[2]=PKW(P1,4), pw2[3]=PKW(P1,6), pw2); \
    VRD(3); SBAR(); GAPA(C0=__builtin_amdgcn_mfma_f32_32x32x16_bf16(kf[6],qr[3],C0,0,0,0),   P1[10],P1[11],P1[12],P1[13], pw3[0]=PKW(P1,8), pw3[1]=PKW(P1,10), pw3); \
    VRD(7); SBAR(); GAPA(C1=__builtin_amdgcn_mfma_f32_32x32x16_bf16(kf[7],qr[3],C1,0,0,0),   P1[14],P1[15],0.f,0.f,       pw3[2]=PKW(P1,12),pw3[3]=PKW(P1,14), pw3); \
    l_reg+=sacc; \
    if(GK){DMA_K((t)+3,sl_cur);} if(GV){DMA_V((t)+1,sl_next);} \
    CMASK(C0,C1,t); \
    { float a=MX3(C0[0],C0[1],C1[0]),b=MX3(C0[2],C0[3],C1[1]); a=MX3(a,C1[2],C1[3]); \
      _Pragma("unroll") for(int r=4;r<16;r+=4){a=MX3(a,C0[r],C0[r+1]);b=MX3(b,C0[r+2],C0[r+3]);a=MX3(a,C1[r],C1[r+1]);b=MX3(b,C1[r+2],C1[r+3]);} \
      float rm=__builtin_fmaxf(a,b); { auto rr=__builtin_amdgcn_permlane32_swap(__float_as_uint(rm),__float_as_uint(rm),false,false); rm=__builtin_fmaxf(__uint_as_float(rr[0]),__uint_as_float(rr[1])); } \
      resc=false; \
      if(__builtin_expect(__any(rm>(float)THRL),0)){ const float dl=__builtin_fmaxf(rm,0.f); mhat+=dl; \
        _Pragma("unroll") for(int r=0;r<16;++r){C0[r]-=dl;C1[r]-=dl;} \
        _Pragma("unroll") for(int r=0;r<16;++r)negm[r]=-mhat; asm volatile("":"+v"(negm)); \
        const float f=__builtin_amdgcn_exp2f(-dl); l_reg*=f; if(hi==0)wsf[r32]=f; resc=true; } } \
    SBAR(); \
    GAPB(o[0]=__builtin_amdgcn_mfma_f32_32x32x16_bf16(PAF(0),VFR(0),o[0],0,0,0), C0,0); \
    GAPB(o[1]=__builtin_amdgcn_mfma_f32_32x32x16_bf16(PAF(0),VFR(4),o[1],0,0,0), C0,4); \
    KRD(GL,0); GAPB(o[0]=__builtin_amdgcn_mfma_f32_32x32x16_bf16(PAF(1),VFR(1),o[0],0,0,0), C0,8); \
    KRD(GL,1); GAPB(o[1]=__builtin_amdgcn_mfma_f32_32x32x16_bf16(PAF(1),VFR(5),o[1],0,0,0), C0,12); \
    KRD(GL,2); GAPB(o[0]=__builtin_amdgcn_mfma_f32_32x32x16_bf16(PAF(2),VFR(2),o[0],0,0,0), C1,0); \
    KRD(GL,3); GAPB(o[1]=__builtin_amdgcn_mfma_f32_32x32x16_bf16(PAF(2),VFR(6),o[1],0,0,0), C1,4); \
    GAPB(o[0]=__builtin_amdgcn_mfma_f32_32x32x16_bf16(PAF(3),VFR(3),o[0],0,0,0), C1,8); \
    GAPB(o[1]=__builtin_amdgcn_mfma_f32_32x32x16_bf16(PAF(3),VFR(7),o[1],0,0,0), C1,12); \
    }while(0)
  int t=1;
  for(;t+5<NT;t+=2){
    STEP(pB0,pB1,pA0,pA1,t,true,true,true);     WAIT_BAR(2); RESC(); ROT();
    STEP(pA0,pA1,pB0,pB1,t+1,true,true,true);   WAIT_BAR(2); RESC(); ROT();
  }
  #define ENDW(tt) do{ if((tt)+3<NT){WAIT_BAR(2);} else if((tt)+2<NT){WAIT_BAR(1);} else {WAIT_BAR(0);} }while(0)
  for(;t+1<NT;t+=2){
    STEP(pB0,pB1,pA0,pA1,t,(t+3<NT),(t+1<NT),(t+1<NT));       ENDW(t);   RESC(); ROT();
    STEP(pA0,pA1,pB0,pB1,t+1,(t+4<NT),(t+2<NT),(t+2<NT));     ENDW(t+1); RESC(); ROT();
  }
  if(nKh){
    const bf16*nks=nKh+(long)(ntile0*KVBLK+lane)*DM+wid*8;
    glds16(nks,(unsigned)__builtin_amdgcn_readfirstlane(kdst));
    if(NT%3==0){ const bf16*nvs=nVh+(long)(ntile0*KVBLK+16*(wid&3)+(lane>>2))*DM+(wid>>2)*32+(lane&3)*8; glds16(nvs,(unsigned)__builtin_amdgcn_readfirstlane(vdst)); }
    glds16(nks+(long)KVBLK*DM,(unsigned)__builtin_amdgcn_readfirstlane(kdst+SLOTB)); }
  STEP(pB0,pB1,pA0,pA1,NT-1,false,false,false); RESC();
  { float sacc=pB0[0]+pB0[1]; _Pragma("unroll") for(int r=2;r<16;++r)sacc+=pB0[r]; _Pragma("unroll") for(int r=0;r<16;++r)sacc+=pB1[r]; l_reg+=sacc;
    pw0=(u32x4){PKW(pB0,0),PKW(pB0,2),PKW(pB0,4),PKW(pB0,6)};pw1=(u32x4){PKW(pB0,8),PKW(pB0,10),PKW(pB0,12),PKW(pB0,14)};pw2=(u32x4){PKW(pB1,0),PKW(pB1,2),PKW(pB1,4),PKW(pB1,6)};pw3=(u32x4){PKW(pB1,8),PKW(pB1,10),PKW(pB1,12),PKW(pB1,14)};
    SBAR(); pv(o,vb0+sl_cur,PAF(0),PAF(1),PAF(2),PAF(3)); }
  #undef PKW
  #undef PAF
  #undef VFR
  #undef PIN
  #undef MX3
  #undef GAPA
  #undef GAPB
  #undef EX
  #undef VRD
  #undef KRD
  #undef STEP
  #undef ENDW
  {auto rr=__builtin_amdgcn_permlane32_swap(__float_as_uint(l_reg),__float_as_uint(l_reg),false,false);l_reg=__uint_as_float(rr[0])+__uint_as_float(rr[1]);}
  if(MODE==1) l_reg+=__builtin_amdgcn_exp2f(sink_l2-mhat);
  if(hi==0)wsf[32+r32]=l_reg;asm volatile("s_waitcnt lgkmcnt(0)":::"memory");
  float rli[16];
  #pragma unroll
  for(int r=0;r<16;++r)rli[r]=__builtin_amdgcn_rcpf(wsf[32+crow(r,hi)]);
  bf16*Ow=Oh+(long)(q0+wid*QBLK)*OPITCH;
  { bf16*stg=(bf16*)(shm+LDS_OST)+wid*2048;
    #pragma unroll
    for(int r=0;r<16;++r){const int orow=crow(r,hi);
      #pragma unroll
      for(int d0=0;d0<2;++d0)stg[orow*64+d0*32+r32]=__float2bfloat16(o[d0][r]*rli[r]);}
    asm volatile("s_waitcnt lgkmcnt(0)":::"memory");
    #pragma unroll
    for(int i=0;i<4;++i){const int row=i*8+(lane>>3),ch=lane&7; const u32x4 v=*(const u32x4*)(stg+row*64+ch*8); ATTN_STORE16(Oh,(unsigned)(((q0+wid*QBLK+row)*OPITCH+ch*8)*2),v);} }
  asm volatile("s_waitcnt lgkmcnt(0)\n\ts_barrier":::"memory");
  #undef DMA_K
  #undef DMA_V
  #undef CMASK
  #undef START
  #undef RESC
  #undef ROT
}
#undef SBAR
#undef WAIT_BAR
}
#define GAS __attribute__((address_space(1)))
#define LAS __attribute__((address_space(3)))
typedef unsigned short bf16;
typedef unsigned v4u __attribute__((ext_vector_type(4)));
typedef float f32x4 __attribute__((ext_vector_type(4)));
constexpr int NWAVES = 8;
#ifndef REP_P0
#define REP_P0 1
#endif
#ifndef REP_ATT_E
#define REP_ATT_E 1
#endif
#ifndef REP_ATT_O
#define REP_ATT_O 1
#endif
#ifndef REP_GU
#define REP_GU 1
#endif
#ifndef REP_PROJ
#define REP_PROJ 1
#endif
constexpr int LDS_BYTES = 135168;
static_assert(attn_body::ATTN_LDS_TOTAL <= 131072, "attention LDS inside the ring");

constexpr size_t SZ_WGU = (size_t)NGU * DMODEL * 2, SZ_WD = (size_t)DMODEL * DFF * 2;
constexpr size_t WS_WGU = 0;
constexpr size_t WS_WD = WS_WGU + 4 * SZ_WGU;
constexpr size_t WS_WIN = WS_WD + 4 * SZ_WD;
constexpr size_t WS_WOE = WS_WIN + (size_t)1536 * 1024 * 2;
constexpr size_t WS_WQKV = WS_WOE + (size_t)1024 * 1024 * 2;
constexpr size_t WS_WOO = WS_WQKV + (size_t)3072 * 1024 * 2;
constexpr size_t WS_XB = WS_WOO + (size_t)1024 * 1024 * 2;
constexpr size_t WS_PART = WS_XB + (size_t)SEQ * DMODEL * 2;
constexpr size_t WS_U = WS_PART + (size_t)SEQ * 16 * 4;
constexpr size_t WS_PROJ = WS_U, WS_O = WS_U + (size_t)SEQ * 3072 * 2, WS_END = WS_O + (size_t)SEQ * 1024 * 2;
static_assert(WS_END <= 268435456 && WS_U % 256 == 0, "d_ws map");

struct Args { const float* in[19]; float* out; unsigned char* ws; };
typedef unsigned long long u64;
__device__ __forceinline__ u64 ldptr(LAS u64* PT, int i) { const u64 v = PT[i]; const unsigned lo = __builtin_amdgcn_readfirstlane((unsigned)v), hi = __builtin_amdgcn_readfirstlane((unsigned)(v >> 32)); return ((u64)hi << 32) | lo; }

__device__ __forceinline__ unsigned f2bf(float f) { unsigned u = __builtin_bit_cast(unsigned, f); return (u + 0x7fffu + ((u >> 16) & 1u)) >> 16; }
__device__ __forceinline__ unsigned pk2(float lo, float hi) { return f2bf(lo) | (f2bf(hi) << 16); }
__device__ __forceinline__ float bf2f(unsigned short b) { return __builtin_bit_cast(float, (unsigned)b << 16); }
#define LDS_WAIT() asm volatile("s_waitcnt lgkmcnt(0)" ::: "memory")
__device__ __forceinline__ float wave_sum(float v) {
#pragma unroll
    for (int o = 1; o < 64; o <<= 1) v += __shfl_xor(v, o);
    return v;
}
__device__ __forceinline__ void transpose_item(const float* W, int K, int N, bf16* WT, const float* gain, int mode, LAS float* scr, int item, int lane) {
    const int nblk = N / 32, kb = item / nblk, nb = item % nblk, k0 = 64 * kb, n0 = 32 * nb;
    {
        const int kk8 = lane >> 3, seg = lane & 7;
        f32x4 w[8]; float gk[8];
#pragma unroll
        for (int i = 0; i < 8; ++i) { w[i] = __builtin_nontemporal_load((const GAS f32x4*)(W + (size_t)(k0 + 8 * i + kk8) * N + n0 + 4 * seg)); gk[i] = gain ? gain[k0 + 8 * i + kk8] : 1.f; }
#pragma unroll
        for (int i = 0; i < 8; ++i) { LAS float* d = scr + (8 * i + kk8) * 33 + 4 * seg; const f32x4 v = w[i] * gk[i]; d[0] = v.x; d[1] = v.y; d[2] = v.z; d[3] = v.w; }
    }
    LDS_WAIT(); asm volatile("" ::: "memory");
    const int d0 = (mode == 0) ? n0 : (mode == 3) ? ((n0 & ~255) + 128 * ((n0 >> 5) & 1) + 32 * ((n0 & 255) >> 6)) : ((n0 >> 7) * 256 + (n0 & 127) + (mode == 2 ? 128 : 0));
    const auto wrs = __builtin_amdgcn_make_buffer_rsrc((void*)WT, 0, 0x7fffffff, 0x00020000);
    const int c = lane & 7;
#pragma unroll
    for (int j = 0; j < 4; ++j) { const int n = (lane >> 3) + 8 * j; const LAS float* s = scr + (8 * c) * 33 + n;
        v4u o; o.x = pk2(s[0 * 33], s[1 * 33]); o.y = pk2(s[2 * 33], s[3 * 33]); o.z = pk2(s[4 * 33], s[5 * 33]); o.w = pk2(s[6 * 33], s[7 * 33]);
        __builtin_amdgcn_raw_buffer_store_b128(o, wrs, (int)((((unsigned)(d0 + n)) * (unsigned)K + k0 + 8 * c) * 2u), 0, 16); }
    LDS_WAIT(); asm volatile("" ::: "memory");
}

__device__ __forceinline__ void cs_of(float ang, float& c, float& s) {
    double t = (double)ang * 0.15915494309189535; t -= __builtin_rint(t); const float r = (float)t;
    c = __builtin_amdgcn_cosf(r); s = __builtin_amdgcn_sinf(r);
}

#define P_IN(i) ((const float*)(const GAS float*)ldptr(PT, (i)))
#define P_WSB(off) ((bf16*)(GAS bf16*)(ldptr(PT, 20) + (off)))
__device__ __forceinline__ void conv_weights(LAS u64* PT, LAS unsigned char* ldsl, const unsigned mask, const int worker, const int nworkers, const int wave, const int lane) {
    LAS float* scr = (LAS float*)(ldsl + wave * 16384);
    bf16* WGU = P_WSB(WS_WGU); bf16* WD = P_WSB(WS_WD);
    constexpr int I_G = 16 * 88, I_D = 44 * 32, I_IN = 16 * 48, I_O = 16 * 32, I_QKV = 16 * 96;
    for (int it = worker; ; it += nworkers) {
        int r = it;
#define CONV_ENTRY(bit, cnt, call) if (mask & (1u << (bit))) { if (r < (cnt)) { call; continue; } r -= (cnt); }
#define FFN_ITEMS(f_, L_, GI, WG, WU, WDN) { const size_t wo = (size_t)(L_) * DMODEL * DFF; \
            CONV_ENTRY(3 * (f_) + 0, I_G, transpose_item(P_IN(WG) + wo, DMODEL, DFF, WGU + (size_t)(f_) * NGU * DMODEL, P_IN(GI) + (L_) * DMODEL, 1, scr, r, lane)) \
            CONV_ENTRY(3 * (f_) + 1, I_G, transpose_item(P_IN(WU) + wo, DMODEL, DFF, WGU + (size_t)(f_) * NGU * DMODEL, P_IN(GI) + (L_) * DMODEL, 2, scr, r, lane)) \
            CONV_ENTRY(3 * (f_) + 2, I_D, transpose_item(P_IN(WDN) + wo, DFF, DMODEL, WD + (size_t)(f_) * DMODEL * DFF, nullptr, 0, scr, r, lane)) }
        FFN_ITEMS(0, 0, 1, 2, 3, 4)
        FFN_ITEMS(1, 0, 6, 7, 8, 9)
        FFN_ITEMS(2, 1, 1, 2, 3, 4)
        FFN_ITEMS(3, 1, 6, 7, 8, 9)
#undef FFN_ITEMS
        CONV_ENTRY(12, I_IN, transpose_item(P_IN(10), DMODEL, 1536, P_WSB(WS_WIN), P_IN(5), 3, scr, r, lane))
        CONV_ENTRY(13, I_O, transpose_item(P_IN(14), DMODEL, DMODEL, P_WSB(WS_WOE), nullptr, 0, scr, r, lane))
        CONV_ENTRY(14, I_QKV, transpose_item(P_IN(15), DMODEL, 3072, P_WSB(WS_WQKV), P_IN(5) + DMODEL, 0, scr, r, lane))
        CONV_ENTRY(15, I_O, transpose_item(P_IN(17), DMODEL, DMODEL, P_WSB(WS_WOO), nullptr, 0, scr, r, lane))
#undef CONV_ENTRY
        break;
    }
}
#undef P_IN
#undef P_WSB
__device__ __forceinline__ void conv_in_tail(LAS u64* PT, LAS unsigned char* ldsl, const unsigned mask, const int nwg, const int G, const int bx, const int wave, const int lane) {
    const int rem = nwg % G, first = rem;
    if (bx >= first) conv_weights(PT, ldsl, mask, (bx - first) * NWAVES + wave, (G - first) * NWAVES, wave, lane);
}
#define RLX_AGENT __ATOMIC_RELAXED, __HIP_MEMORY_SCOPE_AGENT
#define XB_TMO      128
#define XB_XCNT(j)  (256  + 64 * (j))
#define XB_XSUB(j)  (1280 + 64 * (j))
#define XB_XGEN(j)  (2304 + 64 * (j))
#define XB_TOP      3328
#define XB_TOPGEN   3392
#define XCD_BAR_WORDS 3456
#define XB_SPIN_CAP (1u << 18)

__device__ __forceinline__ unsigned xb_ld(unsigned* p)              { return __hip_atomic_load(p, __ATOMIC_RELAXED, __HIP_MEMORY_SCOPE_AGENT); }
__device__ __forceinline__ unsigned xb_add(unsigned* p, unsigned v) { return __hip_atomic_fetch_add(p, v, __ATOMIC_RELAXED, __HIP_MEMORY_SCOPE_AGENT); }
__device__ __forceinline__ unsigned xb_xcc_id() { return (unsigned)__builtin_amdgcn_s_getreg((3 << 11) | 20) & 0xFu; }
#define XB_SPIN(cond, bar) do { unsigned _sp = 0; while (cond) { __builtin_amdgcn_s_sleep(1); \
    if ((++_sp & 255u) == 0u) { if (xb_ld(&(bar)[XB_TMO])) break; if (_sp > XB_SPIN_CAP) { atomicAdd(&(bar)[XB_TMO], 1u); break; } } } } while (0)

struct XcdBarrier {
    unsigned* bar; unsigned x;
    volatile LAS unsigned* st;
};

__device__ __forceinline__ XcdBarrier xcd_barrier_post(unsigned* bar, volatile LAS unsigned* st) {
    XcdBarrier b; b.bar = bar; b.x = xb_xcc_id(); b.st = st;
    if (threadIdx.x == 0) (void)xb_add(&bar[XB_XCNT(b.x)], 1u);
    return b;
}
__device__ __forceinline__ void xcd_barrier_complete(unsigned* bar, unsigned x, unsigned& nloc, unsigned& nx) {
    const unsigned G = gridDim.x * gridDim.y * gridDim.z;
    unsigned sum, cnt, mine, sp = 0u;
    for (;;) {
        sum = 0u; cnt = 0u; mine = 0u;
#pragma unroll
        for (unsigned j = 0; j < 16; ++j) { const unsigned c = xb_ld(&bar[XB_XCNT(j)]); sum += c; cnt += (c > 0u) ? 1u : 0u; mine = (j == x) ? c : mine; }
        if (sum == G) break;
        __builtin_amdgcn_s_sleep(1);
        if ((++sp & 255u) == 0u) { if (xb_ld(&bar[XB_TMO])) break; if (sp > XB_SPIN_CAP) { atomicAdd(&bar[XB_TMO], 1u); break; } }
    }
    nloc = mine > 0u ? mine : 1u; nx = cnt > 0u ? cnt : 1u;
}

__device__ __forceinline__ void xcd_barrier(const XcdBarrier& b) {
    asm volatile("s_waitcnt vmcnt(0)" ::: "memory");
    __syncthreads();
    if (threadIdx.x == 0) {
        unsigned* bar = b.bar;
        __builtin_amdgcn_s_waitcnt(0);
        unsigned nloc = b.st[0], nx = b.st[1];
        if (nloc == 0u) { xcd_barrier_complete(bar, b.x, nloc, nx); b.st[0] = nloc; b.st[1] = nx; }
        const unsigned old = xb_add(&bar[XB_XSUB(b.x)], 1u);
        const unsigned gen = old / nloc;
        if (old + 1u == (gen + 1u) * nloc) {
            __builtin_amdgcn_fence(__ATOMIC_RELEASE, "agent");
            asm volatile("s_waitcnt vmcnt(0)" ::: "memory");
            const unsigned og = xb_add(&bar[XB_TOP], 1u);
            const unsigned tg = og / nx;
            if (og + 1u == (tg + 1u) * nx) xb_add(&bar[XB_TOPGEN], 1u);
            else XB_SPIN(xb_ld(&bar[XB_TOPGEN]) == tg, bar);
            __builtin_amdgcn_fence(__ATOMIC_ACQUIRE, "agent");
            xb_add(&bar[XB_XGEN(b.x)], 1u);
            asm volatile("s_waitcnt vmcnt(0)" ::: "memory");
        } else {
            XB_SPIN(xb_ld(&bar[XB_XGEN(b.x)]) == gen, bar);
            __builtin_amdgcn_fence(__ATOMIC_ACQUIRE, "agent");
            asm volatile("s_waitcnt vmcnt(0)" ::: "memory");
        }
    }
    __syncthreads();
}

constexpr size_t WS_ROPE = WS_PART + 768 * 1024;
constexpr size_t WS_BAR = WS_PART + 512 * 1024;
__global__ void __launch_bounds__(NWAVES * 64, 2) fwd_megakernel(Args args) {
    extern __shared__ __attribute__((aligned(16))) unsigned char lds[];
    LAS unsigned char* ldsl = (LAS unsigned char*)lds;
#define FRESH() int tid = threadIdx.x; asm volatile("" : "+v"(tid)); int G = gridDim.x, bx = blockIdx.x; asm volatile("" : "+s"(G), "+s"(bx)); \
    const int lane = tid & 63, wave = __builtin_amdgcn_readfirstlane(tid >> 6); const int gw = bx * NWAVES + wave, NGW = G * NWAVES; (void)lane; (void)gw; (void)NGW;
    LAS u64* PT = (LAS u64*)(ldsl + 131072);
    if (threadIdx.x == 0) {
#pragma unroll
        for (int i = 0; i < 19; ++i) PT[i] = (u64)args.in[i];
        PT[19] = (u64)args.out; PT[20] = (u64)args.ws;
        ((volatile LAS unsigned*)(ldsl + 131072 + 256))[0] = 0u; ((volatile LAS unsigned*)(ldsl + 131072 + 256))[1] = 0u;
    }
    __syncthreads();
    { XcdBarrier b0 = xcd_barrier_post((unsigned*)(GAS unsigned*)((u64)args.ws + WS_BAR), (volatile LAS unsigned*)(ldsl + 131072 + 256)); (void)b0; }
#define GRID_BAR() do { XcdBarrier b_; b_.bar = (unsigned*)(GAS unsigned*)(ldptr(PT, 20) + WS_BAR); b_.x = xb_xcc_id(); b_.st = (volatile LAS unsigned*)(ldsl + 131072 + 256); xcd_barrier(b_); } while (0)
    int par = 0;
#define P_IN(i) ((const float*)(const GAS float*)ldptr(PT, (i)))
#define P_OUT ((float*)(GAS float*)ldptr(PT, 19))
#define P_WSB(off) ((bf16*)(GAS bf16*)(ldptr(PT, 20) + (off)))
#define P_SUMQ ((u64*)(GAS u64*)(ldptr(PT, 20) + WS_PART))

#ifndef NO_P0
    {
        FRESH();
        bf16* XB = P_WSB(WS_XB); u64* SUMQ = P_SUMQ;
        for (int rep = 0; rep < REP_P0; ++rep) {
        conv_weights(PT, ldsl, 0x0003u, gw, NGW, wave, lane);
        if (bx == 0 && tid < 48) { float* rt = (float*)(GAS float*)(ldptr(PT, 20) + WS_ROPE);
            rt[tid] = (tid < 16) ? (float)::exp2(-(double)tid * (2.0 / 32.0) * 13.287712379549449) : (float)::exp2(-(double)(tid - 16) * (2.0 / 64.0) * 13.287712379549449); }
        const float* x = P_IN(0); const auto xrs = __builtin_amdgcn_make_buffer_rsrc((void*)XB, 0, 0x7fffffff, 0x00020000);
        for (int m0 = gw; m0 < SEQ; m0 += 2 * NGW) {
            f32x4 v[2][4]; float s[2];
#pragma unroll
            for (int q = 0; q < 2; ++q) { const int m = m0 + q * NGW; const GAS f32x4* xr = (const GAS f32x4*)(x + (size_t)(m < SEQ ? m : m0) * DMODEL) + lane;
#pragma unroll
                for (int j = 0; j < 4; ++j) v[q][j] = xr[64 * j]; }
#pragma unroll
            for (int q = 0; q < 2; ++q) { const int m = m0 + q * NGW; s[q] = 0.f;
#pragma unroll
                for (int j = 0; j < 4; ++j) s[q] += (v[q][j].x * v[q][j].x + v[q][j].y * v[q][j].y) + (v[q][j].z * v[q][j].z + v[q][j].w * v[q][j].w);
                s[q] = wave_sum(s[q]);
                if (m < SEQ) {
#pragma unroll
                    for (int j = 0; j < 4; ++j) { typedef unsigned v2u __attribute__((ext_vector_type(2))); const v2u w2 = {pk2(v[q][j].x, v[q][j].y), pk2(v[q][j].z, v[q][j].w)};
                        __builtin_amdgcn_raw_buffer_store_b64(w2, xrs, (int)(((unsigned)m * DMODEL + 256u * j + 4u * lane) * 2u), 0, 16); }
                    if (lane == 0) { SUMQ[m] = (unsigned long long)(s[q] * 1048576.f); SUMQ[SEQ + m] = 0ull; }
                } }
        }
        }
    }
    GRID_BAR();
#endif

#pragma unroll 1
    for (int L = 0; L < 2; ++L) {
#pragma unroll 1
        for (int h2 = 0; h2 < 2; ++h2) {
            const int f = 2 * L + h2;
#ifndef NO_GU
            {
                FRESH();
                u64* SUMQ = P_SUMQ; pg8::Gemm g{P_WSB(WS_XB), P_WSB(WS_WGU) + (size_t)f * NGU * DMODEL, SEQ, NGU, DMODEL}; pg8::StaticOrder S; S.init(SEQ, NGU, G, bx);
                pg8::EpiGU E{P_WSB(WS_U), SUMQ + par * SEQ, SUMQ + (par ^ 1) * SEQ};
                for (int rep = 0; rep < ((f == 0) ? REP_GU : 1); ++rep)
                pg8::gemm_phase<pg8::EpiGU, pg8::StaticOrder, true, true>(ldsl, g, S, E);
                { const unsigned cm = (f == 0) ? 0x301Cu : (f == 1) ? 0x02C0u : (f == 2) ? 0xCC00u : 0u; if (cm) conv_in_tail(PT, ldsl, cm, (SEQ / 256) * (NGU / 256), G, bx, wave, lane); }
            }
#endif
            GRID_BAR();
#ifndef NO_DOWN
            {
                FRESH();
                u64* SUMQ = P_SUMQ; pg8::Gemm g{P_WSB(WS_U), P_WSB(WS_WD) + (size_t)f * DMODEL * DFF, SEQ, DMODEL, DFF}; pg8::StaticOrder S; S.init(SEQ, DMODEL, G, bx);
                if (f == 0) { pg8::EpiRes<true> E{P_IN(0), P_WSB(WS_XB), SUMQ + (par ^ 1) * SEQ, 0.5f}; pg8::gemm_phase<pg8::EpiRes<true>, pg8::StaticOrder, true, true>(ldsl, g, S, E); }
                else if (f == 3) { pg8::EpiFinal E{P_WSB(WS_XB), P_OUT, SUMQ + (par ^ 1) * SEQ, (unsigned*)(GAS unsigned*)(ldptr(PT, 20) + WS_BAR) + XCD_BAR_WORDS, P_IN(18), 0.5f};
                    pg8::gemm_phase<pg8::EpiFinal, pg8::StaticOrder, true, true>(ldsl, g, S, E); }
                else { pg8::EpiRes<false> E{nullptr, P_WSB(WS_XB), SUMQ + (par ^ 1) * SEQ, 0.5f}; pg8::gemm_phase<pg8::EpiRes<false>, pg8::StaticOrder, true, true>(ldsl, g, S, E); }
                par ^= 1;
            }
#endif
            if (f == 3) break;
            GRID_BAR();
            if (h2 == 1) continue;
            const int NPROJ = (L == 0) ? 1536 : 3072;
#ifndef NO_PROJ
            {
                FRESH();
                u64* SUMQ = P_SUMQ; pg8::Gemm g{P_WSB(WS_XB), (L == 0) ? P_WSB(WS_WIN) : P_WSB(WS_WQKV), SEQ, NPROJ, DMODEL}; pg8::StaticOrder S; S.init(SEQ, NPROJ, G, bx);
                if (L == 0) {
                    pg8::EpiProjEven E{P_WSB(WS_PROJ), SUMQ + par * SEQ, SUMQ + (par ^ 1) * SEQ, P_IN(11), P_IN(12), (const float*)(const GAS float*)(ldptr(PT, 20) + WS_ROPE), QSCALE};
                    pg8::gemm_phase<pg8::EpiProjEven, pg8::StaticOrder, true, true>(ldsl, g, S, E);
                    conv_in_tail(PT, ldsl, 0x0120u, (SEQ / 256) * (1536 / 256), G, bx, wave, lane);
                } else {
                    pg8::EpiProj E{P_WSB(WS_PROJ), (unsigned)NPROJ, SUMQ + par * SEQ, SUMQ + (par ^ 1) * SEQ, 1024, QSCALE};
                    pg8::gemm_phase<pg8::EpiProj, pg8::StaticOrder, true, true>(ldsl, g, S, E);
                }
            }
#endif
            GRID_BAR();
            if (L == 0) {
                FRESH();
                {
                const attn_body::bf16* P = (const attn_body::bf16*)P_WSB(WS_PROJ); attn_body::bf16* O = (attn_body::bf16*)P_WSB(WS_O);
#define EVEN_KV(u_, kc_, vc_, t0_) { const int uu_ = (u_) & 511, h_ = uu_ & 7, qb_ = uu_ >> 3, kvh_ = h_ >> 2; \
                    if ((u_) < 512) { kc_ = 512 + kvh_ * 64; vc_ = 640 + kvh_ * 64; t0_ = 0; } else { kc_ = 1280 + kvh_ * 64; vc_ = 1408 + kvh_ * 64; t0_ = min(max(qb_ * 4 - 2, 0), 248); } }
                bool pre = false;
                for (int u = bx; u < 1024; u += G) {
                    const int uu = u & 511, h = uu & 7, qb = uu >> 3;
                    int kc, vc, t0; EVEN_KV(u, kc, vc, t0)
                    const int un = u + G; int nkc = 0, nvc = 0, nt0 = 0; const bool hn = un < 1024; if (hn) EVEN_KV(un, nkc, nvc, nt0)
                    const attn_body::bf16* nK = hn ? P + nkc : nullptr; const attn_body::bf16* nV = hn ? P + nvc : nullptr;
                    if (u < 512) attn_body::attn_unit<0, 8>(P + h * 64, P + kc, P + vc, O + h * 64, 1536, qb * 256, 0, 256, 0.f, nullptr, false, pre, false, nK, nV, nt0, (char*)lds);
                    else attn_body::attn_unit<1, 8>(P + 768 + h * 64, P + kc, P + vc, O + 512 + h * 64, 1536, qb * 256, t0, 8, P_IN(13)[h] * LOG2E, nullptr, false, pre, false, nK, nV, nt0, (char*)lds);
                    pre = hn;
                }
#ifdef PROBE_B2
                for (int u = bx + 512; u < 1024; u += G) {
                    const int uu = u & 511, h = uu & 7, qb = uu >> 3; int kc, vc, t0; EVEN_KV(u, kc, vc, t0)
                    attn_body::attn_unit<1, 8>(P + 768 + h * 64, P + kc, P + vc, O + 512 + h * 64, 1536, qb * 256, t0, 8, P_IN(13)[h] * LOG2E, nullptr, false, false, false, nullptr, nullptr, 0, (char*)lds);
                }
#endif
#undef EVEN_KV
                }
            } else {
                FRESH();
                int hb = -1;
#ifdef PROBE_NA24
                for (int u = bx; u < 1024; u += G) {
                    const int h = u & 15, qb = u >> 4; const int t0 = min(max(qb * 4 - 4, 0), 232);
                    const attn_body::bf16* P = (const attn_body::bf16*)P_WSB(WS_PROJ); attn_body::bf16* O = (attn_body::bf16*)P_WSB(WS_O);
                    attn_body::attn_unit<2, 8>(P + h * 64, P + 1024 + h * 64, P + 2048 + h * 64, O + h * 64, 3072, qb * 256, t0, 24, 0.f, P_IN(16) + h * 465, h != hb, false, false, nullptr, nullptr, 0, (char*)lds); hb = h;
                }
#endif
                {
                const attn_body::bf16* P = (const attn_body::bf16*)P_WSB(WS_PROJ); attn_body::bf16* O = (attn_body::bf16*)P_WSB(WS_O);
                bool pre = false;
                for (int u = bx; u < 1024; u += G) {
                    const int h = u & 15, qb = u >> 4; const int t0 = min(max(qb * 4 - 4, 0), 244);
                    const int un = u + G; const bool hn = un < 1024; const int nh = un & 15, nqb = un >> 4, nt0 = min(max(nqb * 4 - 4, 0), 244);
                    attn_body::attn_unit<2, 8>(P + h * 64, P + 1024 + h * 64, P + 2048 + h * 64, O + h * 64, 3072, qb * 256, t0, 12, 0.f, P_IN(16) + h * 465, h != hb, pre, pre,
                                               hn ? P + 1024 + nh * 64 : nullptr, hn ? P + 2048 + nh * 64 : nullptr, nt0, (char*)lds); hb = h;
                    pre = hn;
                }
                }
            }
            GRID_BAR();
#ifndef NO_OUT
            {
                FRESH();
                u64* SUMQ = P_SUMQ; float* OUT = P_OUT; pg8::Gemm g{P_WSB(WS_O), (L == 0) ? P_WSB(WS_WOE) : P_WSB(WS_WOO), SEQ, DMODEL, DMODEL}; pg8::StaticOrder S; S.init(SEQ, DMODEL, G, bx);
                pg8::EpiRes<false> E{nullptr, P_WSB(WS_XB), SUMQ + (par ^ 1) * SEQ, 1.0f}; par ^= 1;
                pg8::gemm_phase<pg8::EpiRes<false>, pg8::StaticOrder, true, true>(ldsl, g, S, E);
            }
#endif
            GRID_BAR();
        }
    }
}

extern "C" void kernel_launch(void* const* d_in, const int* in_sizes, int n_in, void* d_out, int out_size, void* d_ws, size_t ws_size, hipStream_t stream) {
    static int grid = 0;
    if (grid == 0) {
        if (n_in != 19 || out_size != SEQ * DMODEL || ws_size < WS_END) { fprintf(stderr, "kernel_launch: unexpected shapes (n_in %d, out %d, ws %zu < %zu)\n", n_in, out_size, ws_size, (size_t)WS_END); grid = -1; return; }
        int dev = 0, cus = 0, per_cu = 0;
        (void)hipGetDevice(&dev);
        (void)hipDeviceGetAttribute(&cus, hipDeviceAttributeMultiprocessorCount, dev);
        if (hipFuncSetAttribute((const void*)fwd_megakernel, hipFuncAttributeMaxDynamicSharedMemorySize, LDS_BYTES) != hipSuccess) { fprintf(stderr, "kernel_launch: hipFuncSetAttribute failed\n"); grid = -1; return; }
        if (hipOccupancyMaxActiveBlocksPerMultiprocessor(&per_cu, (const void*)fwd_megakernel, NWAVES * 64, LDS_BYTES) != hipSuccess || per_cu < 1) { fprintf(stderr, "kernel_launch: occupancy query failed (%d)\n", per_cu); (void)hipGetLastError(); per_cu = 1; }
        grid = cus * per_cu;
        fprintf(stderr, "kernel_launch: %d CUs x %d = grid %d\n", cus, per_cu, grid);
    }
    if (grid < 0) return;
    Args a{};
    for (int i = 0; i < 19; ++i) a.in[i] = (const float*)d_in[i];
    a.out = (float*)d_out; a.ws = (unsigned char*)d_ws;
    (void)hipMemsetAsync((unsigned char*)d_ws + WS_BAR, 0, (XCD_BAR_WORDS + 64 * 64) * 4, stream);
    void* kargs[] = {&a};
    hipError_t e = hipLaunchCooperativeKernel((const void*)fwd_megakernel, dim3(grid), dim3(NWAVES * 64), kargs, LDS_BYTES, stream);
    if (e != hipSuccess) fprintf(stderr, "kernel_launch: cooperative launch failed: %s (grid %d)\n", hipGetErrorString(e), grid);
}
```
